# Optimizing an MI355X kernel written in HIP

```python
import math
import jax, jax.numpy as jnp
from jax import lax
import numpy as np

D_MODEL = 4096
BATCH = 4
SEQ = 4096
DEPTH = 1
DEC_BATCH = 32
DEC_SEQ = 64
PAST_LEN = 2048

CHUNK = 64
Q_BLOCK = 128
N_HEADS = 8
N_KV_HEADS = 4
GROUP = N_HEADS // N_KV_HEADS
HEAD_DIM = 128
V_DIM = 2 * HEAD_DIM
ATTN_WIDTH = N_HEADS * V_DIM
LRU_WIDTH = D_MODEL - ATTN_WIDTH
LRU_BLOCKS = 16
LRU_BLOCK = LRU_WIDTH // LRU_BLOCKS
CONV_WIDTH = 4
C_LRU = 8.0
ROT_DIM = HEAD_DIM // 4
ROPE_THETA = 500000.0
D_FF = 4 * D_MODEL
EPS = 1e-6
Q_COLS = N_HEADS * 2 * HEAD_DIM
K_COLS = N_KV_HEADS * 2 * HEAD_DIM
V_COLS = N_KV_HEADS * V_DIM
IN_COLS = Q_COLS + K_COLS + V_COLS + 2 * LRU_WIDTH

kernel_name = 'hymba_diffattn_rglru_stream_step'


def lambda_init_fn(layer_idx):
    return 0.8 - 0.6 * math.exp(-0.3 * layer_idx)


def rms_norm(x, g):
    xf = x.astype(jnp.float32)
    y = xf * lax.rsqrt(jnp.mean(xf * xf, axis=-1, keepdims=True) + EPS)
    return (y * g.astype(jnp.float32)).astype(x.dtype)


def rope_partial(x, pos):
    half = ROT_DIM // 2
    T = x.shape[1]
    inv = ROPE_THETA ** (-jnp.arange(half, dtype=jnp.float32) / half)
    ang = pos.astype(jnp.float32)[:, None] * inv[None, :]
    bshape = (1, T) + (1,) * (x.ndim - 3) + (half,)
    cos = jnp.cos(ang).reshape(bshape)
    sin = jnp.sin(ang).reshape(bshape)
    xf = x.astype(jnp.float32)
    x1 = xf[..., :half]
    x2 = xf[..., half:ROT_DIM]
    out = jnp.concatenate([x1 * cos - x2 * sin, x2 * cos + x1 * sin, xf[..., ROT_DIM:]], axis=-1)
    return out.astype(x.dtype)


def diff_attention(q, k, v, q_pos, k_pos, lam):
    s = jnp.einsum('bqhgcd,bkhcd->bhgcqk', q, k).astype(jnp.float32) * (HEAD_DIM ** -0.5)
    chunk_end = (q_pos // CHUNK + 1) * CHUNK
    visible = k_pos[None, :] < chunk_end[:, None]
    s = jnp.where(visible, s, -1e30)
    p = jax.nn.softmax(s, axis=-1)
    a = p[:, :, :, 0] - lam * p[:, :, :, 1]
    return jnp.einsum('bhgqk,bkhe->bqhge', a.astype(v.dtype), v)


def prompt_attention(q, k, v, lam):
    B, T = q.shape[0], q.shape[1]
    nb = T // Q_BLOCK
    qb = q.reshape((B, nb, Q_BLOCK) + q.shape[2:]).swapaxes(0, 1)
    k_pos = jnp.arange(T)

    def one_block(args):
        q_i, i = args
        q_pos = i * Q_BLOCK + jnp.arange(Q_BLOCK)
        return diff_attention(q_i, k, v, q_pos, k_pos, lam)

    ob = lax.map(one_block, (qb, jnp.arange(nb)))
    return ob.swapaxes(0, 1).reshape((B, T) + ob.shape[3:])


def causal_conv(x, prev, w, b):
    T = x.shape[1]
    xp = jnp.concatenate([prev.astype(x.dtype), x], axis=1)
    acc = b.astype(x.dtype)
    for j in range(CONV_WIDTH):
        acc = acc + xp[:, j:j + T] * w[j]
    return acc, xp[:, -(CONV_WIDTH - 1):]


def rg_lru(x, h0, ga_w, ga_b, gx_w, gx_b, lru_lam):
    B, T, _ = x.shape
    xb = x.reshape(B, T, LRU_BLOCKS, LRU_BLOCK)
    r = jax.nn.sigmoid((jnp.einsum('btnc,ncd->btnd', xb, ga_w) + ga_b).astype(jnp.float32)).reshape(B, T, LRU_WIDTH)
    i = jax.nn.sigmoid((jnp.einsum('btnc,ncd->btnd', xb, gx_w) + gx_b).astype(jnp.float32)).reshape(B, T, LRU_WIDTH)
    log_a = -C_LRU * r * jax.nn.softplus(-lru_lam.astype(jnp.float32))
    a = jnp.exp(log_a)
    u = jnp.sqrt(-jnp.expm1(2.0 * log_a)) * (i * x.astype(jnp.float32))

    def step(h, au):
        a_t, u_t = au
        h = a_t * h + u_t
        return h, h

    hT, hs = lax.scan(step, h0.astype(jnp.float32), (a.swapaxes(0, 1), u.swapaxes(0, 1)))
    return hs.swapaxes(0, 1).astype(x.dtype), hT


def trunk_layer(x, pos, k_past, v_past, conv_prev, h0, lp, lam_init):
    (g_mix, w_in, conv_w, conv_b, ga_w, ga_b, gx_w, gx_b, lru_lam,
     lq1, lk1, lq2, lk2, subln_g, w_out, g_mlp, w_up, w_down) = lp
    B, T, _ = x.shape
    xn = rms_norm(x, g_mix)
    proj = xn @ w_in
    o1 = Q_COLS
    o2 = o1 + K_COLS
    o3 = o2 + V_COLS
    o4 = o3 + LRU_WIDTH
    q = rope_partial(proj[..., :o1].reshape(B, T, N_KV_HEADS, GROUP, 2, HEAD_DIM), pos)
    k = rope_partial(proj[..., o1:o2].reshape(B, T, N_KV_HEADS, 2, HEAD_DIM), pos)
    v = proj[..., o2:o3].reshape(B, T, N_KV_HEADS, V_DIM)
    xr = proj[..., o3:o4]
    gr = proj[..., o4:]
    f32 = jnp.float32
    lam = (jnp.exp(jnp.sum(lq1.astype(f32) * lk1.astype(f32)))
           - jnp.exp(jnp.sum(lq2.astype(f32) * lk2.astype(f32))) + lam_init)
    if k_past is None:
        o = prompt_attention(q, k, v, lam)
    else:
        P = k_past.shape[1]
        k_all = jnp.concatenate([k_past.reshape(B, P, N_KV_HEADS, 2, HEAD_DIM).astype(k.dtype), k], axis=1)
        v_all = jnp.concatenate([v_past.astype(v.dtype), v], axis=1)
        o = diff_attention(q, k_all, v_all, pos, jnp.arange(P + T), lam)
    o = (rms_norm(o, subln_g) * (1.0 - lam_init)).reshape(B, T, ATTN_WIDTH)
    xc, conv_state = causal_conv(xr, conv_prev, conv_w, conv_b)
    hs, hT = rg_lru(xc, h0, ga_w, ga_b, gx_w, gx_b, lru_lam)
    y_lru = hs * jax.nn.gelu(gr)
    h = x + jnp.concatenate([o, y_lru], axis=-1) @ w_out
    z = rms_norm(h, g_mlp) @ w_up
    h = h + jnp.square(jax.nn.relu(z)) @ w_down
    return h, k.reshape(B, T, N_KV_HEADS, 2 * HEAD_DIM), v, conv_state, hT.astype(x.dtype)


def setup_inputs(seed: int = 0) -> dict:
    key = jax.random.key(seed)
    ks = jax.random.split(key, 26)
    f32 = jnp.float32

    def nrm(k, shape, s):
        return jax.random.normal(k, shape, f32) * s

    u = jax.random.uniform(ks[14], (DEPTH, LRU_WIDTH), f32, 0.9, 0.999)
    a = u ** (1.0 / C_LRU)
    lru_lambda = jnp.log(a) - jnp.log1p(-a)
    return {
        'x_prompt': nrm(ks[0], (BATCH, SEQ, D_MODEL), 1.0),
        'x_sample': nrm(ks[1], (DEC_BATCH, DEC_SEQ, D_MODEL), 1.0),
        'cache_k': nrm(ks[2], (DEPTH, DEC_BATCH, PAST_LEN, N_KV_HEADS, 2 * HEAD_DIM), 1.0),
        'cache_v': nrm(ks[3], (DEPTH, DEC_BATCH, PAST_LEN, N_KV_HEADS, V_DIM), 1.0),
        'state_conv': nrm(ks[4], (DEPTH, DEC_BATCH, CONV_WIDTH - 1, LRU_WIDTH), 1.0),
        'state_lru': nrm(ks[5], (DEPTH, DEC_BATCH, LRU_WIDTH), 0.5),
        'norm_mix': 1.0 + nrm(ks[6], (DEPTH, D_MODEL), 0.02),
        'w_in': nrm(ks[7], (DEPTH, D_MODEL, IN_COLS), D_MODEL ** -0.5),
        'conv_w': nrm(ks[8], (DEPTH, CONV_WIDTH, LRU_WIDTH), CONV_WIDTH ** -0.5),
        'conv_b': nrm(ks[9], (DEPTH, LRU_WIDTH), 0.01),
        'gate_a_w': nrm(ks[10], (DEPTH, LRU_BLOCKS, LRU_BLOCK, LRU_BLOCK), LRU_BLOCK ** -0.5),
        'gate_a_b': nrm(ks[11], (DEPTH, LRU_BLOCKS, LRU_BLOCK), 0.01),
        'gate_x_w': nrm(ks[12], (DEPTH, LRU_BLOCKS, LRU_BLOCK, LRU_BLOCK), LRU_BLOCK ** -0.5),
        'gate_x_b': nrm(ks[13], (DEPTH, LRU_BLOCKS, LRU_BLOCK), 0.01),
        'lru_lambda': lru_lambda,
        'lambda_q1': nrm(ks[15], (DEPTH, HEAD_DIM), 0.1),
        'lambda_k1': nrm(ks[16], (DEPTH, HEAD_DIM), 0.1),
        'lambda_q2': nrm(ks[17], (DEPTH, HEAD_DIM), 0.1),
        'lambda_k2': nrm(ks[18], (DEPTH, HEAD_DIM), 0.1),
        'subln_g': 1.0 + nrm(ks[19], (DEPTH, V_DIM), 0.02),
        'w_out': nrm(ks[20], (DEPTH, ATTN_WIDTH + LRU_WIDTH, D_MODEL), (ATTN_WIDTH + LRU_WIDTH) ** -0.5),
        'norm_mlp': 1.0 + nrm(ks[21], (DEPTH, D_MODEL), 0.02),
        'w_up': nrm(ks[22], (DEPTH, D_MODEL, D_FF), D_MODEL ** -0.5),
        'w_down': nrm(ks[23], (DEPTH, D_FF, D_MODEL), D_FF ** -0.5),
        'norm_final': 1.0 + nrm(ks[24], (D_MODEL,), 0.02),
    }


def reference(x_prompt, x_sample, cache_k, cache_v, state_conv, state_lru,
              norm_mix, w_in, conv_w, conv_b, gate_a_w, gate_a_b, gate_x_w, gate_x_b,
              lru_lambda, lambda_q1, lambda_k1, lambda_q2, lambda_k2, subln_g,
              w_out, norm_mlp, w_up, w_down, norm_final):
    Bp, Tp, _ = x_prompt.shape
    Bs, Ts, _ = x_sample.shape
    P = cache_k.shape[2]
    pos_p = jnp.arange(Tp)
    pos_s = P + jnp.arange(Ts)
    hp = x_prompt
    hs = x_sample
    kp_l, vp_l, cp_l, lp_l = [], [], [], []
    ks_l, vs_l, cs_l, ls_l = [], [], [], []
    for l in range(DEPTH):
        lp = (norm_mix[l], w_in[l], conv_w[l], conv_b[l], gate_a_w[l], gate_a_b[l],
              gate_x_w[l], gate_x_b[l], lru_lambda[l], lambda_q1[l], lambda_k1[l],
              lambda_q2[l], lambda_k2[l], subln_g[l], w_out[l], norm_mlp[l], w_up[l], w_down[l])
        lam_init = lambda_init_fn(l)
        conv0 = jnp.zeros((Bp, CONV_WIDTH - 1, LRU_WIDTH), x_prompt.dtype)
        h0 = jnp.zeros((Bp, LRU_WIDTH), jnp.float32)
        hp, kp, vp, cp, lpr = trunk_layer(hp, pos_p, None, None, conv0, h0, lp, lam_init)
        hs, kn, vn, cn, lsn = trunk_layer(hs, pos_s, cache_k[l], cache_v[l], state_conv[l], state_lru[l], lp, lam_init)
        kp_l.append(kp); vp_l.append(vp); cp_l.append(cp); lp_l.append(lpr)
        ks_l.append(kn); vs_l.append(vn); cs_l.append(cn); ls_l.append(lsn)
    y_prompt = rms_norm(hp, norm_final)
    y_sample = rms_norm(hs, norm_final)
    k_prompt = jnp.stack(kp_l)
    v_prompt = jnp.stack(vp_l)
    conv_prompt = jnp.stack(cp_l)
    lru_prompt = jnp.stack(lp_l)
    k_sample = jnp.stack(ks_l)
    v_sample = jnp.stack(vs_l)
    conv_sample = jnp.stack(cs_l)
    lru_sample = jnp.stack(ls_l)
    return (y_prompt, y_sample, k_prompt, v_prompt, conv_prompt, lru_prompt,
            k_sample, v_sample, conv_sample, lru_sample)
```

```cpp
#include <hip/hip_runtime.h>
#include <cstdio>
#include <cstdint>
namespace pg8 {
#define PG8_LAS __attribute__((address_space(3)))
typedef unsigned short bf16_t;
typedef short bf16x8 __attribute__((ext_vector_type(8)));
typedef float f32x4 __attribute__((ext_vector_type(4)));
typedef unsigned u32x4 __attribute__((ext_vector_type(4)));
constexpr int BM = 256, BK = 64, HALF = 128, HTB = HALF * BK * 2  , STAGE_BYTES = 8 * HTB, NXCD = 8, WGM = 8;

__host__ __device__ __forceinline__ int lds_byte(int r, int c) { const int st = (r >> 4) * 2 + (c >> 5), rr = r & 15, cc = c & 31, ob = rr * 64 + cc * 2; return st * 1024 + (ob ^ (((ob >> 9) & 1) << 5)); }
__host__ __device__ __forceinline__ void stage_rc(int b, int& R, int& C) { const int st = b / 1024, sb = b % 1024, swz = sb ^ (((sb >> 9) & 1) << 5); R = (st >> 1) * 16 + swz / 64; C = (st & 1) * 32 + (swz % 64) / 2; }
__host__ __device__ __forceinline__ int perm32(int rho) { const int n = rho >> 4, i = rho & 15; return 8 * (i >> 2) + 4 * n + (i & 3); }

struct Unit { int pm, pn; };
struct Gemm { const bf16_t* A; const bf16_t* Bt; int M, N, K; };

struct StaticOrder {
    int nM, nN, nwg, G, c;
    __host__ __device__ void init(int M, int N, int G_, int c_) { nM = M / BM; nN = N / BM; nwg = nM * nN; G = G_; c = c_; }
    __host__ __device__ bool next(int i, Unit& u) const {
        const long L = (long)i * G + c; if (L >= nwg) return false;
        int wgid = (int)L; { const int q = nwg / NXCD, r = nwg % NXCD, xcd = wgid % NXCD, off = wgid / NXCD; wgid = (xcd < r ? xcd * (q + 1) : r * (q + 1) + (xcd - r) * q) + off; }
        const int nig = WGM * nN, gid = wgid / nig, fm = gid * WGM, gsz = (nM - fm) < WGM ? (nM - fm) : WGM;
        u.pm = fm + ((wgid % nig) % gsz); u.pn = (wgid % nig) / gsz; return true;
    }
    __device__ __forceinline__ void a_ready(const Unit&) const {}
    __device__ __forceinline__ void done(const Unit&) const {}
};

__device__ __forceinline__ unsigned cvt_pk_bf16(float lo, float hi) { unsigned r; asm volatile("v_cvt_pk_bf16_f32 %0, %1, %2" : "=v"(r) : "v"(lo), "v"(hi)); return r; }
typedef float f32x2 __attribute__((ext_vector_type(2)));
template <class Epi, class Sched, bool ALIGN_EPI = false, bool SP2 = false>
__device__ __forceinline__ void gemm_phase(PG8_LAS unsigned char* lds, const Gemm g, const Sched& S, const Epi& E) {
    const int tid = threadIdx.x, wid = __builtin_amdgcn_readfirstlane(tid >> 6), lane = tid & 63, wr = wid >> 2, wc = wid & 3, fr = lane & 15, fq = lane >> 4;
    const int K = g.K, nt = K / BK;
    unsigned voffA[2], voffB[2];
#pragma unroll
    for (int i = 0; i < 2; ++i) { int R, C; stage_rc(tid * 16 + i * 8192, R, C); const int Rb = Epi::PERM ? ((R & ~31) + perm32(R & 31)) : R;
        voffA[i] = (unsigned)(R * K + C) * 2u; voffB[i] = (unsigned)(Rb * K + C) * 2u; }
    const size_t kstep = (size_t)(BK * 2);
    const size_t hstep = (size_t)HALF * K * 2;
    const size_t tstep = 2 * hstep;
    const unsigned ldsw = (unsigned)wid * 1024u;
    const int aoff = lds_byte(wr * 64 + fr, fq * 8), boff = lds_byte(wc * 32 + fr, fq * 8);
#define PG8_SA(b, h) (((b) * 2 + (h)) * HTB)
#define PG8_SB(b, h) ((4 + (b) * 2 + (h)) * HTB)
#define PG8_STAGE(bufoff, gbase, voff) do { _Pragma("unroll") for (int _i = 0; _i < 2; ++_i) \
        __builtin_amdgcn_global_load_lds((const unsigned*)((const char*)(gbase) + (voff)[_i]), (PG8_LAS unsigned*)(lds + (bufoff) + ldsw + _i * 8192), 16, 0, 0); } while (0)
#define PG8_LDA(dst, b, h) do { _Pragma("unroll") for (int m = 0; m < 4; ++m) _Pragma("unroll") for (int k = 0; k < 2; ++k) dst[m][k] = *(const PG8_LAS bf16x8*)(lds + PG8_SA(b, h) + aoff + m * 2048 + k * 1024); } while (0)
#define PG8_LDB(dst, b, h) do { _Pragma("unroll") for (int n = 0; n < 2; ++n) _Pragma("unroll") for (int k = 0; k < 2; ++k) dst[n][k] = *(const PG8_LAS bf16x8*)(lds + PG8_SB(b, h) + boff + n * 2048 + k * 1024); } while (0)
#define PG8_MMA(ai, bj, At, Bt) do { __builtin_amdgcn_s_setprio(1); _Pragma("unroll") for (int m = 0; m < 4; ++m) _Pragma("unroll") for (int n = 0; n < 2; ++n) _Pragma("unroll") for (int k = 0; k < 2; ++k) \
        acc[ai][bj][m][n] = __builtin_amdgcn_mfma_f32_16x16x32_bf16(Bt[n][k], At[m][k], acc[ai][bj][m][n], 0, 0, 0); __builtin_amdgcn_s_setprio(0); } while (0)
#define PG8_WAIT_V(n) asm volatile("s_waitcnt vmcnt(" #n ")" ::: "memory")
#define PG8_WAIT_L(n) asm volatile("s_waitcnt lgkmcnt(" #n ")" ::: "memory")
#define PG8_BAR __builtin_amdgcn_s_barrier()
#define PG8_SCHED __builtin_amdgcn_sched_barrier(0)
    Unit cur, nxt; int ui = 0;
    if (!S.next(0, cur)) return;
    f32x4 acc[2][2][4][2];
#pragma unroll
    for (int a = 0; a < 2; ++a)
#pragma unroll
        for (int b = 0; b < 2; ++b)
#pragma unroll
            for (int m = 0; m < 4; ++m)
#pragma unroll
                for (int n = 0; n < 2; ++n) acc[a][b][m][n] = (f32x4){0.f, 0.f, 0.f, 0.f};
    bf16x8 At[4][2], B0[2][2], B1[2][2];
    const char* cA = (const char*)g.A + (size_t)cur.pm * tstep; const char* cB = (const char*)g.Bt + (size_t)cur.pn * tstep;
    S.a_ready(cur);
    if constexpr (SP2) {
        PG8_STAGE(PG8_SB(0, 0), cB, voffB); PG8_STAGE(PG8_SB(0, 1), cB + hstep, voffB); PG8_STAGE(PG8_SA(0, 0), cA, voffA); PG8_STAGE(PG8_SA(0, 1), cA + hstep, voffA);
        if (wr == 1) PG8_BAR;
        PG8_WAIT_V(2); PG8_BAR;
        PG8_STAGE(PG8_SB(1, 0), cB + kstep, voffB); PG8_STAGE(PG8_SA(1, 0), cA + kstep, voffA); PG8_STAGE(PG8_SB(1, 1), cB + hstep + kstep, voffB);
        PG8_WAIT_V(6); PG8_BAR;
    } else {
        PG8_STAGE(PG8_SB(0, 0), cB, voffB); PG8_STAGE(PG8_SA(0, 0), cA, voffA); PG8_STAGE(PG8_SB(0, 1), cB + hstep, voffB); PG8_STAGE(PG8_SA(0, 1), cA + hstep, voffA);
        if (wr == 1) PG8_BAR;
        PG8_WAIT_V(4); PG8_BAR;
        PG8_STAGE(PG8_SB(1, 0), cB + kstep, voffB); PG8_STAGE(PG8_SA(1, 0), cA + kstep, voffA); PG8_STAGE(PG8_SB(1, 1), cB + hstep + kstep, voffB);
        PG8_WAIT_V(6); PG8_BAR;
    }
    for (;;) {
        const bool has_next = S.next(ui + 1, nxt);
        const char* nA = has_next ? (const char*)g.A + (size_t)nxt.pm * tstep : cA; const char* nB = has_next ? (const char*)g.Bt + (size_t)nxt.pn * tstep : cB;
        for (int t = 0; t < nt; t += 2) {
            const bool last = (t == nt - 2);
            const char* a1 = cA + (size_t)(t + 1) * kstep;
            const char* a2 = last ? nA : cA + (size_t)(t + 2) * kstep; const char* b2 = last ? nB : cB + (size_t)(t + 2) * kstep;
            const char* a3 = a2 + kstep; const char* b3 = b2 + kstep;
            if (last && has_next) S.a_ready(nxt);
            if constexpr (SP2) {
            PG8_LDB(B0, 0, 0); PG8_LDB(B1, 0, 1); PG8_SCHED; PG8_LDA(At, 0, 0); PG8_STAGE(PG8_SA(1, 1), a1 + hstep, voffA);
            PG8_WAIT_V(8); PG8_WAIT_L(0); PG8_BAR; PG8_MMA(0, 0, At, B0); PG8_MMA(0, 1, At, B1); PG8_BAR; PG8_SCHED;
            PG8_LDA(At, 0, 1); PG8_STAGE(PG8_SB(0, 0), b2, voffB); PG8_STAGE(PG8_SB(0, 1), b2 + hstep, voffB); PG8_STAGE(PG8_SA(0, 0), a2, voffA);
            PG8_WAIT_V(8); PG8_WAIT_L(0); PG8_BAR; PG8_MMA(1, 0, At, B0); PG8_MMA(1, 1, At, B1); PG8_BAR; PG8_SCHED;
            PG8_LDB(B0, 1, 0); PG8_LDB(B1, 1, 1); PG8_SCHED; PG8_LDA(At, 1, 0); PG8_STAGE(PG8_SA(0, 1), a2 + hstep, voffA);
            PG8_WAIT_V(8); PG8_WAIT_L(0); PG8_BAR; PG8_MMA(0, 0, At, B0); PG8_MMA(0, 1, At, B1); PG8_BAR; PG8_SCHED;
            PG8_LDA(At, 1, 1); PG8_STAGE(PG8_SB(1, 0), b3, voffB); PG8_STAGE(PG8_SB(1, 1), b3 + hstep, voffB); PG8_STAGE(PG8_SA(1, 0), a3, voffA);
            PG8_WAIT_V(8); PG8_WAIT_L(0); PG8_BAR; PG8_MMA(1, 0, At, B0); PG8_MMA(1, 1, At, B1); PG8_BAR; PG8_SCHED;
            } else {
            PG8_LDB(B0, 0, 0); PG8_SCHED; PG8_LDA(At, 0, 0); PG8_STAGE(PG8_SA(1, 1), a1 + hstep, voffA);
            PG8_WAIT_L(8); PG8_BAR; PG8_WAIT_L(0); PG8_MMA(0, 0, At, B0); PG8_BAR; PG8_SCHED;
            PG8_LDB(B1, 0, 1); PG8_STAGE(PG8_SB(0, 0), b2, voffB);
            PG8_BAR; PG8_WAIT_L(0); PG8_MMA(0, 1, At, B1); PG8_BAR;
            PG8_LDA(At, 0, 1); PG8_STAGE(PG8_SA(0, 0), a2, voffA);
            PG8_BAR; PG8_WAIT_L(0); PG8_MMA(1, 0, At, B0); PG8_BAR; PG8_SCHED;
            PG8_STAGE(PG8_SB(0, 1), b2 + hstep, voffB);
            PG8_WAIT_V(6); PG8_BAR; PG8_MMA(1, 1, At, B1); PG8_BAR;
            PG8_LDB(B0, 1, 0); PG8_SCHED; PG8_LDA(At, 1, 0); PG8_STAGE(PG8_SA(0, 1), a2 + hstep, voffA);
            PG8_WAIT_L(8); PG8_BAR; PG8_WAIT_L(0); PG8_MMA(0, 0, At, B0); PG8_BAR; PG8_SCHED;
            PG8_LDB(B1, 1, 1); PG8_STAGE(PG8_SB(1, 0), b3, voffB);
            PG8_BAR; PG8_WAIT_L(0); PG8_MMA(0, 1, At, B1); PG8_BAR;
            PG8_LDA(At, 1, 1); PG8_STAGE(PG8_SA(1, 0), a3, voffA);
            PG8_BAR; PG8_WAIT_L(0); PG8_MMA(1, 0, At, B0); PG8_BAR; PG8_SCHED;
            PG8_STAGE(PG8_SB(1, 1), b3 + hstep, voffB);
            PG8_WAIT_V(6); PG8_BAR; PG8_MMA(1, 1, At, B1); PG8_BAR;
            }
        }
        if constexpr (ALIGN_EPI) { if (wr == 0) PG8_BAR; }
        if constexpr (!Epi::AFTER_DRAIN) { E(acc, cur, wr, wc, fr, fq); S.done(cur); }
        if (!has_next) break;
#pragma unroll
        for (int a = 0; a < 2; ++a)
#pragma unroll
            for (int b = 0; b < 2; ++b)
#pragma unroll
                for (int m = 0; m < 4; ++m)
#pragma unroll
                    for (int n = 0; n < 2; ++n) acc[a][b][m][n] = (f32x4){0.f, 0.f, 0.f, 0.f};
        cur = nxt; cA = nA; cB = nB; ++ui;
        if constexpr (ALIGN_EPI) { if (wr == 1) PG8_BAR; }
    }
    PG8_WAIT_V(0);
    if constexpr (!ALIGN_EPI) { if (wr == 0) PG8_BAR; }
    PG8_BAR;
    if constexpr (Epi::AFTER_DRAIN) { E.fused(acc, cur, wr, wc, fr, fq, lds, wid, lane); S.done(cur); }
#undef PG8_SA
#undef PG8_SB
#undef PG8_STAGE
#undef PG8_LDA
#undef PG8_LDB
#undef PG8_MMA
#undef PG8_WAIT_V
#undef PG8_WAIT_L
#undef PG8_BAR
#undef PG8_SCHED
}
}
#ifndef PG8_SP2
#define PG8_SP2 true
#endif
#ifndef PG8_ALIGN
#define PG8_ALIGN true
#endif

constexpr int NWAVES = 8;
#ifndef MK_N_LAUNCHES
#define MK_N_LAUNCHES 7
#endif
constexpr int N_PHASES = 7;
constexpr int N_LAUNCHES = MK_N_LAUNCHES;

constexpr int D = 4096, MP = 16384, MS = 2048, M = MP + MS;
constexpr int TP = 4096, TS = 64, PAST = 2048, TKS = PAST + TS;
constexpr int NIN = 8192, DFF = 16384, LW = 2048;
constexpr float EPS = 1e-6f;
constexpr float QSCALE = 0.08838834764831845f * 1.4426950408889634f;
constexpr float LAM_INIT = 0.2f;
constexpr size_t O_Y = 0, O_KP = 75497472, O_VP = 92274688, O_CP = 109051904, O_LP = 109076480, O_KS = 109084672, O_VS = 111181824, O_CS = 113278976, O_LS = 113475584, O_END = 113541120;

constexpr size_t MiB = 1u << 20;
constexpr size_t WS_CTL = 0, CTL_ZERO_BYTES = 1 * MiB;
constexpr size_t WS_TAB = 1 * MiB;
constexpr size_t WS_GWT = 2 * MiB;
constexpr size_t WS_WIN = 4 * MiB, WS_WOUT = 68 * MiB, WS_WUP = 100 * MiB, WS_WDN = 228 * MiB;
constexpr size_t WS_HN = 356 * MiB;
constexpr size_t WS_Z = 500 * MiB;
constexpr size_t WS_XN = 500 * MiB;
constexpr size_t WS_QB = 644 * MiB;
constexpr size_t WS_KP = 716 * MiB;
constexpr size_t WS_KS = 748 * MiB;
constexpr size_t WS_VTP = 880 * MiB;
constexpr size_t WS_VTS = 912 * MiB;
constexpr size_t WS_XR = 1044 * MiB;
constexpr size_t WS_GG = 1116 * MiB;
constexpr size_t WS_END = 1188 * MiB;
constexpr int CW_TMO = 0, CW_CODE = 1, CW_QCTR = 64, CW_BAR = 4096, CW_RSS1 = 16384, CW_RSS2 = 36864;

constexpr int RING_BYTES = 131072, LDSCTL_OFF = RING_BYTES, MISC_OFF = LDSCTL_OFF + 320, LDS_BYTES = 147456;

#define GAS __attribute__((address_space(1)))
#define LAS __attribute__((address_space(3)))
typedef unsigned short bf16;
typedef unsigned v4u __attribute__((ext_vector_type(4)));
typedef unsigned v2u __attribute__((ext_vector_type(2)));
typedef float f32x4 __attribute__((ext_vector_type(4)));
typedef float f32x16 __attribute__((ext_vector_type(16)));
typedef short bf16x8 __attribute__((ext_vector_type(8)));
typedef GAS unsigned gu32;
#define RLX_AGENT __ATOMIC_RELAXED, __HIP_MEMORY_SCOPE_AGENT
#define LDS_WAIT() asm volatile("s_waitcnt lgkmcnt(0)" ::: "memory")
#define VM_WAIT() asm volatile("s_waitcnt vmcnt(0)" ::: "memory")
#define RAW_BAR() __builtin_amdgcn_s_barrier()
__device__ __forceinline__ unsigned f2bf(float f) { unsigned u = __builtin_bit_cast(unsigned, f); return (u + 0x7fffu + ((u >> 16) & 1u)) >> 16; }
__device__ __forceinline__ unsigned pk2(float lo, float hi) { return f2bf(lo) | (f2bf(hi) << 16); }
__device__ __forceinline__ float bf2f(unsigned short b) { return __builtin_bit_cast(float, (unsigned)b << 16); }
__device__ __forceinline__ float wave_sum(float v) {
#pragma unroll
    for (int o = 1; o < 64; o <<= 1) v += __shfl_xor(v, o);
    return v;
}

#define XB_TMO      128
#define XB_XCNT(j)  (256  + 64 * (j))
#define XB_XSUB(j)  (1280 + 64 * (j))
#define XB_XGEN(j)  (2304 + 64 * (j))
#define XB_TOP      3328
#define XB_TOPGEN   3392
#define XCD_BAR_WORDS 3456
#define XB_SPIN_CAP (1u << 18)

__device__ __forceinline__ unsigned xb_ld(unsigned* p)              { return __hip_atomic_load(p, __ATOMIC_RELAXED, __HIP_MEMORY_SCOPE_AGENT); }
__device__ __forceinline__ unsigned xb_add(unsigned* p, unsigned v) { return __hip_atomic_fetch_add(p, v, __ATOMIC_RELAXED, __HIP_MEMORY_SCOPE_AGENT); }
__device__ __forceinline__ unsigned xb_xcc_id() { return (unsigned)__builtin_amdgcn_s_getreg((3 << 11) | 20) & 0xFu; }
#define XB_SPIN(cond, bar) do { unsigned _sp = 0; while (cond) { __builtin_amdgcn_s_sleep(1); \
    if ((++_sp & 255u) == 0u) { if (xb_ld(&(bar)[XB_TMO])) break; if (_sp > XB_SPIN_CAP) { atomicAdd(&(bar)[XB_TMO], 1u); break; } } } } while (0)

struct XcdBarrier {
    unsigned* bar; unsigned x;
    volatile LAS unsigned* st;
};

__device__ __forceinline__ XcdBarrier xcd_barrier_post(unsigned* bar, volatile LAS unsigned* st) {
    XcdBarrier b; b.bar = bar; b.x = xb_xcc_id(); b.st = st;
    if (threadIdx.x == 0) (void)xb_add(&bar[XB_XCNT(b.x)], 1u);
    return b;
}
__device__ __forceinline__ void xcd_barrier_complete(unsigned* bar, unsigned x, unsigned& nloc, unsigned& nx) {
    const unsigned G = gridDim.x * gridDim.y * gridDim.z;
    unsigned sum, cnt, mine, sp = 0u;
    for (;;) {
        sum = 0u; cnt = 0u; mine = 0u;
#pragma unroll
        for (unsigned j = 0; j < 16; ++j) { const unsigned c = xb_ld(&bar[XB_XCNT(j)]); sum += c; cnt += (c > 0u) ? 1u : 0u; mine = (j == x) ? c : mine; }
        if (sum == G) break;
        __builtin_amdgcn_s_sleep(1);
        if ((++sp & 255u) == 0u) { if (xb_ld(&bar[XB_TMO])) break; if (sp > XB_SPIN_CAP) { atomicAdd(&bar[XB_TMO], 1u); break; } }
    }
    nloc = mine > 0u ? mine : 1u; nx = cnt > 0u ? cnt : 1u;
}

__device__ __forceinline__ void xcd_barrier(const XcdBarrier& b) {
    asm volatile("s_waitcnt vmcnt(0)" ::: "memory");
    __syncthreads();
    if (threadIdx.x == 0) {
        unsigned* bar = b.bar;
        __builtin_amdgcn_s_waitcnt(0);
        unsigned nloc = b.st[0], nx = b.st[1];
        if (nloc == 0u) { xcd_barrier_complete(bar, b.x, nloc, nx); b.st[0] = nloc; b.st[1] = nx; }
        const unsigned old = xb_add(&bar[XB_XSUB(b.x)], 1u);
        const unsigned gen = old / nloc;
        if (old + 1u == (gen + 1u) * nloc) {
            __builtin_amdgcn_fence(__ATOMIC_RELEASE, "agent");
            asm volatile("s_waitcnt vmcnt(0)" ::: "memory");
            const unsigned og = xb_add(&bar[XB_TOP], 1u);
            const unsigned tg = og / nx;
            if (og + 1u == (tg + 1u) * nx) xb_add(&bar[XB_TOPGEN], 1u);
            else XB_SPIN(xb_ld(&bar[XB_TOPGEN]) == tg, bar);
            __builtin_amdgcn_fence(__ATOMIC_ACQUIRE, "agent");
            xb_add(&bar[XB_XGEN(b.x)], 1u);
            asm volatile("s_waitcnt vmcnt(0)" ::: "memory");
        } else {
            XB_SPIN(xb_ld(&bar[XB_XGEN(b.x)]) == gen, bar);
            __builtin_amdgcn_fence(__ATOMIC_ACQUIRE, "agent");
            asm volatile("s_waitcnt vmcnt(0)" ::: "memory");
        }
    }
    __syncthreads();
}

struct Args { const float* in[25]; float* out; unsigned char* ws; int ph_lo, ph_hi; };

namespace pg8 {
struct EpiProj {
    static constexpr bool PERM = true, AFTER_DRAIN = false;
    bf16_t *QB, *KP, *KS, *VTP, *VTS, *XR, *GG; float* out; const float* tab;
    __device__ __forceinline__ void operator()(const f32x4 (&acc)[2][2][4][2], const Unit& u, int wr, int wc, int fr, int fq) const {
        const int pn = u.pn; const bool prompt = u.pm < 64;
        const int rbase = u.pm * BM + wr * 64 + fr, cbase = wc * 32 + 8 * fq;
#pragma unroll
        for (int ai = 0; ai < 2; ++ai)
#pragma unroll
            for (int m = 0; m < 4; ++m) {
                const int r = rbase + ai * HALF + m * 16;
                f32x4 v[2][2];
#pragma unroll
                for (int bj = 0; bj < 2; ++bj)
#pragma unroll
                    for (int n = 0; n < 2; ++n) v[bj][n] = acc[ai][bj][m][n];
                if (pn < 12) {
                    if (wc == 0) {
                        const int pos = prompt ? (r & 4095) : (PAST + (r & 63));
                        const float* tc = tab + pos * 16 + 8 * (fq & 1);
#pragma unroll
                        for (int n = 0; n < 2; ++n) {
                            const f32x4 cs = *(const f32x4*)(tc + 4 * n), sn = *(const f32x4*)(tc + 65536 + 4 * n);
#pragma unroll
                            for (int bj = 0; bj < 2; ++bj) {
                                const f32x4 x = v[bj][n]; f32x4 p;
#pragma unroll
                                for (int i = 0; i < 4; ++i) p[i] = __shfl_xor(x[i], 32);
                                v[bj][n] = (fq < 2) ? (x * cs - p * sn) : (x * cs + p * sn);
                            }
                        }
                    }
                    if (pn < 8) {
                        bf16_t* dst = QB + (size_t)r * 2048 + pn * 256 + cbase;
#pragma unroll
                        for (int bj = 0; bj < 2; ++bj) { const f32x4 a = v[bj][0] * QSCALE, b = v[bj][1] * QSCALE; u32x4 w; w.x = cvt_pk_bf16(a[0], a[1]); w.y = cvt_pk_bf16(a[2], a[3]); w.z = cvt_pk_bf16(b[0], b[1]); w.w = cvt_pk_bf16(b[2], b[3]);
                            *(u32x4*)(dst + bj * HALF) = w; }
                    } else {
                        const int kvh = pn - 8;
                        float* fo = out + (prompt ? (O_KP + (size_t)r * 1024) : (O_KS + (size_t)(r - MP) * 1024)) + kvh * 256 + cbase;
                        bf16_t* dst = (prompt ? (KP + (size_t)r * 1024) : (KS + ((size_t)((r - MP) >> 6) * TKS + PAST + (r & 63)) * 1024)) + kvh * 256 + cbase;
#pragma unroll
                        for (int bj = 0; bj < 2; ++bj) { const f32x4 a = v[bj][0], b = v[bj][1]; *(f32x4*)(fo + bj * HALF) = a; *(f32x4*)(fo + bj * HALF + 4) = b;
                            u32x4 w; w.x = cvt_pk_bf16(a[0], a[1]); w.y = cvt_pk_bf16(a[2], a[3]); w.z = cvt_pk_bf16(b[0], b[1]); w.w = cvt_pk_bf16(b[2], b[3]); *(u32x4*)(dst + bj * HALF) = w; }
                    }
                } else if (pn < 16) {
                    const int kvh = pn - 12;
                    float* fo = out + (prompt ? (O_VP + (size_t)r * 1024) : (O_VS + (size_t)(r - MP) * 1024)) + kvh * 256 + cbase;
                    bf16_t* vt; size_t ldv;
                    if (prompt) { vt = VTP + ((size_t)((r >> 12) * 4 + kvh) * 256) * TP + (r & 4095); ldv = TP; }
                    else { vt = VTS + ((size_t)(((r - MP) >> 6) * 4 + kvh) * 256) * TKS + PAST + (r & 63); ldv = TKS; }
#pragma unroll
                    for (int bj = 0; bj < 2; ++bj) { const f32x4 a = v[bj][0], b = v[bj][1]; *(f32x4*)(fo + bj * HALF) = a; *(f32x4*)(fo + bj * HALF + 4) = b;
                        bf16_t* vp = vt + (size_t)(bj * HALF + cbase) * ldv;
#pragma unroll
                        for (int i = 0; i < 4; ++i) { vp[(size_t)i * ldv] = (bf16_t)f2bf(a[i]); vp[(size_t)(4 + i) * ldv] = (bf16_t)f2bf(b[i]); } }
                } else if (pn < 24) {
                    bf16_t* dst = XR + (size_t)r * 2048 + (pn - 16) * 256 + cbase;
#pragma unroll
                    for (int bj = 0; bj < 2; ++bj) { const f32x4 a = v[bj][0], b = v[bj][1]; u32x4 w; w.x = cvt_pk_bf16(a[0], a[1]); w.y = cvt_pk_bf16(a[2], a[3]); w.z = cvt_pk_bf16(b[0], b[1]); w.w = cvt_pk_bf16(b[2], b[3]);
                        *(u32x4*)(dst + bj * HALF) = w; }
                } else {
                    bf16_t* dst = GG + (size_t)r * 2048 + (pn - 24) * 256 + cbase;
#pragma unroll
                    for (int bj = 0; bj < 2; ++bj) { f32x4 a = v[bj][0], b = v[bj][1];
#pragma unroll
                        for (int i = 0; i < 4; ++i) { { const float x = a[i], y = 1.5957691216f * (x + 0.044715f * x * x * x); a[i] = x / (1.0f + __expf(-y)); }
                                                      { const float x = b[i], y = 1.5957691216f * (x + 0.044715f * x * x * x); b[i] = x / (1.0f + __expf(-y)); } }
                        u32x4 w; w.x = cvt_pk_bf16(a[0], a[1]); w.y = cvt_pk_bf16(a[2], a[3]); w.z = cvt_pk_bf16(b[0], b[1]); w.w = cvt_pk_bf16(b[2], b[3]); *(u32x4*)(dst + bj * HALF) = w; }
                }
            }
    }
};
struct EpiRes1 {
    static constexpr bool PERM = true, AFTER_DRAIN = false;
    const float *xp, *xs; float* hout; bf16_t* HN; float* rss;
    __device__ __forceinline__ void operator()(const f32x4 (&acc)[2][2][4][2], const Unit& u, int wr, int wc, int fr, int fq) const {
        const int rbase = u.pm * BM + wr * 64 + fr, col0 = u.pn * BM + wc * 32 + 8 * fq; const bool prompt = u.pm < 64;
#pragma unroll
        for (int ai = 0; ai < 2; ++ai)
#pragma unroll
            for (int m = 0; m < 4; ++m) {
                const int r = rbase + ai * HALF + m * 16;
                const float* xr = (prompt ? xp + (size_t)r * D : xs + (size_t)(r - MP) * D) + col0;
                float* ho = hout + (size_t)r * D + col0; bf16_t* hb = HN + (size_t)r * D + col0; float ss = 0.f;
#pragma unroll
                for (int bj = 0; bj < 2; ++bj) { const f32x4 a = acc[ai][bj][m][0] + *(const f32x4*)(xr + bj * HALF), b = acc[ai][bj][m][1] + *(const f32x4*)(xr + bj * HALF + 4);
                    *(f32x4*)(ho + bj * HALF) = a; *(f32x4*)(ho + bj * HALF + 4) = b;
                    ss += (a[0] * a[0] + a[1] * a[1]) + (a[2] * a[2] + a[3] * a[3]) + (b[0] * b[0] + b[1] * b[1]) + (b[2] * b[2] + b[3] * b[3]);
                    u32x4 w; w.x = cvt_pk_bf16(a[0], a[1]); w.y = cvt_pk_bf16(a[2], a[3]); w.z = cvt_pk_bf16(b[0], b[1]); w.w = cvt_pk_bf16(b[2], b[3]); *(u32x4*)(hb + bj * HALF) = w; }
                ss += __shfl_xor(ss, 16); ss += __shfl_xor(ss, 32);
                if (fq == 0) atomicAdd(rss + r, ss);
            }
    }
};
struct EpiUp {
    static constexpr bool PERM = true, AFTER_DRAIN = false;
    bf16_t* Z; const float* rss;
    __device__ __forceinline__ void operator()(const f32x4 (&acc)[2][2][4][2], const Unit& u, int wr, int wc, int fr, int fq) const {
        const int rbase = u.pm * BM + wr * 64 + fr, col0 = u.pn * BM + wc * 32 + 8 * fq;
#pragma unroll
        for (int ai = 0; ai < 2; ++ai)
#pragma unroll
            for (int m = 0; m < 4; ++m) {
                const int r = rbase + ai * HALF + m * 16;
                const float sc = 1.0f / sqrtf(rss[r] * (1.0f / D) + EPS);
                bf16_t* dst = Z + (size_t)r * DFF + col0;
#pragma unroll
                for (int bj = 0; bj < 2; ++bj) { f32x4 a = acc[ai][bj][m][0], b = acc[ai][bj][m][1];
#pragma unroll
                    for (int i = 0; i < 4; ++i) { const float x = fmaxf(a[i], 0.f) * sc, y = fmaxf(b[i], 0.f) * sc; a[i] = x * x; b[i] = y * y; }
                    u32x4 w; w.x = cvt_pk_bf16(a[0], a[1]); w.y = cvt_pk_bf16(a[2], a[3]); w.z = cvt_pk_bf16(b[0], b[1]); w.w = cvt_pk_bf16(b[2], b[3]); *(u32x4*)(dst + bj * HALF) = w; }
            }
    }
};
struct EpiDown {
    static constexpr bool PERM = true, AFTER_DRAIN = false;
    float* h; float* rss;
    __device__ __forceinline__ void operator()(const f32x4 (&acc)[2][2][4][2], const Unit& u, int wr, int wc, int fr, int fq) const {
        const int rbase = u.pm * BM + wr * 64 + fr, col0 = u.pn * BM + wc * 32 + 8 * fq;
#pragma unroll
        for (int ai = 0; ai < 2; ++ai)
#pragma unroll
            for (int m = 0; m < 4; ++m) {
                const int r = rbase + ai * HALF + m * 16;
                float* ho = h + (size_t)r * D + col0; float ss = 0.f;
#pragma unroll
                for (int bj = 0; bj < 2; ++bj) { const f32x4 a = acc[ai][bj][m][0] + *(const f32x4*)(ho + bj * HALF), b = acc[ai][bj][m][1] + *(const f32x4*)(ho + bj * HALF + 4);
                    *(f32x4*)(ho + bj * HALF) = a; *(f32x4*)(ho + bj * HALF + 4) = b;
                    ss += (a[0] * a[0] + a[1] * a[1]) + (a[2] * a[2] + a[3] * a[3]) + (b[0] * b[0] + b[1] * b[1]) + (b[2] * b[2] + b[3] * b[3]); }
                ss += __shfl_xor(ss, 16); ss += __shfl_xor(ss, 32);
                if (fq == 0) atomicAdd(rss + r, ss);
            }
    }
};
}

__device__ __forceinline__ void tr_item(const float* W, int ldw, bf16* WT, size_t ldt, LAS float* scr, int k0, int n0, int lane, const float* kscale) {
#pragma unroll 8
    for (int i = 0; i < 32; ++i) { const int kk = 2 * i + (lane >> 5); float v = W[(size_t)(k0 + kk) * ldw + n0 + (lane & 31)]; if (kscale) v *= kscale[k0 + kk]; scr[kk * 33 + (lane & 31)] = v; }
    LDS_WAIT(); asm volatile("" ::: "memory");
    const int c = lane & 7;
#pragma unroll
    for (int j = 0; j < 4; ++j) { const int n = (lane >> 3) + 8 * j; const LAS float* s = scr + (8 * c) * 33 + n;
        v4u o; o.x = pk2(s[0 * 33], s[1 * 33]); o.y = pk2(s[2 * 33], s[3 * 33]); o.z = pk2(s[4 * 33], s[5 * 33]); o.w = pk2(s[6 * 33], s[7 * 33]);
        *(GAS v4u*)(WT + (size_t)(n0 + n) * ldt + k0 + 8 * c) = o; }
    LDS_WAIT(); asm volatile("" ::: "memory");
}
__device__ __forceinline__ void tr_matrix_item(const float* W, int K, int N, int ldw, bf16* WT, size_t ldt, LAS float* scr, int item, int lane, const float* kscale) {
    const int nblk = N / 32, kb = item / nblk, nb = item % nblk; (void)K;
    tr_item(W, ldw, WT, ldt, scr, 64 * kb, 32 * nb, lane, kscale);
}
__device__ __forceinline__ void rope_entry(int idx, float* tab) {
    const float invt[16] = {1.0f, 0.44036659598350525f, 0.1939227432012558f, 0.08539710193872452f, 0.03760603070259094f, 0.016560440883040428f, 0.007292664609849453f, 0.0032114461064338684f,
                            0.0014142135623842478f, 0.0006227724370546639f, 0.00027424818836152554f, 0.00012076973507646471f, 5.3182957344688475e-05f, 2.34199997066753e-05f, 1.0313385246263351e-05f, 4.541670477919979e-06f};
    const int pos = idx >> 4, j = idx & 15;
    float inv = invt[0];
#pragma unroll
    for (int k = 1; k < 16; ++k) inv = (j == k) ? invt[k] : inv;
    const float angf = (float)pos * inv;
    const double x = (double)angf, q = __builtin_rint(x * 0.63661977236758134308), r = __builtin_fma(-q, 1.57079632679489661923, x) - q * 6.123233995736766e-17, r2 = r * r;
    double s = r2 * (1.0 / 6227020800.0) - 1.0 / 39916800.0; s = s * r2 + 1.0 / 362880.0; s = s * r2 - 1.0 / 5040.0; s = s * r2 + 1.0 / 120.0; s = s * r2 - 1.0 / 6.0; s = s * r2 * r + r;
    double c = r2 * (1.0 / 87178291200.0) - 1.0 / 479001600.0; c = c * r2 + 1.0 / 3628800.0; c = c * r2 - 1.0 / 40320.0; c = c * r2 + 1.0 / 720.0; c = c * r2 - 1.0 / 24.0; c = c * r2 + 0.5; c = 1.0 - c * r2;
    const int qi = ((int)q) & 3;
    const double sn = (qi == 0) ? s : (qi == 1) ? c : (qi == 2) ? -s : -c, cs = (qi == 0) ? c : (qi == 1) ? -s : (qi == 2) ? -c : s;
    tab[idx] = (float)cs; tab[65536 + idx] = (float)sn;
}

namespace att {
#ifndef ATT_SCHED_BETA
#define ATT_SCHED_BETA
#endif
constexpr int KT_BYTES = 32768, STAGE = 65536;
struct Unit { const bf16* Kb; const bf16* Vt; int ldv, ntiles, qrow0, kvh; };
__device__ __forceinline__ void attn_unit(LAS unsigned char* lds, const Unit& U, const bf16* QB, bf16* CAT, const float* subg, float lam) {
    const int tid = threadIdx.x, lane = tid & 63, wid = __builtin_amdgcn_readfirstlane(tid >> 6);
    const int g = wid >> 2, c = (wid >> 1) & 1, qs = wid & 1, ql = lane & 31, h = lane >> 5;
    const int qrow = U.qrow0 + qs * 32 + ql;
    bf16x8 qf[8];
    { const bf16* qp = QB + (size_t)qrow * 2048 + (U.kvh * 2 + g) * 256 + c * 128 + 8 * h;
#pragma unroll
      for (int ks = 0; ks < 8; ++ks) qf[ks] = *(const GAS bf16x8*)(qp + 16 * ks); }
    const int kr = tid >> 5, kcc = (tid & 31) ^ (kr & 15);
    const bf16* ksrc = U.Kb + (size_t)kr * 1024 + kcc * 8;
    const int ve = tid >> 3, vcc = (tid & 7) ^ ((ve >> 1) & 7);
    const bf16* vsrc = U.Vt + (size_t)ve * U.ldv + vcc * 8;
    const size_t vstep = (size_t)64 * U.ldv;
#define ATT_ISSUE(t, st) do { const bf16* kp_ = ksrc + (size_t)(t) * 65536; const bf16* vp_ = vsrc + (size_t)(t) * 64; \
        _Pragma("unroll") for (int j_ = 0; j_ < 4; ++j_) __builtin_amdgcn_global_load_lds((const unsigned*)(kp_ + (size_t)j_ * 16384), (LAS unsigned*)(lds + (st) * STAGE + wid * 1024 + j_ * 8192), 16, 0, 0); \
        _Pragma("unroll") for (int j_ = 0; j_ < 4; ++j_) __builtin_amdgcn_global_load_lds((const unsigned*)(vp_ + j_ * vstep), (LAS unsigned*)(lds + (st) * STAGE + KT_BYTES + wid * 1024 + j_ * 8192), 16, 0, 0); } while (0)
    const int kap = (ql & 0x13) | ((ql & 4) << 1) | ((ql & 8) >> 1);
    const int kbase = kap * 512 + c * 256, ky = 16 * ((kap & 15) ^ h);
    const int vbase = ql * 128, vy = 16 * (((ql >> 1) & 7) ^ h);
    f32x16 O[8];
#pragma unroll
    for (int e = 0; e < 8; ++e)
#pragma unroll
        for (int i = 0; i < 16; ++i) O[e][i] = 0.f;
    float mrun = -__builtin_inff(), lrun = 0.f;
    ATT_ISSUE(0, 0);
    VM_WAIT(); RAW_BAR();
    const int nt = U.ntiles;
    for (int t = 0; t < nt; ++t) {
        const int st = t & 1;
        if (t + 1 < nt) ATT_ISSUE(t + 1, st ^ 1);
        const LAS unsigned char* kt = lds + st * STAGE + kbase;
        const LAS unsigned char* vt = lds + st * STAGE + KT_BYTES + vbase;
#pragma unroll
        for (int beta = 0; beta < 2; ++beta) {
            f32x16 S;
#pragma unroll
            for (int i = 0; i < 16; ++i) S[i] = 0.f;
#pragma unroll
            for (int ks = 0; ks < 8; ++ks) { const bf16x8 kf = *(const LAS bf16x8*)(kt + beta * 16384 + ((32 * ks) ^ ky)); S = __builtin_amdgcn_mfma_f32_32x32x16_bf16(kf, qf[ks], S, 0, 0, 0); }
            float mx = S[0];
#pragma unroll
            for (int i = 1; i < 16; ++i) mx = fmaxf(mx, S[i]);
            mx = fmaxf(mx, __shfl_xor(mx, 32));
            if (__any(mx > mrun + 8.0f)) {
                const float mn = fmaxf(mrun, mx), al = __builtin_amdgcn_exp2f(mrun - mn); mrun = mn; lrun *= al;
#pragma unroll
                for (int e = 0; e < 8; ++e) O[e] = O[e] * al;
            }
            float ps = 0.f; unsigned pw[8];
#pragma unroll
            for (int i = 0; i < 16; i += 2) { const float p0 = __builtin_amdgcn_exp2f(S[i] - mrun), p1 = __builtin_amdgcn_exp2f(S[i + 1] - mrun); ps += p0 + p1; pw[i >> 1] = pk2(p0, p1); }
            lrun += ps;
            bf16x8 pb[2];
#pragma unroll
            for (int j = 0; j < 2; ++j) { v4u w; w.x = pw[4 * j]; w.y = pw[4 * j + 1]; w.z = pw[4 * j + 2]; w.w = pw[4 * j + 3]; pb[j] = __builtin_bit_cast(bf16x8, w); }
#pragma unroll
            for (int e = 0; e < 8; ++e)
#pragma unroll
                for (int j = 0; j < 2; ++j) { const bf16x8 vf = *(const LAS bf16x8*)(vt + e * 4096 + ((32 * (2 * beta + j)) ^ vy)); O[e] = __builtin_amdgcn_mfma_f32_32x32x16_bf16(vf, pb[j], O[e], 0, 0, 0); }
            ATT_SCHED_BETA;
        }
        VM_WAIT(); RAW_BAR();
    }
#undef ATT_ISSUE
    lrun += __shfl_xor(lrun, 32);
    const float inv = 1.0f / lrun;
    LAS float* X = (LAS float*)(lds + (g * 2 + qs) * 32768);
    if (c == 1) {
#pragma unroll
        for (int e = 0; e < 8; ++e)
#pragma unroll
            for (int i = 0; i < 16; ++i) X[(e * 16 + i) * 64 + lane] = O[e][i] * inv;
    }
    LDS_WAIT(); RAW_BAR();
    if (c == 0) {
        float ss = 0.f;
#pragma unroll
        for (int e = 0; e < 8; ++e) {
#pragma unroll
            for (int i = 0; i < 16; ++i) { const float o = O[e][i] * inv - lam * X[(e * 16 + i) * 64 + lane]; O[e][i] = o; ss += o * o; }
            asm volatile("" : "+v"(ss) :: "memory"); }
        ss += __shfl_xor(ss, 32);
        const float rs = (1.0f - LAM_INIT) / sqrtf(ss * (1.0f / 256.0f) + EPS);
        bf16* orow = CAT + (size_t)qrow * D + (U.kvh * 2 + g) * 256 + 4 * h;
#pragma unroll
        for (int e = 0; e < 8; ++e) {
#pragma unroll
            for (int i4 = 0; i4 < 4; ++i4) { const int e0 = 32 * e + 8 * i4; const f32x4 gv = *(const f32x4*)(subg + e0 + 4 * h);
                v2u w; w.x = pk2(O[e][4 * i4] * rs * gv[0], O[e][4 * i4 + 1] * rs * gv[1]); w.y = pk2(O[e][4 * i4 + 2] * rs * gv[2], O[e][4 * i4 + 3] * rs * gv[3]);
                *(GAS v2u*)(orow + e0) = w; }
            asm volatile("" ::: "memory"); }
    }
    LDS_WAIT(); RAW_BAR();
}
}

namespace lru {
constexpr int XP_OFF = 0, XC_OFF = 34816, XCB_OFF = 67584, CR_OFF = 84992, SEG_OFF = 88064, HC_OFF = 92160, XCB_PITCH = 272;
__device__ __forceinline__ float sigm(float x) { return 1.0f / (1.0f + expf(-x)); }
__device__ __forceinline__ void lru_unit(LAS unsigned char* lds, int row0, int T, int n, const float* cprev, const float* h0, float* conv_out, float* h_out,
                                         const bf16* XR, const bf16* GG, bf16* CAT, const bf16* GWT, const float* conv_w, const float* conv_b, const float* ga_b, const float* gx_b, const float* lam) {
    const int tid = threadIdx.x, lane = tid & 63, wid = __builtin_amdgcn_readfirstlane(tid >> 6);
    const int ch = tid & 127, rg = __builtin_amdgcn_readfirstlane(tid >> 7), gch = n * 128 + ch;
    LAS float* XP = (LAS float*)(lds + XP_OFF); LAS float* XC = (LAS float*)(lds + XC_OFF); LAS unsigned char* XCB = lds + XCB_OFF;
    LAS float* CR = (LAS float*)(lds + CR_OFF); LAS float* SEG = (LAS float*)(lds + SEG_OFF); LAS float* HC = (LAS float*)(lds + HC_OFF);
    const float w0 = conv_w[gch], w1 = conv_w[2048 + gch], w2 = conv_w[4096 + gch], w3 = conv_w[6144 + gch], cb = conv_b[gch];
    const int cha = 16 * wid + (lane & 15), g4 = lane >> 4;
    const float ba = ga_b[n * 128 + cha], bx = gx_b[n * 128 + cha], sp = log1pf(expf(-lam[n * 128 + cha]));
    bf16x8 bfr[2][4];
#pragma unroll
    for (int gt = 0; gt < 2; ++gt)
#pragma unroll
        for (int ks = 0; ks < 4; ++ks) bfr[gt][ks] = *(const GAS bf16x8*)(GWT + ((size_t)(n * 256 + gt * 128 + cha)) * 128 + 32 * ks + 8 * g4);
    if (rg == 0) HC[ch] = h0 ? h0[gch] : 0.f;
    if (tid < 384) CR[tid] = cprev ? cprev[(tid >> 7) * 2048 + gch] : 0.f;
    LDS_WAIT(); RAW_BAR();
    float hlast = 0.f;
    const int nch = T / 64;
    for (int cs = 0; cs < nch; ++cs) {
        const int t0 = row0 + cs * 64;
        if (tid < 384) XP[tid] = CR[(cs & 1) * 384 + tid];
#pragma unroll
        for (int jj = 0; jj < 2; ++jj) { const int q = tid + 512 * jj, r = q >> 4, k = q & 15;
            const v4u raw = *(const GAS v4u*)(XR + (size_t)(t0 + r) * 2048 + n * 128 + 8 * k);
            f32x4 a, b; a[0] = __builtin_bit_cast(float, raw.x << 16); a[1] = __builtin_bit_cast(float, raw.x & 0xffff0000u); a[2] = __builtin_bit_cast(float, raw.y << 16); a[3] = __builtin_bit_cast(float, raw.y & 0xffff0000u);
            b[0] = __builtin_bit_cast(float, raw.z << 16); b[1] = __builtin_bit_cast(float, raw.z & 0xffff0000u); b[2] = __builtin_bit_cast(float, raw.w << 16); b[3] = __builtin_bit_cast(float, raw.w & 0xffff0000u);
            *(LAS f32x4*)(XP + (3 + r) * 128 + 8 * k) = a; *(LAS f32x4*)(XP + (3 + r) * 128 + 8 * k + 4) = b;
            if (r >= 61) { LAS float* cr = CR + ((cs + 1) & 1) * 384 + (r - 61) * 128 + 8 * k; *(LAS f32x4*)cr = a; *(LAS f32x4*)(cr + 4) = b; } }
        LDS_WAIT(); RAW_BAR();
        { float a0 = XP[(16 * rg) * 128 + ch], a1 = XP[(16 * rg + 1) * 128 + ch], a2 = XP[(16 * rg + 2) * 128 + ch];
#pragma unroll
          for (int i = 0; i < 16; ++i) { const int r = 16 * rg + i; const float a3 = XP[(r + 3) * 128 + ch];
              float xc = cb + a0 * w0; xc += a1 * w1; xc += a2 * w2; xc += a3 * w3;
              XC[r * 128 + ch] = xc; *(LAS unsigned short*)(XCB + r * XCB_PITCH + 2 * ch) = (unsigned short)f2bf(xc); a0 = a1; a1 = a2; a2 = a3; } }
        LDS_WAIT(); RAW_BAR();
        pg8::f32x4 acc[4][2];
#pragma unroll
        for (int rb = 0; rb < 4; ++rb) { acc[rb][0] = (pg8::f32x4){0.f, 0.f, 0.f, 0.f}; acc[rb][1] = (pg8::f32x4){0.f, 0.f, 0.f, 0.f};
#pragma unroll
            for (int ks = 0; ks < 4; ++ks) { const bf16x8 af = *(const LAS bf16x8*)(XCB + (16 * rb + (lane & 15)) * XCB_PITCH + (32 * ks + 8 * g4) * 2);
                acc[rb][0] = __builtin_amdgcn_mfma_f32_16x16x32_bf16(af, bfr[0][ks], acc[rb][0], 0, 0, 0); acc[rb][1] = __builtin_amdgcn_mfma_f32_16x16x32_bf16(af, bfr[1][ks], acc[rb][1], 0, 0, 0); } }
#pragma unroll
        for (int rb = 0; rb < 4; ++rb)
#pragma unroll
            for (int i = 0; i < 4; ++i) { const int t = 16 * rb + 4 * g4 + i;
                const float r = sigm(acc[rb][0][i] + ba), ig = sigm(acc[rb][1][i] + bx), la = -8.0f * r * sp, a = expf(la), mult = sqrtf(-expm1f(2.0f * la));
                const float xc = XC[t * 128 + cha]; XP[t * 128 + cha] = a; XC[t * 128 + cha] = mult * (ig * xc); }
        LDS_WAIT(); RAW_BAR();
        { float H = 0.f, P = 1.f;
#pragma unroll
          for (int i = 0; i < 16; ++i) { const int r = 16 * rg + i; const float a = XP[r * 128 + ch], u = XC[r * 128 + ch]; H = a * H + u; P *= a; XC[r * 128 + ch] = H; XP[r * 128 + ch] = P; }
          SEG[(rg * 128 + ch) * 2] = P; SEG[(rg * 128 + ch) * 2 + 1] = H; }
        LDS_WAIT(); RAW_BAR();
        { float hin = HC[ch];
          for (int s = 0; s < rg; ++s) hin = SEG[(s * 128 + ch) * 2] * hin + SEG[(s * 128 + ch) * 2 + 1];
          const bf16* gp = GG + (size_t)(t0 + 16 * rg) * 2048 + n * 128 + ch; bf16* op = CAT + (size_t)(t0 + 16 * rg) * D + 2048 + n * 128 + ch;
          float hh = 0.f;
#pragma unroll
          for (int i = 0; i < 16; ++i) { const int r = 16 * rg + i; hh = XC[r * 128 + ch] + XP[r * 128 + ch] * hin; const float gv = bf2f(gp[(size_t)i * 2048]); op[(size_t)i * D] = (bf16)f2bf(hh * gv); }
          hlast = hh; }
        LDS_WAIT(); RAW_BAR();
        if (rg == 3) HC[ch] = hlast;
    }
    LDS_WAIT(); RAW_BAR();
    if (rg == 3) h_out[gch] = hlast;
    if (tid < 384) conv_out[(tid >> 7) * 2048 + gch] = CR[(nch & 1) * 384 + tid];
    LDS_WAIT(); RAW_BAR();
}
}

__global__ void __launch_bounds__(NWAVES * 64, 2) mega_fwd(Args args) {
    extern __shared__ __attribute__((aligned(16))) unsigned char lds_raw[];
    LAS unsigned char* lds = (LAS unsigned char*)lds_raw;
    volatile LAS unsigned* MISC = (volatile LAS unsigned*)(lds + MISC_OFF);
    const int tid = threadIdx.x, lane = tid & 63, wave = __builtin_amdgcn_readfirstlane(tid >> 6);
    const int G = gridDim.x, bx = blockIdx.x;
    const int vcu = (G % 8 == 0) ? (bx % 8) * (G / 8) + bx / 8 : bx;
    unsigned char* ws = args.ws;
    gu32* ctl = (gu32*)(ws + WS_CTL);
    float* out = args.out;
    const float* x_prompt = args.in[0]; const float* x_sample = args.in[1]; const float* cache_k = args.in[2]; const float* cache_v = args.in[3];
    const float* state_conv = args.in[4]; const float* state_lru = args.in[5]; const float* norm_mix = args.in[6]; const float* w_in = args.in[7];
    const float* conv_w = args.in[8]; const float* conv_b = args.in[9]; const float* gate_a_w = args.in[10]; const float* gate_a_b = args.in[11];
    const float* gate_x_w = args.in[12]; const float* gate_x_b = args.in[13]; const float* lru_lambda = args.in[14];
    const float* lq1 = args.in[15]; const float* lk1 = args.in[16]; const float* lq2 = args.in[17]; const float* lk2 = args.in[18]; const float* subln_g = args.in[19];
    const float* w_out = args.in[20]; const float* norm_mlp = args.in[21]; const float* w_up = args.in[22]; const float* w_down = args.in[23]; const float* norm_final = args.in[24];
    bf16* WIN = (bf16*)(ws + WS_WIN); bf16* WOUT = (bf16*)(ws + WS_WOUT); bf16* WUP = (bf16*)(ws + WS_WUP); bf16* WDN = (bf16*)(ws + WS_WDN);
    bf16* HN = (bf16*)(ws + WS_HN); bf16* Z = (bf16*)(ws + WS_Z); bf16* XN = (bf16*)(ws + WS_XN); bf16* CAT = XN; bf16* QB = (bf16*)(ws + WS_QB);
    bf16* KP = (bf16*)(ws + WS_KP); bf16* KS = (bf16*)(ws + WS_KS); bf16* VTP = (bf16*)(ws + WS_VTP); bf16* VTS = (bf16*)(ws + WS_VTS);
    bf16* XR = (bf16*)(ws + WS_XR); bf16* GG = (bf16*)(ws + WS_GG); bf16* GWT = (bf16*)(ws + WS_GWT); float* TAB = (float*)(ws + WS_TAB);
    float* RSS1 = (float*)(ws + WS_CTL) + CW_RSS1; float* RSS2 = (float*)(ws + WS_CTL) + CW_RSS2;

    for (int u = tid; u < (LDS_BYTES - LDSCTL_OFF) / 4; u += NWAVES * 64) ((LAS unsigned*)(lds + LDSCTL_OFF))[u] = 0u;
    __syncthreads();
    XcdBarrier bar; bar.bar = (unsigned*)(ctl + CW_BAR); bar.x = 0; bar.st = nullptr;
    if (N_LAUNCHES == 1) bar = xcd_barrier_post((unsigned*)(ctl + CW_BAR), MISC + 8);
#define GRID_BAR() do { if (N_LAUNCHES == 1) xcd_barrier(bar); } while (0)
    const int lo = args.ph_lo, hi = args.ph_hi;
#ifndef PH_MASK
#define PH_MASK 0x7f
#endif
#define IN(k) (((PH_MASK >> (k)) & 1) && lo <= (k) && (k) < hi)
#define BOTH(k) (IN(k) && IN((k) + 1))

    if (IN(0)) {
        LAS float* scr = (LAS float*)(lds + wave * 16384);
        const int gw = vcu * NWAVES + wave, NGW = G * NWAVES;
        constexpr int I_IN = 64 * 256, I_OUT = 64 * 128, I_UP = 64 * 512, I_DN = 256 * 128, I_CV = 128 * 256, I_GW = 32 * 8;
        constexpr int NITEMS = I_IN + I_OUT + I_UP + I_DN + I_CV + I_GW;
        for (int it = gw; it < NITEMS; it += NGW) {
            int r = it;
            if (r < I_IN) { tr_matrix_item(w_in, D, NIN, NIN, WIN, D, scr, r, lane, nullptr); continue; } r -= I_IN;
            if (r < I_OUT) { tr_matrix_item(w_out, D, D, D, WOUT, D, scr, r, lane, nullptr); continue; } r -= I_OUT;
            if (r < I_UP) { tr_matrix_item(w_up, D, DFF, DFF, WUP, D, scr, r, lane, norm_mlp); continue; } r -= I_UP;
            if (r < I_DN) { tr_matrix_item(w_down, DFF, D, D, WDN, DFF, scr, r, lane, nullptr); continue; } r -= I_DN;
            if (r < I_CV) { const int sl = r >> 8, sb = sl >> 2, kvh = sl & 3;
                tr_matrix_item(cache_v + (size_t)sb * PAST * 1024 + kvh * 256, PAST, 256, 1024, VTS + (size_t)sl * 256 * TKS, TKS, scr, r & 255, lane, nullptr); continue; } r -= I_CV;
            { const int gi = r >> 3, gt = gi >> 4, nb = gi & 15;
              tr_matrix_item((gt ? gate_x_w : gate_a_w) + (size_t)nb * 16384, 128, 128, 128, GWT + (size_t)(nb * 256 + gt * 128) * 128, 128, scr, r & 7, lane, nullptr); }
        }
        for (int m = gw; m < M; m += NGW) {
            const GAS f32x4* xr = (const GAS f32x4*)(m < MP ? x_prompt + (size_t)m * D : x_sample + (size_t)(m - MP) * D) + lane;
            f32x4 v[16]; float s = 0.f;
#pragma unroll
            for (int j = 0; j < 16; ++j) { v[j] = xr[64 * j]; s += (v[j][0] * v[j][0] + v[j][1] * v[j][1]) + (v[j][2] * v[j][2] + v[j][3] * v[j][3]); }
            const float rstd = 1.0f / sqrtf(wave_sum(s) * (1.0f / D) + EPS);
            GAS v2u* o8 = (GAS v2u*)(XN + (size_t)m * D) + lane;
#pragma unroll
            for (int j = 0; j < 16; ++j) { const f32x4 gv = ((const GAS f32x4*)norm_mix)[lane + 64 * j]; v2u w; w.x = pk2(v[j][0] * rstd * gv[0], v[j][1] * rstd * gv[1]); w.y = pk2(v[j][2] * rstd * gv[2], v[j][3] * rstd * gv[3]); o8[64 * j] = w; }
        }
        for (int rr = gw; rr < 32 * PAST; rr += NGW) {
            const int sb = rr >> 11, t = rr & 2047;
            const GAS f32x4* src = (const GAS f32x4*)(cache_k + (size_t)rr * 1024); GAS v4u* dst = (GAS v4u*)(KS + ((size_t)sb * TKS + t) * 1024);
#pragma unroll
            for (int j = 0; j < 2; ++j) { const f32x4 a = src[j * 128 + lane * 2], b = src[j * 128 + lane * 2 + 1]; v4u w; w.x = pk2(a[0], a[1]); w.y = pk2(a[2], a[3]); w.z = pk2(b[0], b[1]); w.w = pk2(b[2], b[3]); dst[j * 64 + lane] = w; }
        }
        for (int jb = gw; jb < 1024; jb += NGW) rope_entry(jb * 64 + lane, TAB);
        if (BOTH(0)) GRID_BAR();
    }

    if (IN(1)) {
        pg8::Gemm g{XN, WIN, M, NIN, D}; pg8::StaticOrder S; S.init(M, NIN, G, bx);
        pg8::EpiProj E{QB, KP, KS, VTP, VTS, XR, GG, out, TAB};
        pg8::gemm_phase<pg8::EpiProj, pg8::StaticOrder, PG8_ALIGN, PG8_SP2>(lds, g, S, E);
        if (BOTH(1)) GRID_BAR();
    }

    if (IN(2)) {
#ifndef P2_NO_LRU
        for (int u = bx; u < 64 + 512; u += G) {
            if (u < 64) { const int b = u >> 4, n = u & 15;
                lru::lru_unit(lds, b * TP, TP, n, nullptr, nullptr, out + O_CP + (size_t)b * 3 * LW, out + O_LP + (size_t)b * LW, XR, GG, CAT, GWT, conv_w, conv_b, gate_a_b, gate_x_b, lru_lambda);
            } else { const int v = u - 64, sb = v >> 4, n = v & 15;
                lru::lru_unit(lds, MP + sb * TS, TS, n, state_conv + (size_t)sb * 3 * LW, state_lru + (size_t)sb * LW, out + O_CS + (size_t)sb * 3 * LW, out + O_LS + (size_t)sb * LW, XR, GG, CAT, GWT, conv_w, conv_b, gate_a_b, gate_x_b, lru_lambda);
            }
        }
#endif
#ifndef P2_NO_ATT
        float lam;
        { const float d1 = wave_sum(lq1[lane] * lk1[lane] + lq1[lane + 64] * lk1[lane + 64]), d2 = wave_sum(lq2[lane] * lk2[lane] + lq2[lane + 64] * lk2[lane + 64]); lam = expf(d1) - expf(d2) + LAM_INIT; }
        for (;;) {
            if (tid == 0) MISC[16] = __hip_atomic_fetch_add((unsigned*)(ctl + CW_QCTR), 1u, RLX_AGENT);
            LDS_WAIT(); RAW_BAR();
            const int idx = (int)MISC[16];
            LDS_WAIT(); RAW_BAR();
            if (idx >= 1152) break;
            att::Unit U;
            int pu = -1, su = -1;
            if (idx < 496) pu = idx; else if (idx < 624) su = idx - 496; else pu = idx - 128;
            if (su >= 0) { const int sb = su >> 2, kvh = su & 3; U.Kb = KS + (size_t)sb * TKS * 1024 + kvh * 256; U.Vt = VTS + (size_t)(sb * 4 + kvh) * 256 * TKS; U.ldv = TKS; U.ntiles = TKS / 64; U.qrow0 = MP + sb * TS; U.kvh = kvh; }
            else { const int qc = 63 - (pu >> 4), bk = pu & 15, b = bk >> 2, kvh = bk & 3; U.Kb = KP + (size_t)b * TP * 1024 + kvh * 256; U.Vt = VTP + (size_t)(b * 4 + kvh) * 256 * TP; U.ldv = TP; U.ntiles = qc + 1; U.qrow0 = b * TP + qc * 64; U.kvh = kvh; }
            att::attn_unit(lds, U, QB, CAT, subln_g, lam);
        }
#endif
        if (BOTH(2)) GRID_BAR();
    }

    if (IN(3)) {
        pg8::Gemm g{CAT, WOUT, M, D, D}; pg8::StaticOrder S; S.init(M, D, G, bx);
        pg8::EpiRes1 E{x_prompt, x_sample, out + O_Y, HN, RSS1};
        pg8::gemm_phase<pg8::EpiRes1, pg8::StaticOrder, PG8_ALIGN, PG8_SP2>(lds, g, S, E);
        if (BOTH(3)) GRID_BAR();
    }

    if (IN(4)) {
        pg8::Gemm g{HN, WUP, M, DFF, D}; pg8::StaticOrder S; S.init(M, DFF, G, bx);
        pg8::EpiUp E{Z, RSS1};
        pg8::gemm_phase<pg8::EpiUp, pg8::StaticOrder, PG8_ALIGN, PG8_SP2>(lds, g, S, E);
        if (BOTH(4)) GRID_BAR();
    }

    if (IN(5)) {
        pg8::Gemm g{Z, WDN, M, D, DFF}; pg8::StaticOrder S; S.init(M, D, G, bx);
        pg8::EpiDown E{out + O_Y, RSS2};
        pg8::gemm_phase<pg8::EpiDown, pg8::StaticOrder, PG8_ALIGN, PG8_SP2>(lds, g, S, E);
        if (BOTH(5)) GRID_BAR();
    }

    if (IN(6)) {
        const int gw = vcu * NWAVES + wave, NGW = G * NWAVES;
        for (int m = gw; m < M; m += NGW) {
            GAS f32x4* yr = (GAS f32x4*)(out + O_Y + (size_t)m * D) + lane;
            const float rstd = 1.0f / sqrtf(RSS2[m] * (1.0f / D) + EPS);
#pragma unroll
            for (int j = 0; j < 16; ++j) { const f32x4 gv = ((const GAS f32x4*)norm_final)[lane + 64 * j]; yr[64 * j] = yr[64 * j] * rstd * gv; }
        }
    }
#undef IN
#undef BOTH
#undef GRID_BAR
}

extern "C" void kernel_launch(void* const* d_in, const int* in_sizes, int n_in, void* d_out, int out_size, void* d_ws, size_t ws_size, hipStream_t stream) {
    static int grid = 0;
    if (grid == 0) {
        if (n_in != 25 || in_sizes[0] != MP * D || (size_t)out_size != O_END || ws_size < WS_END) { fprintf(stderr, "kernel_launch: unexpected shapes (n_in %d, in0 %d, out %d, ws %zu); nothing launched\n", n_in, n_in > 0 ? in_sizes[0] : -1, out_size, ws_size); grid = -1; return; }
        int dev = 0, cus = 0, per_cu = 0;
        if (hipGetDevice(&dev) != hipSuccess || hipDeviceGetAttribute(&cus, hipDeviceAttributeMultiprocessorCount, dev) != hipSuccess) { grid = -1; return; }
        if (hipFuncSetAttribute((const void*)mega_fwd, hipFuncAttributeMaxDynamicSharedMemorySize, LDS_BYTES) != hipSuccess) { fprintf(stderr, "kernel_launch: hipFuncSetAttribute failed\n"); grid = -1; return; }
        if (hipOccupancyMaxActiveBlocksPerMultiprocessor(&per_cu, (const void*)mega_fwd, NWAVES * 64, LDS_BYTES) != hipSuccess || per_cu < 1) { fprintf(stderr, "kernel_launch: occupancy query reports %d workgroups per CU\n", per_cu); }
        (void)hipGetLastError();
        grid = cus;
    }
    if (grid < 0) return;
    if (hipMemsetAsync((char*)d_ws + WS_CTL, 0, CTL_ZERO_BYTES, stream) != hipSuccess) return;
    Args a{};
    for (int i = 0; i < 25; ++i) a.in[i] = (const float*)d_in[i];
    a.out = (float*)d_out; a.ws = (unsigned char*)d_ws;
    for (int li = 0; li < N_LAUNCHES; ++li) {
        a.ph_lo = (N_LAUNCHES == 1) ? 0 : li; a.ph_hi = (N_LAUNCHES == 1) ? N_PHASES : li + 1;
        hipLaunchKernelGGL(mega_fwd, dim3(grid), dim3(NWAVES * 64), LDS_BYTES, stream, a);
        const hipError_t le = hipPeekAtLastError();
        if (le != hipSuccess) { fprintf(stderr, "kernel_launch: launch %d failed: %s\n", li, hipGetErrorName(le)); break; }
    }
}
```

```cpp
#include <hip/hip_runtime.h>
#include <cstdio>
#include <cstdint>
#ifndef PG8_WGM_XCD
#define PG8_WGM_XCD 1
#endif
#ifndef PG8_SUB9
#define PG8_SUB9 9
#endif
#ifndef PG8_SUB8
#define PG8_SUB8 8
#endif
namespace pg8 {
#define PG8_LAS __attribute__((address_space(3)))
typedef unsigned short bf16_t;
typedef short bf16x8 __attribute__((ext_vector_type(8)));
typedef float f32x4 __attribute__((ext_vector_type(4)));
typedef unsigned u32x4 __attribute__((ext_vector_type(4)));
constexpr int BM = 256, BK = 64, HALF = 128, HTB = HALF * BK * 2  , STAGE_BYTES = 8 * HTB, NXCD = 8, WGM = 8;

__host__ __device__ __forceinline__ int lds_byte(int r, int c) { const int st = (r >> 4) * 2 + (c >> 5), rr = r & 15, cc = c & 31, ob = rr * 64 + cc * 2; return st * 1024 + (ob ^ (((ob >> 9) & 1) << 5)); }
__host__ __device__ __forceinline__ void stage_rc(int b, int& R, int& C) { const int st = b / 1024, sb = b % 1024, swz = sb ^ (((sb >> 9) & 1) << 5); R = (st >> 1) * 16 + swz / 64; C = (st & 1) * 32 + (swz % 64) / 2; }
__host__ __device__ __forceinline__ int perm32(int rho) { const int n = rho >> 4, i = rho & 15; return 8 * (i >> 2) + 4 * n + (i & 3); }

struct Unit { int pm, pn; };
struct Gemm { const bf16_t* A; const bf16_t* Bt; int M, N, K, ld; };

struct StaticOrder {
    int nM, nN, nwg, G, c, wgm;
    __host__ __device__ void init(int M, int N, int G_, int c_) { nM = M / BM; nN = N / BM; nwg = nM * nN; G = G_; c = c_; wgm = (PG8_WGM_XCD && nM % NXCD == 0) ? nM / NXCD : WGM; if (PG8_WGM_XCD && nM % NXCD == 0 && nM / NXCD == 9) wgm = PG8_SUB9; if (PG8_WGM_XCD && nM % NXCD == 0 && nM / NXCD == 8) wgm = PG8_SUB8; }
    __host__ __device__ bool next(int i, Unit& u) const {
        const long L = (long)i * G + c; if (L >= nwg) return false;
        int wgid = (int)L; { const int q = nwg / NXCD, r = nwg % NXCD, xcd = wgid % NXCD, off = wgid / NXCD; wgid = (xcd < r ? xcd * (q + 1) : r * (q + 1) + (xcd - r) * q) + off; }
        const int nig = wgm * nN, gid = wgid / nig, fm = gid * wgm, gsz = (nM - fm) < wgm ? (nM - fm) : wgm;
        u.pm = fm + ((wgid % nig) % gsz); u.pn = (wgid % nig) / gsz; return true;
    }
    __device__ __forceinline__ void a_ready(const Unit&) const {}
    __device__ __forceinline__ void done(const Unit&) const {}
};

__device__ __forceinline__ unsigned cvt_pk_bf16(float lo, float hi) { unsigned r; asm volatile("v_cvt_pk_bf16_f32 %0, %1, %2" : "=v"(r) : "v"(lo), "v"(hi)); return r; }
typedef float f32x2 __attribute__((ext_vector_type(2)));
template <class Epi, class Sched, bool ALIGN_EPI = false, bool SP2 = false>
__device__ __forceinline__ void gemm_phase(PG8_LAS unsigned char* lds, const Gemm g, const Sched& S, const Epi& E) {
    const int tid = threadIdx.x, wid = __builtin_amdgcn_readfirstlane(tid >> 6), lane = tid & 63, wr = wid >> 2, wc = wid & 3, fr = lane & 15, fq = lane >> 4;
    const int K = g.ld, nt = g.K / BK;
    unsigned voffA[2], voffB[2];
#pragma unroll
    for (int i = 0; i < 2; ++i) { int R, C; stage_rc(tid * 16 + i * 8192, R, C); const int Rb = Epi::PERM ? ((R & ~31) + perm32(R & 31)) : R;
        voffA[i] = (unsigned)(R * K + C) * 2u; voffB[i] = (unsigned)(Rb * K + C) * 2u; }
    const size_t kstep = (size_t)(BK * 2);
    const size_t hstep = (size_t)HALF * K * 2;
    const size_t tstep = 2 * hstep;
    const unsigned ldsw = (unsigned)wid * 1024u;
    const int aoff = lds_byte(wr * 64 + fr, fq * 8), boff = lds_byte(wc * 32 + fr, fq * 8);
#define PG8_SA(b, h) (((b) * 2 + (h)) * HTB)
#define PG8_SB(b, h) ((4 + (b) * 2 + (h)) * HTB)
#define PG8_STAGE(bufoff, gbase, voff) do { _Pragma("unroll") for (int _i = 0; _i < 2; ++_i) \
        __builtin_amdgcn_global_load_lds((const unsigned*)((const char*)(gbase) + (voff)[_i]), (PG8_LAS unsigned*)(lds + (bufoff) + ldsw + _i * 8192), 16, 0, 0); } while (0)
#define PG8_LDA(dst, b, h) do { _Pragma("unroll") for (int m = 0; m < 4; ++m) _Pragma("unroll") for (int k = 0; k < 2; ++k) dst[m][k] = *(const PG8_LAS bf16x8*)(lds + PG8_SA(b, h) + aoff + m * 2048 + k * 1024); } while (0)
#define PG8_LDB(dst, b, h) do { _Pragma("unroll") for (int n = 0; n < 2; ++n) _Pragma("unroll") for (int k = 0; k < 2; ++k) dst[n][k] = *(const PG8_LAS bf16x8*)(lds + PG8_SB(b, h) + boff + n * 2048 + k * 1024); } while (0)
#ifndef PG8_MMA_ORDER
#define PG8_MMA_ORDER 0
#endif
#if PG8_MMA_ORDER == 0
#define PG8_MMA(ai, bj, At, Bt) do { __builtin_amdgcn_s_setprio(1); _Pragma("unroll") for (int m = 0; m < 4; ++m) _Pragma("unroll") for (int n = 0; n < 2; ++n) _Pragma("unroll") for (int k = 0; k < 2; ++k) \
        acc[ai][bj][m][n] = __builtin_amdgcn_mfma_f32_16x16x32_bf16(Bt[n][k], At[m][k], acc[ai][bj][m][n], 0, 0, 0); __builtin_amdgcn_s_setprio(0); } while (0)
#elif PG8_MMA_ORDER == 1
#define PG8_MMA(ai, bj, At, Bt) do { __builtin_amdgcn_s_setprio(1); _Pragma("unroll") for (int k = 0; k < 2; ++k) _Pragma("unroll") for (int n = 0; n < 2; ++n) _Pragma("unroll") for (int m = 0; m < 4; ++m) \
        acc[ai][bj][m][n] = __builtin_amdgcn_mfma_f32_16x16x32_bf16(Bt[n][k], At[m][k], acc[ai][bj][m][n], 0, 0, 0); __builtin_amdgcn_s_setprio(0); } while (0)
#elif PG8_MMA_ORDER == 3
#define PG8_MMA(ai, bj, At, Bt) do { __builtin_amdgcn_s_setprio(1); _Pragma("unroll") for (int n = 0; n < 2; ++n) _Pragma("unroll") for (int m = 0; m < 4; ++m) _Pragma("unroll") for (int k = 0; k < 2; ++k) \
        acc[ai][bj][m][n] = __builtin_amdgcn_mfma_f32_16x16x32_bf16(Bt[n][k], At[m][k], acc[ai][bj][m][n], 0, 0, 0); __builtin_amdgcn_s_setprio(0); } while (0)
#elif PG8_MMA_ORDER == 4
#define PG8_MMA(ai, bj, At, Bt) do { _Pragma("unroll") for (int m = 0; m < 4; ++m) _Pragma("unroll") for (int n = 0; n < 2; ++n) _Pragma("unroll") for (int k = 0; k < 2; ++k) \
        acc[ai][bj][m][n] = __builtin_amdgcn_mfma_f32_16x16x32_bf16(Bt[n][k], At[m][k], acc[ai][bj][m][n], 0, 0, 0); } while (0)
#else
#define PG8_MMA(ai, bj, At, Bt) do { __builtin_amdgcn_s_setprio(1); _Pragma("unroll") for (int k = 0; k < 2; ++k) _Pragma("unroll") for (int m = 0; m < 4; ++m) _Pragma("unroll") for (int n = 0; n < 2; ++n) \
        acc[ai][bj][m][n] = __builtin_amdgcn_mfma_f32_16x16x32_bf16(Bt[n][k], At[m][k], acc[ai][bj][m][n], 0, 0, 0); __builtin_amdgcn_s_setprio(0); } while (0)
#endif
#define PG8_WAIT_V(n) asm volatile("s_waitcnt vmcnt(" #n ")" ::: "memory")
#define PG8_WAIT_L(n) asm volatile("s_waitcnt lgkmcnt(" #n ")" ::: "memory")
#define PG8_BAR __builtin_amdgcn_s_barrier()
#define PG8_SCHED __builtin_amdgcn_sched_barrier(0)
    Unit cur, nxt; int ui = 0;
    if (!S.next(0, cur)) return;
    f32x4 acc[2][2][4][2];
#pragma unroll
    for (int a = 0; a < 2; ++a)
#pragma unroll
        for (int b = 0; b < 2; ++b)
#pragma unroll
            for (int m = 0; m < 4; ++m)
#pragma unroll
                for (int n = 0; n < 2; ++n) acc[a][b][m][n] = (f32x4){0.f, 0.f, 0.f, 0.f};
    bf16x8 At[4][2], B0[2][2], B1[2][2];
    const char* cA = (const char*)g.A + (size_t)cur.pm * tstep; const char* cB = (const char*)g.Bt + (size_t)cur.pn * tstep;
    S.a_ready(cur);
    if constexpr (SP2) {
        PG8_STAGE(PG8_SB(0, 0), cB, voffB); PG8_STAGE(PG8_SB(0, 1), cB + hstep, voffB); PG8_STAGE(PG8_SA(0, 0), cA, voffA); PG8_STAGE(PG8_SA(0, 1), cA + hstep, voffA);
        if (wr == 1) PG8_BAR;
        PG8_WAIT_V(2); PG8_BAR;
        PG8_STAGE(PG8_SB(1, 0), cB + kstep, voffB); PG8_STAGE(PG8_SA(1, 0), cA + kstep, voffA); PG8_STAGE(PG8_SB(1, 1), cB + hstep + kstep, voffB);
        PG8_WAIT_V(6); PG8_BAR;
    } else {
        PG8_STAGE(PG8_SB(0, 0), cB, voffB); PG8_STAGE(PG8_SA(0, 0), cA, voffA); PG8_STAGE(PG8_SB(0, 1), cB + hstep, voffB); PG8_STAGE(PG8_SA(0, 1), cA + hstep, voffA);
        if (wr == 1) PG8_BAR;
        PG8_WAIT_V(4); PG8_BAR;
        PG8_STAGE(PG8_SB(1, 0), cB + kstep, voffB); PG8_STAGE(PG8_SA(1, 0), cA + kstep, voffA); PG8_STAGE(PG8_SB(1, 1), cB + hstep + kstep, voffB);
        PG8_WAIT_V(6); PG8_BAR;
    }
    for (;;) {
        const bool has_next = S.next(ui + 1, nxt);
        const char* nA = has_next ? (const char*)g.A + (size_t)nxt.pm * tstep : cA; const char* nB = has_next ? (const char*)g.Bt + (size_t)nxt.pn * tstep : cB;
        for (int t = 0; t < nt; t += 2) {
            const bool last = (t == nt - 2);
            const char* a1 = cA + (size_t)(t + 1) * kstep;
            const char* a2 = last ? nA : cA + (size_t)(t + 2) * kstep; const char* b2 = last ? nB : cB + (size_t)(t + 2) * kstep;
            const char* a3 = a2 + kstep; const char* b3 = b2 + kstep;
            if (last && has_next) S.a_ready(nxt);
            if constexpr (SP2) {
            PG8_LDB(B0, 0, 0); PG8_LDB(B1, 0, 1); PG8_SCHED; PG8_LDA(At, 0, 0); PG8_STAGE(PG8_SA(1, 1), a1 + hstep, voffA);
            PG8_WAIT_V(8); PG8_WAIT_L(0); PG8_BAR; PG8_MMA(0, 0, At, B0); PG8_MMA(0, 1, At, B1); PG8_BAR; PG8_SCHED;
            PG8_LDA(At, 0, 1); PG8_STAGE(PG8_SB(0, 0), b2, voffB); PG8_STAGE(PG8_SB(0, 1), b2 + hstep, voffB); PG8_STAGE(PG8_SA(0, 0), a2, voffA);
            PG8_WAIT_V(8); PG8_WAIT_L(0); PG8_BAR; PG8_MMA(1, 0, At, B0); PG8_MMA(1, 1, At, B1); PG8_BAR; PG8_SCHED;
            PG8_LDB(B0, 1, 0); PG8_LDB(B1, 1, 1); PG8_SCHED; PG8_LDA(At, 1, 0); PG8_STAGE(PG8_SA(0, 1), a2 + hstep, voffA);
            PG8_WAIT_V(8); PG8_WAIT_L(0); PG8_BAR; PG8_MMA(0, 0, At, B0); PG8_MMA(0, 1, At, B1); PG8_BAR; PG8_SCHED;
            PG8_LDA(At, 1, 1); PG8_STAGE(PG8_SB(1, 0), b3, voffB); PG8_STAGE(PG8_SB(1, 1), b3 + hstep, voffB); PG8_STAGE(PG8_SA(1, 0), a3, voffA);
            PG8_WAIT_V(8); PG8_WAIT_L(0); PG8_BAR; PG8_MMA(1, 0, At, B0); PG8_MMA(1, 1, At, B1); PG8_BAR; PG8_SCHED;
            } else {
            PG8_LDB(B0, 0, 0); PG8_SCHED; PG8_LDA(At, 0, 0); PG8_STAGE(PG8_SA(1, 1), a1 + hstep, voffA);
            PG8_WAIT_L(8); PG8_BAR; PG8_WAIT_L(0); PG8_MMA(0, 0, At, B0); PG8_BAR; PG8_SCHED;
            PG8_LDB(B1, 0, 1); PG8_STAGE(PG8_SB(0, 0), b2, voffB);
            PG8_BAR; PG8_WAIT_L(0); PG8_MMA(0, 1, At, B1); PG8_BAR;
            PG8_LDA(At, 0, 1); PG8_STAGE(PG8_SA(0, 0), a2, voffA);
            PG8_BAR; PG8_WAIT_L(0); PG8_MMA(1, 0, At, B0); PG8_BAR; PG8_SCHED;
            PG8_STAGE(PG8_SB(0, 1), b2 + hstep, voffB);
            PG8_WAIT_V(6); PG8_BAR; PG8_MMA(1, 1, At, B1); PG8_BAR;
            PG8_LDB(B0, 1, 0); PG8_SCHED; PG8_LDA(At, 1, 0); PG8_STAGE(PG8_SA(0, 1), a2 + hstep, voffA);
            PG8_WAIT_L(8); PG8_BAR; PG8_WAIT_L(0); PG8_MMA(0, 0, At, B0); PG8_BAR; PG8_SCHED;
            PG8_LDB(B1, 1, 1); PG8_STAGE(PG8_SB(1, 0), b3, voffB);
            PG8_BAR; PG8_WAIT_L(0); PG8_MMA(0, 1, At, B1); PG8_BAR;
            PG8_LDA(At, 1, 1); PG8_STAGE(PG8_SA(1, 0), a3, voffA);
            PG8_BAR; PG8_WAIT_L(0); PG8_MMA(1, 0, At, B0); PG8_BAR; PG8_SCHED;
            PG8_STAGE(PG8_SB(1, 1), b3 + hstep, voffB);
            PG8_WAIT_V(6); PG8_BAR; PG8_MMA(1, 1, At, B1); PG8_BAR;
            }
        }
        if constexpr (ALIGN_EPI) { if (wr == 0) PG8_BAR; }
        if constexpr (!Epi::AFTER_DRAIN) { E(acc, cur, wr, wc, fr, fq); S.done(cur); }
        if (!has_next) break;
#pragma unroll
        for (int a = 0; a < 2; ++a)
#pragma unroll
            for (int b = 0; b < 2; ++b)
#pragma unroll
                for (int m = 0; m < 4; ++m)
#pragma unroll
                    for (int n = 0; n < 2; ++n) acc[a][b][m][n] = (f32x4){0.f, 0.f, 0.f, 0.f};
        cur = nxt; cA = nA; cB = nB; ++ui;
        if constexpr (ALIGN_EPI) { if (wr == 1) PG8_BAR; }
    }
    PG8_WAIT_V(0);
    if constexpr (!ALIGN_EPI) { if (wr == 0) PG8_BAR; }
    PG8_BAR;
    if constexpr (Epi::AFTER_DRAIN) { E.fused(acc, cur, wr, wc, fr, fq, lds, wid, lane); S.done(cur); }
#undef PG8_SA
#undef PG8_SB
#undef PG8_STAGE
#undef PG8_LDA
#undef PG8_LDB
#undef PG8_MMA
#undef PG8_WAIT_V
#undef PG8_WAIT_L
#undef PG8_BAR
#undef PG8_SCHED
}
}
#ifndef PG8_SP2
#define PG8_SP2 true
#endif
#ifndef PG8_ALIGN
#define PG8_ALIGN true
#endif

constexpr int NWAVES = 8;
#ifndef MK_N_LAUNCHES
#define MK_N_LAUNCHES 1
#endif
constexpr int N_PHASES = 7;
constexpr int N_LAUNCHES = MK_N_LAUNCHES;

constexpr int D = 4096, MP = 16384, MS = 2048, M = MP + MS;
constexpr int TP = 4096, TS = 64, PAST = 2048, TKS = PAST + TS;
constexpr int NIN = 8192, DFF = 16384, LW = 2048;
constexpr float EPS = 1e-6f;
constexpr float QSCALE = 0.08838834764831845f * 1.4426950408889634f;
constexpr float LAM_INIT = 0.2f;
constexpr size_t O_Y = 0, O_KP = 75497472, O_VP = 92274688, O_CP = 109051904, O_LP = 109076480, O_KS = 109084672, O_VS = 111181824, O_CS = 113278976, O_LS = 113475584, O_END = 113541120;

constexpr size_t MiB = 1u << 20;
constexpr size_t WS_CTL = 0, CTL_ZERO_BYTES = 1 * MiB;
constexpr size_t WS_TAB = 1 * MiB;
constexpr size_t WS_GWT = 2 * MiB;
constexpr size_t WS_WIN = 4 * MiB, WS_WOUT = 68 * MiB, WS_WUP = 100 * MiB, WS_WDN = 228 * MiB;
constexpr size_t WS_HN = 356 * MiB;
constexpr size_t WS_Z = 500 * MiB;
constexpr size_t WS_XN = 500 * MiB;
constexpr size_t WS_QB = 644 * MiB;
constexpr size_t WS_KP = 716 * MiB;
constexpr size_t WS_KS = 748 * MiB;
constexpr size_t WS_VTP = 880 * MiB;
constexpr size_t WS_VTS = 912 * MiB;
constexpr size_t WS_XR = 1044 * MiB;
constexpr size_t WS_GG = 1116 * MiB;
constexpr size_t WS_SP = 1080 * MiB;
constexpr size_t WS_END = 1188 * MiB;
constexpr int CW_TMO = 0, CW_CODE = 1, CW_QCTR = 64  , CW_BAR = 4096, CW_P6 = 8192  , CW_RSS1 = 16384  ;

constexpr int RING_BYTES = 131072, LDSCTL_OFF = RING_BYTES, MISC_OFF = LDSCTL_OFF + 320, LDSCTL_BYTES = 1024, QX_OFF = LDSCTL_OFF + LDSCTL_BYTES  , SUBG_OFF = QX_OFF + 16384  , LDS_BYTES = 151552;

#ifndef XHALF_PERMLANE
#define XHALF_PERMLANE 1
#endif
#define GAS __attribute__((address_space(1)))
#define LAS __attribute__((address_space(3)))
typedef unsigned short bf16;
typedef unsigned v4u __attribute__((ext_vector_type(4)));
typedef unsigned v2u __attribute__((ext_vector_type(2)));
typedef float f32x4 __attribute__((ext_vector_type(4)));
typedef float f32x16 __attribute__((ext_vector_type(16)));
typedef short bf16x8 __attribute__((ext_vector_type(8)));
typedef GAS unsigned gu32;
#define RLX_AGENT __ATOMIC_RELAXED, __HIP_MEMORY_SCOPE_AGENT
#define LDS_WAIT() asm volatile("s_waitcnt lgkmcnt(0)" ::: "memory")
#define VM_WAIT() asm volatile("s_waitcnt vmcnt(0)" ::: "memory")
#define RAW_BAR() __builtin_amdgcn_s_barrier()
__device__ __forceinline__ unsigned f2bf(float f) { unsigned u = __builtin_bit_cast(unsigned, f); return (u + 0x7fffu + ((u >> 16) & 1u)) >> 16; }
__device__ __forceinline__ unsigned pk2(float lo, float hi) { return f2bf(lo) | (f2bf(hi) << 16); }
typedef __bf16 hwbf16x2 __attribute__((ext_vector_type(2)));
typedef float f32x2v __attribute__((ext_vector_type(2)));
__device__ __forceinline__ unsigned cvt2bf(float lo, float hi) { const f32x2v v = {lo, hi}; return __builtin_bit_cast(unsigned, __builtin_convertvector(v, hwbf16x2)); }
__device__ __forceinline__ float xhalf_max(float v) {
#if XHALF_PERMLANE
    const unsigned u = __builtin_bit_cast(unsigned, v); const auto r = __builtin_amdgcn_permlane32_swap(u, u, false, false);
    return fmaxf(__builtin_bit_cast(float, r[0]), __builtin_bit_cast(float, r[1]));
#else
    return fmaxf(v, __shfl_xor(v, 32));
#endif
}
__device__ __forceinline__ float bf2f(unsigned short b) { return __builtin_bit_cast(float, (unsigned)b << 16); }
__device__ __forceinline__ float wave_sum(float v) {
#pragma unroll
    for (int o = 1; o < 64; o <<= 1) v += __shfl_xor(v, o);
    return v;
}

#define XB_TMO      128
#define XB_XCNT(j)  (256  + 64 * (j))
#define XB_XSUB(j)  (1280 + 64 * (j))
#define XB_XGEN(j)  (2304 + 64 * (j))
#define XB_TOP      3328
#define XB_TOPGEN   3392
#define XCD_BAR_WORDS 3456
#define XB_SPIN_CAP (1u << 18)

__device__ __forceinline__ unsigned xb_ld(unsigned* p)              { return __hip_atomic_load(p, __ATOMIC_RELAXED, __HIP_MEMORY_SCOPE_AGENT); }
__device__ __forceinline__ unsigned xb_add(unsigned* p, unsigned v) { return __hip_atomic_fetch_add(p, v, __ATOMIC_RELAXED, __HIP_MEMORY_SCOPE_AGENT); }
__device__ __forceinline__ unsigned xb_xcc_id() { return (unsigned)__builtin_amdgcn_s_getreg((3 << 11) | 20) & 0xFu; }
#define XB_SPIN(cond, bar) do { unsigned _sp = 0; while (cond) { __builtin_amdgcn_s_sleep(1); \
    if ((++_sp & 255u) == 0u) { if (xb_ld(&(bar)[XB_TMO])) break; if (_sp > XB_SPIN_CAP) { atomicAdd(&(bar)[XB_TMO], 1u); break; } } } } while (0)

struct XcdBarrier {
    unsigned* bar; unsigned x;
    volatile LAS unsigned* st;
};

__device__ __forceinline__ XcdBarrier xcd_barrier_post(unsigned* bar, volatile LAS unsigned* st) {
    XcdBarrier b; b.bar = bar; b.x = xb_xcc_id(); b.st = st;
    if (threadIdx.x == 0) (void)xb_add(&bar[XB_XCNT(b.x)], 1u);
    return b;
}
__device__ __forceinline__ void xcd_barrier_complete(unsigned* bar, unsigned x, unsigned& nloc, unsigned& nx) {
    const unsigned G = gridDim.x * gridDim.y * gridDim.z;
    unsigned sum, cnt, mine, sp = 0u;
    for (;;) {
        sum = 0u; cnt = 0u; mine = 0u;
#pragma unroll
        for (unsigned j = 0; j < 16; ++j) { const unsigned c = xb_ld(&bar[XB_XCNT(j)]); sum += c; cnt += (c > 0u) ? 1u : 0u; mine = (j == x) ? c : mine; }
        if (sum == G) break;
        __builtin_amdgcn_s_sleep(1);
        if ((++sp & 255u) == 0u) { if (xb_ld(&bar[XB_TMO])) break; if (sp > XB_SPIN_CAP) { atomicAdd(&bar[XB_TMO], 1u); break; } }
    }
    nloc = mine > 0u ? mine : 1u; nx = cnt > 0u ? cnt : 1u;
}

__device__ __forceinline__ void xcd_barrier(const XcdBarrier& b) {
    asm volatile("s_waitcnt vmcnt(0)" ::: "memory");
    __syncthreads();
    if (threadIdx.x == 0) {
        unsigned* bar = b.bar;
        __builtin_amdgcn_s_waitcnt(0);
        unsigned nloc = b.st[0], nx = b.st[1];
        if (nloc == 0u) { xcd_barrier_complete(bar, b.x, nloc, nx); b.st[0] = nloc; b.st[1] = nx; }
        const unsigned old = xb_add(&bar[XB_XSUB(b.x)], 1u);
        const unsigned gen = old / nloc;
        if (old + 1u == (gen + 1u) * nloc) {
            __builtin_amdgcn_fence(__ATOMIC_RELEASE, "agent");
            asm volatile("s_waitcnt vmcnt(0)" ::: "memory");
            const unsigned og = xb_add(&bar[XB_TOP], 1u);
            const unsigned tg = og / nx;
            if (og + 1u == (tg + 1u) * nx) xb_add(&bar[XB_TOPGEN], 1u);
            else XB_SPIN(xb_ld(&bar[XB_TOPGEN]) == tg, bar);
            __builtin_amdgcn_fence(__ATOMIC_ACQUIRE, "agent");
            xb_add(&bar[XB_XGEN(b.x)], 1u);
            asm volatile("s_waitcnt vmcnt(0)" ::: "memory");
        } else {
            XB_SPIN(xb_ld(&bar[XB_XGEN(b.x)]) == gen, bar);
            __builtin_amdgcn_fence(__ATOMIC_ACQUIRE, "agent");
            asm volatile("s_waitcnt vmcnt(0)" ::: "memory");
        }
    }
    __syncthreads();
}

struct Args { const float* in[25]; float* out; unsigned char* ws; int ph_lo, ph_hi, qslot, variant; };

namespace pg8 {
struct EpiProj {
    static constexpr bool PERM = true, AFTER_DRAIN = false;
    bf16_t *QB, *KP, *KS, *VTP, *VTS, *XR, *GG; float* out; const float* tab;
    __device__ __forceinline__ void operator()(const f32x4 (&acc)[2][2][4][2], const Unit& u, int wr, int wc, int fr, int fq) const {
        const int pn = u.pn; const bool prompt = u.pm < 64;
        const int rbase = u.pm * BM + wr * 64 + fr, cbase = wc * 32 + 8 * fq;
#pragma unroll
        for (int ai = 0; ai < 2; ++ai)
#pragma unroll
            for (int m = 0; m < 4; ++m) {
                const int r = rbase + ai * HALF + m * 16;
                f32x4 v[2][2];
#pragma unroll
                for (int bj = 0; bj < 2; ++bj)
#pragma unroll
                    for (int n = 0; n < 2; ++n) v[bj][n] = acc[ai][bj][m][n];
                if (pn < 12) {
                    if (wc == 0) {
                        const int pos = prompt ? (r & 4095) : (PAST + (r & 63));
                        const float* tc = tab + pos * 16 + 8 * (fq & 1);
#pragma unroll
                        for (int n = 0; n < 2; ++n) {
                            const f32x4 cs = *(const f32x4*)(tc + 4 * n), sn = *(const f32x4*)(tc + 65536 + 4 * n);
#pragma unroll
                            for (int bj = 0; bj < 2; ++bj) {
                                const f32x4 x = v[bj][n]; f32x4 p;
#pragma unroll
                                for (int i = 0; i < 4; ++i) p[i] = __shfl_xor(x[i], 32);
                                v[bj][n] = (fq < 2) ? (x * cs - p * sn) : (x * cs + p * sn);
                            }
                        }
                    }
                    if (pn < 8) {
                        bf16_t* dst = QB + (size_t)r * 2048 + pn * 256 + cbase;
#pragma unroll
                        for (int bj = 0; bj < 2; ++bj) { const f32x4 a = v[bj][0] * QSCALE, b = v[bj][1] * QSCALE; u32x4 w; w.x = cvt_pk_bf16(a[0], a[1]); w.y = cvt_pk_bf16(a[2], a[3]); w.z = cvt_pk_bf16(b[0], b[1]); w.w = cvt_pk_bf16(b[2], b[3]);
                            *(u32x4*)(dst + bj * HALF) = w; }
                    } else {
                        const int kvh = pn - 8;
                        float* fo = out + (prompt ? (O_KP + (size_t)r * 1024) : (O_KS + (size_t)(r - MP) * 1024)) + kvh * 256 + cbase;
                        bf16_t* dst = (prompt ? (KP + (size_t)r * 1024) : (KS + ((size_t)((r - MP) >> 6) * TKS + PAST + (r & 63)) * 1024)) + kvh * 256 + cbase;
#pragma unroll
                        for (int bj = 0; bj < 2; ++bj) { const f32x4 a = v[bj][0], b = v[bj][1]; *(f32x4*)(fo + bj * HALF) = a; *(f32x4*)(fo + bj * HALF + 4) = b;
                            u32x4 w; w.x = cvt_pk_bf16(a[0], a[1]); w.y = cvt_pk_bf16(a[2], a[3]); w.z = cvt_pk_bf16(b[0], b[1]); w.w = cvt_pk_bf16(b[2], b[3]); *(u32x4*)(dst + bj * HALF) = w; }
                    }
                } else if (pn < 16) {
                    const int kvh = pn - 12;
                    float* fo = out + (prompt ? (O_VP + (size_t)r * 1024) : (O_VS + (size_t)(r - MP) * 1024)) + kvh * 256 + cbase;
                    bf16_t* vt; size_t ldv;
                    if (prompt) { vt = VTP + ((size_t)((r >> 12) * 4 + kvh) * 256) * TP + (r & 4095); ldv = TP; }
                    else { vt = VTS + ((size_t)(((r - MP) >> 6) * 4 + kvh) * 256) * TKS + PAST + (r & 63); ldv = TKS; }
#pragma unroll
                    for (int bj = 0; bj < 2; ++bj) { const f32x4 a = v[bj][0], b = v[bj][1]; *(f32x4*)(fo + bj * HALF) = a; *(f32x4*)(fo + bj * HALF + 4) = b;
                        bf16_t* vp = vt + (size_t)(bj * HALF + cbase) * ldv;
#pragma unroll
                        for (int i = 0; i < 4; ++i) { vp[(size_t)i * ldv] = (bf16_t)f2bf(a[i]); vp[(size_t)(4 + i) * ldv] = (bf16_t)f2bf(b[i]); } }
                } else if (pn < 24) {
                    bf16_t* dst = XR + (size_t)r * 2048 + (pn - 16) * 256 + cbase;
#pragma unroll
                    for (int bj = 0; bj < 2; ++bj) { const f32x4 a = v[bj][0], b = v[bj][1]; u32x4 w; w.x = cvt_pk_bf16(a[0], a[1]); w.y = cvt_pk_bf16(a[2], a[3]); w.z = cvt_pk_bf16(b[0], b[1]); w.w = cvt_pk_bf16(b[2], b[3]);
                        *(u32x4*)(dst + bj * HALF) = w; }
                } else {
                    bf16_t* dst = GG + (size_t)r * 2048 + (pn - 24) * 256 + cbase;
#pragma unroll
                    for (int bj = 0; bj < 2; ++bj) { f32x4 a = v[bj][0], b = v[bj][1];
#pragma unroll
                        for (int i = 0; i < 4; ++i) { { const float x = a[i], y = 1.5957691216f * (x + 0.044715f * x * x * x); a[i] = x / (1.0f + __expf(-y)); }
                                                      { const float x = b[i], y = 1.5957691216f * (x + 0.044715f * x * x * x); b[i] = x / (1.0f + __expf(-y)); } }
                        u32x4 w; w.x = cvt_pk_bf16(a[0], a[1]); w.y = cvt_pk_bf16(a[2], a[3]); w.z = cvt_pk_bf16(b[0], b[1]); w.w = cvt_pk_bf16(b[2], b[3]); *(u32x4*)(dst + bj * HALF) = w; }
                }
            }
    }
};
struct EpiRes1 {
    static constexpr bool PERM = true, AFTER_DRAIN = false;
    const float *xp, *xs; bf16_t* HN; float* rss;
    __device__ __forceinline__ void operator()(const f32x4 (&acc)[2][2][4][2], const Unit& u, int wr, int wc, int fr, int fq) const {
        const int rbase = u.pm * BM + wr * 64 + fr, col0 = u.pn * BM + wc * 32 + 8 * fq; const bool prompt = u.pm < 64;
#pragma unroll
        for (int ai = 0; ai < 2; ++ai)
#pragma unroll
            for (int m = 0; m < 4; ++m) {
                const int r = rbase + ai * HALF + m * 16;
                const float* xr = (prompt ? xp + (size_t)r * D : xs + (size_t)(r - MP) * D) + col0;
                bf16_t* hb = HN + (size_t)r * D + col0; float ss = 0.f;
#pragma unroll
                for (int bj = 0; bj < 2; ++bj) { const f32x4 a = acc[ai][bj][m][0] + *(const f32x4*)(xr + bj * HALF), b = acc[ai][bj][m][1] + *(const f32x4*)(xr + bj * HALF + 4);
                    ss += (a[0] * a[0] + a[1] * a[1]) + (a[2] * a[2] + a[3] * a[3]) + (b[0] * b[0] + b[1] * b[1]) + (b[2] * b[2] + b[3] * b[3]);
                    u32x4 w; w.x = cvt_pk_bf16(a[0], a[1]); w.y = cvt_pk_bf16(a[2], a[3]); w.z = cvt_pk_bf16(b[0], b[1]); w.w = cvt_pk_bf16(b[2], b[3]); *(u32x4*)(hb + bj * HALF) = w; }
                ss += __shfl_xor(ss, 16); ss += __shfl_xor(ss, 32);
                if (fq == 0) atomicAdd(rss + r, ss);
            }
    }
};
struct EpiUp {
    static constexpr bool PERM = true, AFTER_DRAIN = false;
    bf16_t* Z;
    __device__ __forceinline__ void operator()(const f32x4 (&acc)[2][2][4][2], const Unit& u, int wr, int wc, int fr, int fq) const {
        const int rbase = u.pm * BM + wr * 64 + fr, col0 = u.pn * BM + wc * 32 + 8 * fq;
#pragma unroll
        for (int ai = 0; ai < 2; ++ai)
#pragma unroll
            for (int m = 0; m < 4; ++m) {
                bf16_t* dst = Z + (size_t)(rbase + ai * HALF + m * 16) * DFF + col0;
#pragma unroll
                for (int bj = 0; bj < 2; ++bj) { f32x4 a = acc[ai][bj][m][0], b = acc[ai][bj][m][1];
#pragma unroll
                    for (int i = 0; i < 4; ++i) { const float x = fmaxf(a[i], 0.f), y = fmaxf(b[i], 0.f); a[i] = x * x; b[i] = y * y; }
                    u32x4 w; w.x = cvt_pk_bf16(a[0], a[1]); w.y = cvt_pk_bf16(a[2], a[3]); w.z = cvt_pk_bf16(b[0], b[1]); w.w = cvt_pk_bf16(b[2], b[3]); *(u32x4*)(dst + bj * HALF) = w; }
            }
    }
};
struct EpiDown {
    static constexpr bool PERM = true, AFTER_DRAIN = false;
    bf16_t* h; const float* rss;
    __device__ __forceinline__ void operator()(const f32x4 (&acc)[2][2][4][2], const Unit& u, int wr, int wc, int fr, int fq) const {
        const int rbase = u.pm * BM + wr * 64 + fr, col0 = u.pn * BM + wc * 32 + 8 * fq;
#pragma unroll
        for (int ai = 0; ai < 2; ++ai)
#pragma unroll
            for (int m = 0; m < 4; ++m) {
                const int r = rbase + ai * HALF + m * 16;
                bf16_t* ho = h + (size_t)r * D + col0; const float sc = 1.0f / (rss[r] * (1.0f / D) + EPS);
#pragma unroll
                for (int bj = 0; bj < 2; ++bj) { const u32x4 hv = *(const u32x4*)(ho + bj * HALF);
                    f32x4 a = acc[ai][bj][m][0] * sc, b = acc[ai][bj][m][1] * sc;
                    a[0] += __builtin_bit_cast(float, hv.x << 16); a[1] += __builtin_bit_cast(float, hv.x & 0xffff0000u); a[2] += __builtin_bit_cast(float, hv.y << 16); a[3] += __builtin_bit_cast(float, hv.y & 0xffff0000u);
                    b[0] += __builtin_bit_cast(float, hv.z << 16); b[1] += __builtin_bit_cast(float, hv.z & 0xffff0000u); b[2] += __builtin_bit_cast(float, hv.w << 16); b[3] += __builtin_bit_cast(float, hv.w & 0xffff0000u);
                    u32x4 w; w.x = cvt_pk_bf16(a[0], a[1]); w.y = cvt_pk_bf16(a[2], a[3]); w.z = cvt_pk_bf16(b[0], b[1]); w.w = cvt_pk_bf16(b[2], b[3]); *(u32x4*)(ho + bj * HALF) = w; }
            }
    }
};
struct EpiPart {
    static constexpr bool PERM = true, AFTER_DRAIN = false;
    float* S; const float* rss;
    __device__ __forceinline__ void operator()(const f32x4 (&acc)[2][2][4][2], const Unit& u, int wr, int wc, int fr, int fq) const {
        const int rbase = u.pm * BM + wr * 64 + fr, col0 = u.pn * BM + wc * 32 + 8 * fq;
#pragma unroll
        for (int ai = 0; ai < 2; ++ai)
#pragma unroll
            for (int m = 0; m < 4; ++m) {
                const int r = rbase + ai * HALF + m * 16;
                float* so = S + (size_t)r * D + col0; const float sc = 1.0f / (rss[r] * (1.0f / D) + EPS);
#pragma unroll
                for (int bj = 0; bj < 2; ++bj) { *(f32x4*)(so + bj * HALF) = acc[ai][bj][m][0] * sc; *(f32x4*)(so + bj * HALF + 4) = acc[ai][bj][m][1] * sc; }
            }
    }
};
struct OneUnit {
    Unit u; bool valid;
    __device__ __forceinline__ bool next(int i, Unit& o) const { if (i > 0 || !valid) return false; o = u; return true; }
    __device__ __forceinline__ void a_ready(const Unit&) const {}
    __device__ __forceinline__ void done(const Unit&) const {}
};
}

__device__ __forceinline__ void tr_item(const float* W, int ldw, bf16* WT, size_t ldt, LAS float* scr, int k0, int n0, int lane, const float* kscale) {
#pragma unroll
    for (int i = 0; i < 8; ++i) { const int kk = 8 * i + (lane >> 3), c4 = 4 * (lane & 7); f32x4 v = *(const GAS f32x4*)(W + (size_t)(k0 + kk) * ldw + n0 + c4); if (kscale) v = v * kscale[k0 + kk];
        LAS float* d = scr + kk * 33 + c4; d[0] = v[0]; d[1] = v[1]; d[2] = v[2]; d[3] = v[3]; }
    LDS_WAIT(); asm volatile("" ::: "memory");
    const int c = lane & 7;
#pragma unroll
    for (int j = 0; j < 4; ++j) { const int n = (lane >> 3) + 8 * j; const LAS float* s = scr + (8 * c) * 33 + n;
        v4u o; o.x = pk2(s[0 * 33], s[1 * 33]); o.y = pk2(s[2 * 33], s[3 * 33]); o.z = pk2(s[4 * 33], s[5 * 33]); o.w = pk2(s[6 * 33], s[7 * 33]);
        *(GAS v4u*)(WT + (size_t)(n0 + n) * ldt + k0 + 8 * c) = o; }
    LDS_WAIT(); asm volatile("" ::: "memory");
}
__device__ __forceinline__ void tr_matrix_item(const float* W, int K, int N, int ldw, bf16* WT, size_t ldt, LAS float* scr, int item, int lane, const float* kscale) {
    const int nblk = N / 32, kb = item / nblk, nb = item % nblk; (void)K;
    tr_item(W, ldw, WT, ldt, scr, 64 * kb, 32 * nb, lane, kscale);
}
__device__ __forceinline__ void rope_entry(int idx, float* tab) {
    const float invt[16] = {1.0f, 0.44036659598350525f, 0.1939227432012558f, 0.08539710193872452f, 0.03760603070259094f, 0.016560440883040428f, 0.007292664609849453f, 0.0032114461064338684f,
                            0.0014142135623842478f, 0.0006227724370546639f, 0.00027424818836152554f, 0.00012076973507646471f, 5.3182957344688475e-05f, 2.34199997066753e-05f, 1.0313385246263351e-05f, 4.541670477919979e-06f};
    const int pos = idx >> 4, j = idx & 15;
    float inv = invt[0];
#pragma unroll
    for (int k = 1; k < 16; ++k) inv = (j == k) ? invt[k] : inv;
    const float angf = (float)pos * inv;
    const double x = (double)angf, q = __builtin_rint(x * 0.63661977236758134308), r = __builtin_fma(-q, 1.57079632679489661923, x) - q * 6.123233995736766e-17, r2 = r * r;
    double s = r2 * (1.0 / 6227020800.0) - 1.0 / 39916800.0; s = s * r2 + 1.0 / 362880.0; s = s * r2 - 1.0 / 5040.0; s = s * r2 + 1.0 / 120.0; s = s * r2 - 1.0 / 6.0; s = s * r2 * r + r;
    double c = r2 * (1.0 / 87178291200.0) - 1.0 / 479001600.0; c = c * r2 + 1.0 / 3628800.0; c = c * r2 - 1.0 / 40320.0; c = c * r2 + 1.0 / 720.0; c = c * r2 - 1.0 / 24.0; c = c * r2 + 0.5; c = 1.0 - c * r2;
    const int qi = ((int)q) & 3;
    const double sn = (qi == 0) ? s : (qi == 1) ? c : (qi == 2) ? -s : -c, cs = (qi == 0) ? c : (qi == 1) ? -s : (qi == 2) ? -c : s;
    tab[idx] = (float)cs; tab[65536 + idx] = (float)sn;
}

namespace att {
#ifndef ATT_QKD
#define ATT_QKD 2
#endif
#ifndef ATT_PVD
#define ATT_PVD 4
#endif
#ifndef ATT_SCHED_BETA
#define ATT_SCHED_BETA
#endif
constexpr int KT_BYTES = 32768, STAGE = 65536;
struct Unit { const bf16* Kb; const bf16* Vt; int ldv, ntiles, qrow0, kvh; };
__device__ __forceinline__ void attn_unit(LAS unsigned char* lds, const Unit& U, const bf16* QB, bf16* CAT, const float* subg, float lam) {
    int tid = threadIdx.x; asm volatile("" : "+v"(tid));
    const int lane = tid & 63, wid = __builtin_amdgcn_readfirstlane(tid >> 6);
    const int g = wid >> 2, c = (wid >> 1) & 1, qs = wid & 1, ql = lane & 31, h = lane >> 5;
    const int qrow = U.qrow0 + qs * 32 + ql;
    bf16x8 qf[6];
    LAS bf16x8* qx = (LAS bf16x8*)(lds + QX_OFF) + tid;
    { const bf16* qp = QB + (size_t)qrow * 2048 + (U.kvh * 2 + g) * 256 + c * 128 + 8 * h;
#pragma unroll
      for (int ks = 0; ks < 6; ++ks) qf[ks] = *(const GAS bf16x8*)(qp + 16 * ks);
      qx[0] = *(const GAS bf16x8*)(qp + 96); qx[512] = *(const GAS bf16x8*)(qp + 112); }
    const int kr = tid >> 5, kcc = (tid & 31) ^ (kr & 15);
    const unsigned koff = (unsigned)(kr * 1024 + kcc * 8) * 2u;
    const int ve = tid >> 3, vcc = (tid & 7) ^ ((ve >> 1) & 7);
    const unsigned voff = (unsigned)(ve * U.ldv + vcc * 8) * 2u;
    const char* kb0 = (const char*)U.Kb; const char* vb0 = (const char*)U.Vt;
    const size_t vstep = (size_t)128 * U.ldv;
#ifndef ATT_DMA_REP
#define ATT_DMA_REP 1
#endif
#define ATT_ISSUE_K(t, st) do { const char* kp_ = kb0 + (size_t)(t) * 131072; \
        _Pragma("unroll") for (int j2_ = 0; j2_ < 4 * ATT_DMA_REP; ++j2_) { const int j_ = j2_ & 3; __builtin_amdgcn_global_load_lds((const unsigned*)(kp_ + (size_t)j_ * 32768 + koff), (LAS unsigned*)(lds + (st) * STAGE + wid * 1024 + j_ * 8192), 16, 0, 0); } } while (0)
#define ATT_ISSUE_V(t, st) do { const char* vp_ = vb0 + (size_t)(t) * 128; \
        _Pragma("unroll") for (int j2_ = 0; j2_ < 4 * ATT_DMA_REP; ++j2_) { const int j_ = j2_ & 3; __builtin_amdgcn_global_load_lds((const unsigned*)(vp_ + j_ * vstep + voff), (LAS unsigned*)(lds + (st) * STAGE + KT_BYTES + wid * 1024 + j_ * 8192), 16, 0, 0); } } while (0)
    const int kap = (ql & 0x13) | ((ql & 4) << 1) | ((ql & 8) >> 1);
    const unsigned kaddr0 = (unsigned)(kap * 512 + c * 256 + 16 * ((kap & 15) ^ h));
    const unsigned vaddr0 = (unsigned)(KT_BYTES + ql * 128 + 16 * (((ql >> 1) & 7) ^ h));
    f32x16 O[8];
#pragma unroll
    for (int e = 0; e < 8; ++e)
#pragma unroll
        for (int i = 0; i < 16; ++i) O[e][i] = 0.f;
    float mrun = 0.f, lrun = 0.f;
    ATT_ISSUE_K(0, 0); ATT_ISSUE_V(0, 0);
    VM_WAIT(); RAW_BAR();
    if (g == 1) RAW_BAR();
    const int nt = U.ntiles;
    for (int t = 0; t < nt; ++t) {
        const int st = t & 1, tn = (t + 1 < nt) ? t + 1 : t;
        const unsigned ka = kaddr0 + (unsigned)st * STAGE, va = vaddr0 + (unsigned)st * STAGE;
        const unsigned ka5 = ka >> 5, kal = ka & 31u, va5 = va >> 5, val = va & 31u;
#define ATT_KF(beta, ks) (*(const LAS bf16x8*)(lds + ((((ka5 ^ (unsigned)(ks)) << 5) | kal) + 16384u * (beta))))
#define ATT_VF(e, s) (*(const LAS bf16x8*)(lds + ((((va5 ^ (unsigned)(s)) << 5) | val) + 4096u * (e))))
#pragma unroll
        for (int beta = 0; beta < 2; ++beta) {
            if (g == 1) __builtin_amdgcn_s_setprio(1);
            f32x16 S;
#pragma unroll
            for (int i = 0; i < 16; ++i) S[i] = -mrun;
            { bf16x8 kf[8];
#pragma unroll
              for (int ks = 0; ks < 8; ++ks) kf[ks] = ATT_KF(beta, ks);
#pragma unroll
              for (int ks = 0; ks < 8; ++ks) S = __builtin_amdgcn_mfma_f32_32x32x16_bf16(kf[ks], (ks < 6) ? qf[ks < 6 ? ks : 0] : qx[(ks - 6) * 512], S, 0, 0, 0);
              __builtin_amdgcn_sched_group_barrier(0x100, ATT_QKD + 2, 0);
#pragma unroll
              for (int ks = 0; ks < 8 - ATT_QKD; ++ks) { __builtin_amdgcn_sched_group_barrier(0x8, 1, 0); __builtin_amdgcn_sched_group_barrier(0x100, 1, 0); }
              __builtin_amdgcn_sched_group_barrier(0x8, ATT_QKD, 0); }
            float mx = fmaxf(fmaxf(S[0], S[1]), S[2]);
#pragma unroll
            for (int i = 3; i < 15; i += 2) mx = fmaxf(fmaxf(mx, S[i]), S[i + 1]);
            mx = fmaxf(mx, S[15]);
            mx = xhalf_max(mx);
            const bool first = (t == 0) && (beta == 0);
            if (first || __any(mx > 8.0f)) {
                const float d = first ? mx : fmaxf(mx, 0.f);
                if (!first) { const float al = __builtin_amdgcn_exp2f(-d); lrun *= al;
#pragma unroll
                    for (int e = 0; e < 8; ++e) O[e] = O[e] * al; }
                mrun += d;
#pragma unroll
                for (int i = 0; i < 16; ++i) S[i] -= d;
            }
            float ps = 0.f; bf16x8 pb[2];
#pragma unroll
            for (int j = 0; j < 2; ++j) { v4u w;
#pragma unroll
                for (int k = 0; k < 4; ++k) { const float p0 = __builtin_amdgcn_exp2f(S[8 * j + 2 * k]), p1 = __builtin_amdgcn_exp2f(S[8 * j + 2 * k + 1]); ps += p0 + p1; w[k] = cvt2bf(p0, p1); }
                pb[j] = __builtin_bit_cast(bf16x8, w); }
            lrun += ps;
            if (beta == 0) ATT_ISSUE_K(tn, st ^ 1);
            if (g == 1) __builtin_amdgcn_s_setprio(0);
            if (beta == 1) { if (ATT_DMA_REP == 1) asm volatile("s_waitcnt vmcnt(4)" ::: "memory"); else asm volatile("s_waitcnt vmcnt(8)" ::: "memory"); }
            LDS_WAIT(); RAW_BAR();
            { bf16x8 vf[8][2];
#pragma unroll
              for (int e = 0; e < 8; ++e)
#pragma unroll
                  for (int j = 0; j < 2; ++j) vf[e][j] = ATT_VF(e, 2 * beta + j);
#pragma unroll
              for (int e = 0; e < 8; ++e)
#pragma unroll
                  for (int j = 0; j < 2; ++j) O[e] = __builtin_amdgcn_mfma_f32_32x32x16_bf16(vf[e][j], pb[j], O[e], 0, 0, 0);
              __builtin_amdgcn_sched_group_barrier(0x100, ATT_PVD, 0);
#pragma unroll
              for (int e = 0; e < 16 - ATT_PVD; ++e) { __builtin_amdgcn_sched_group_barrier(0x8, 1, 0); __builtin_amdgcn_sched_group_barrier(0x100, 1, 0); }
              __builtin_amdgcn_sched_group_barrier(0x8, ATT_PVD, 0); }
            if (beta == 0) ATT_ISSUE_V(tn, st ^ 1);
            if (beta == 1) VM_WAIT();
            LDS_WAIT(); RAW_BAR();
        }
    }
    if (g == 0) RAW_BAR();
#undef ATT_KF
#undef ATT_VF
#undef ATT_ISSUE_K
#undef ATT_ISSUE_V
    lrun += __shfl_xor(lrun, 32);
    const float inv = 1.0f / lrun;
    LAS float* X = (LAS float*)(lds + (g * 2 + qs) * 32768);
    if (c == 1) {
#pragma unroll
        for (int e = 0; e < 8; ++e)
#pragma unroll
            for (int i = 0; i < 16; ++i) X[(e * 16 + i) * 64 + lane] = O[e][i] * inv;
    }
    LDS_WAIT(); RAW_BAR();
    if (c == 0) {
        float ss = 0.f;
#pragma unroll
        for (int e = 0; e < 8; ++e) {
#pragma unroll
            for (int i = 0; i < 16; ++i) { const float o = O[e][i] * inv - lam * X[(e * 16 + i) * 64 + lane]; O[e][i] = o; ss += o * o; }
            asm volatile("" : "+v"(ss) :: "memory"); }
        ss += __shfl_xor(ss, 32);
        const float rs = 1.0f / sqrtf(ss * (1.0f / 256.0f) + EPS);
        bf16* orow = CAT + (size_t)qrow * D + (U.kvh * 2 + g) * 256 + 4 * h;
#pragma unroll
        for (int e = 0; e < 8; ++e) {
#pragma unroll
            for (int i4 = 0; i4 < 4; ++i4) { const int e0 = 32 * e + 8 * i4; const f32x4 gv = *(const LAS f32x4*)(lds + SUBG_OFF + (e0 + 4 * h) * 4);
                v2u w; w.x = pk2(O[e][4 * i4] * rs * gv[0], O[e][4 * i4 + 1] * rs * gv[1]); w.y = pk2(O[e][4 * i4 + 2] * rs * gv[2], O[e][4 * i4 + 3] * rs * gv[3]);
                *(GAS v2u*)(orow + e0) = w; }
            asm volatile("" ::: "memory"); }
    }
    LDS_WAIT(); RAW_BAR();
}
}

namespace lru {
constexpr int XCB_PITCH = 272;
__device__ __forceinline__ float sigm(float x) { return __builtin_amdgcn_rcpf(1.0f + __expf(-x)); }
__device__ __forceinline__ float em1_small(float x) { float p = 1.0f / 5040.0f; p = p * x + 1.0f / 720.0f; p = p * x + 1.0f / 120.0f; p = p * x + 1.0f / 24.0f; p = p * x + 1.0f / 6.0f; p = p * x + 0.5f; p = p * x + 1.0f; return p * x; }
struct Job { int row0, n, nchunks; const float* cprev; const float* h0; float* conv_out; float* h_out; };
__device__ __forceinline__ void lru_chain(LAS unsigned char* lds, const Job& J, const bf16* XR, const bf16* GG, bf16* CAT, const bf16* GWT, const float* conv_w, const float* conv_b,
                                          const float* ga_b, const float* gx_b, const float* lam) {
    const int tid = threadIdx.x, lane = tid & 63, wid = __builtin_amdgcn_readfirstlane(tid >> 6);
    const int nl = lane & 15, g4 = lane >> 4, ch = 16 * wid + nl, gch = J.n * 128 + ch;
    LAS unsigned char* XCB = lds;
    const float w0 = conv_w[gch], w1 = conv_w[2048 + gch], w2 = conv_w[4096 + gch], w3 = conv_w[6144 + gch], cb = conv_b[gch];
    const float ba = ga_b[gch], bxv = gx_b[gch], sp = log1pf(__expf(-lam[gch]));
    bf16x8 bfr[2][4];
#pragma unroll
    for (int gt = 0; gt < 2; ++gt)
#pragma unroll
        for (int ks = 0; ks < 4; ++ks) bfr[gt][ks] = *(const GAS bf16x8*)(GWT + ((size_t)(J.n * 256 + gt * 128 + ch)) * 128 + 32 * ks + 8 * g4);
    float hin = J.h0 ? J.h0[gch] : 0.f;
    float x[19], ggv[16];
    { const bf16* xp = XR + (size_t)(J.row0 + 16 * g4 - 3) * 2048 + gch;
#pragma unroll
      for (int j = 0; j < 19; ++j) { if (j < 3) x[j] = (g4 == 0) ? (J.cprev ? J.cprev[j * 2048 + gch] : 0.f) : bf2f(xp[(size_t)j * 2048]); else x[j] = bf2f(xp[(size_t)j * 2048]); }
      const bf16* gp = GG + (size_t)(J.row0 + 16 * g4) * 2048 + gch;
#pragma unroll
      for (int i = 0; i < 16; ++i) ggv[i] = bf2f(gp[(size_t)i * 2048]); }
    for (int cs = 0; cs < J.nchunks; ++cs) {
        const int t0 = J.row0 + 64 * cs;
        float xc[16], gcur[16];
#pragma unroll
        for (int i = 0; i < 16; ++i) { float v = cb + x[i] * w0; v += x[i + 1] * w1; v += x[i + 2] * w2; v += x[i + 3] * w3; xc[i] = v; gcur[i] = ggv[i];
            *(LAS unsigned short*)(XCB + (16 * g4 + i) * XCB_PITCH + 2 * ch) = (unsigned short)f2bf(v); }
        if (cs == J.nchunks - 1 && g4 == 3) { J.conv_out[gch] = x[16]; J.conv_out[2048 + gch] = x[17]; J.conv_out[4096 + gch] = x[18]; }
        if (cs + 1 < J.nchunks) { const bf16* xp = XR + (size_t)(t0 + 64 + 16 * g4 - 3) * 2048 + gch;
#pragma unroll
            for (int j = 0; j < 19; ++j) x[j] = bf2f(xp[(size_t)j * 2048]);
            const bf16* gp = GG + (size_t)(t0 + 64 + 16 * g4) * 2048 + gch;
#pragma unroll
            for (int i = 0; i < 16; ++i) ggv[i] = bf2f(gp[(size_t)i * 2048]); }
        LDS_WAIT(); RAW_BAR();
        pg8::f32x4 acc[4][2];
        { const int trow = 16 * (nl >> 2) + (nl & 3);
#pragma unroll
          for (int rb = 0; rb < 4; ++rb) { acc[rb][0] = (pg8::f32x4){0.f, 0.f, 0.f, 0.f}; acc[rb][1] = (pg8::f32x4){0.f, 0.f, 0.f, 0.f};
#pragma unroll
              for (int ks = 0; ks < 4; ++ks) { const bf16x8 af = *(const LAS bf16x8*)(XCB + (trow + 4 * rb) * XCB_PITCH + (32 * ks + 8 * g4) * 2);
                  acc[rb][0] = __builtin_amdgcn_mfma_f32_16x16x32_bf16(af, bfr[0][ks], acc[rb][0], 0, 0, 0); acc[rb][1] = __builtin_amdgcn_mfma_f32_16x16x32_bf16(af, bfr[1][ks], acc[rb][1], 0, 0, 0); } } }
        LDS_WAIT(); RAW_BAR();
        float Hl[16], Pc[16]; float H = 0.f, P = 1.f;
#pragma unroll
        for (int rb = 0; rb < 4; ++rb)
#pragma unroll
            for (int i = 0; i < 4; ++i) { const int j = 4 * rb + i;
                const float r = sigm(acc[rb][0][i] + ba), ig = sigm(acc[rb][1][i] + bxv), la = -8.0f * r * sp, la2 = la + la;
                const float a = (la > -0.25f) ? 1.0f + em1_small(la) : __expf(la), m2 = (la2 > -0.25f) ? -em1_small(la2) : 1.0f - __expf(la2), u = __builtin_amdgcn_sqrtf(m2) * (ig * xc[j]);
                H = a * H + u; P *= a; Hl[j] = H; Pc[j] = P; }
        float Pt = 1.f, Ht = 0.f, Pp = 1.f, Hp = 0.f;
#pragma unroll
        for (int s = 0; s < 4; ++s) { const float ps = __shfl(P, nl + 16 * s), hs = __shfl(H, nl + 16 * s); if (s == g4) { Pp = Pt; Hp = Ht; } Ht = ps * Ht + hs; Pt *= ps; }
        { const float hs = Pp * hin + Hp;
          bf16* op = CAT + (size_t)(t0 + 16 * g4) * D + 2048 + gch;
#pragma unroll
          for (int j = 0; j < 16; ++j) op[(size_t)j * D] = (bf16)f2bf((Hl[j] + Pc[j] * hs) * gcur[j]); }
        hin = Pt * hin + Ht;
    }
    if (g4 == 0) J.h_out[gch] = hin;
}
}

__global__ void __launch_bounds__(NWAVES * 64, 2) mega_fwd(Args args) {
    extern __shared__ __attribute__((aligned(16))) unsigned char lds_raw[];
    LAS unsigned char* lds = (LAS unsigned char*)lds_raw;
    volatile LAS unsigned* MISC = (volatile LAS unsigned*)(lds + MISC_OFF);
    const int tid = threadIdx.x, lane = tid & 63, wave = __builtin_amdgcn_readfirstlane(tid >> 6);
    const int G = gridDim.x, bx = blockIdx.x;
    const int vcu = (G % 8 == 0) ? (bx % 8) * (G / 8) + bx / 8 : bx;
    unsigned char* ws = args.ws;
    gu32* ctl = (gu32*)(ws + WS_CTL);
    float* out = args.out;
    const float* x_prompt = args.in[0]; const float* x_sample = args.in[1]; const float* cache_k = args.in[2]; const float* cache_v = args.in[3];
    const float* state_conv = args.in[4]; const float* state_lru = args.in[5]; const float* norm_mix = args.in[6]; const float* w_in = args.in[7];
    const float* conv_w = args.in[8]; const float* conv_b = args.in[9]; const float* gate_a_w = args.in[10]; const float* gate_a_b = args.in[11];
    const float* gate_x_w = args.in[12]; const float* gate_x_b = args.in[13]; const float* lru_lambda = args.in[14];
    const float* lq1 = args.in[15]; const float* lk1 = args.in[16]; const float* lq2 = args.in[17]; const float* lk2 = args.in[18]; const float* subln_g = args.in[19];
    const float* w_out = args.in[20]; const float* norm_mlp = args.in[21]; const float* w_up = args.in[22]; const float* w_down = args.in[23]; const float* norm_final = args.in[24];
    bf16* WIN = (bf16*)(ws + WS_WIN); bf16* WOUT = (bf16*)(ws + WS_WOUT); bf16* WUP = (bf16*)(ws + WS_WUP); bf16* WDN = (bf16*)(ws + WS_WDN);
    bf16* HN = (bf16*)(ws + WS_HN); bf16* Z = (bf16*)(ws + WS_Z); bf16* XN = (bf16*)(ws + WS_XN); bf16* CAT = XN; bf16* QB = (bf16*)(ws + WS_QB);
    bf16* KP = (bf16*)(ws + WS_KP); bf16* KS = (bf16*)(ws + WS_KS); bf16* VTP = (bf16*)(ws + WS_VTP); bf16* VTS = (bf16*)(ws + WS_VTS);
    bf16* XR = (bf16*)(ws + WS_XR); bf16* GG = (bf16*)(ws + WS_GG); bf16* GWT = (bf16*)(ws + WS_GWT); float* TAB = (float*)(ws + WS_TAB);
    float* RSS1 = (float*)(ws + WS_CTL) + CW_RSS1;

    for (int u = tid; u < LDSCTL_BYTES / 4; u += NWAVES * 64) ((LAS unsigned*)(lds + LDSCTL_OFF))[u] = 0u;
    __syncthreads();
    XcdBarrier bar; bar.bar = (unsigned*)(ctl + CW_BAR); bar.x = 0; bar.st = nullptr;
    if (N_LAUNCHES == 1) bar = xcd_barrier_post((unsigned*)(ctl + CW_BAR), MISC + 8);
#define GRID_BAR() do { if (N_LAUNCHES == 1) xcd_barrier(bar); } while (0)
    const int lo = args.ph_lo, hi = args.ph_hi;
#ifndef PH_MASK
#define PH_MASK 0x7f
#endif
#define IN(k) (((PH_MASK >> (k)) & 1) && lo <= (k) && (k) < hi)
#define BOTH(k) (IN(k) && IN((k) + 1))

#ifndef P0_REPS
#define P0_REPS 1
#endif
#ifndef P2_REPS
#define P2_REPS 1
#endif
#ifndef P4_REPS
#define P4_REPS 1
#endif
    if (IN(0)) {
      for (int rep0 = 0; rep0 < P0_REPS; ++rep0) {
        LAS float* scr = (LAS float*)(lds + wave * 16384);
        const int gw = vcu * NWAVES + wave, NGW = G * NWAVES;
        constexpr int I_IN = 64 * 256, I_OUT = 64 * 128, I_UP = 64 * 512, I_CV = 128 * 256, I_GW = 32 * 8;
        constexpr int NITEMS = I_IN + I_OUT + I_UP + I_CV + I_GW;
        for (int it = gw; it < NITEMS; it += NGW) {
            int r = it;
            if (r < I_IN) { tr_matrix_item(w_in, D, NIN, NIN, WIN, D, scr, r, lane, nullptr); continue; } r -= I_IN;
            if (r < I_OUT) { tr_matrix_item(w_out, D, D, D, WOUT, D, scr, r, lane, nullptr); continue; } r -= I_OUT;
            if (r < I_UP) { tr_matrix_item(w_up, D, DFF, DFF, WUP, D, scr, r, lane, norm_mlp); continue; } r -= I_UP;
            if (r < I_CV) { const int sl = r >> 8, sb = sl >> 2, kvh = sl & 3;
                tr_matrix_item(cache_v + (size_t)sb * PAST * 1024 + kvh * 256, PAST, 256, 1024, VTS + (size_t)sl * 256 * TKS, TKS, scr, r & 255, lane, nullptr); continue; } r -= I_CV;
            { const int gi = r >> 3, gt = gi >> 4, nb = gi & 15;
              tr_matrix_item((gt ? gate_x_w : gate_a_w) + (size_t)nb * 16384, 128, 128, 128, GWT + (size_t)(nb * 256 + gt * 128) * 128, 128, scr, r & 7, lane, nullptr); }
        }
        for (int m = gw; m < M; m += NGW) {
            const GAS f32x4* xr = (const GAS f32x4*)(m < MP ? x_prompt + (size_t)m * D : x_sample + (size_t)(m - MP) * D) + lane;
            f32x4 v[16]; float s = 0.f;
#pragma unroll
            for (int j = 0; j < 16; ++j) { v[j] = xr[64 * j]; s += (v[j][0] * v[j][0] + v[j][1] * v[j][1]) + (v[j][2] * v[j][2] + v[j][3] * v[j][3]); }
            const float rstd = 1.0f / sqrtf(wave_sum(s) * (1.0f / D) + EPS);
            GAS v2u* o8 = (GAS v2u*)(XN + (size_t)m * D) + lane;
#pragma unroll
            for (int j = 0; j < 16; ++j) { const f32x4 gv = ((const GAS f32x4*)norm_mix)[lane + 64 * j]; v2u w; w.x = pk2(v[j][0] * rstd * gv[0], v[j][1] * rstd * gv[1]); w.y = pk2(v[j][2] * rstd * gv[2], v[j][3] * rstd * gv[3]); o8[64 * j] = w; }
        }
        for (int rr = gw; rr < 32 * PAST; rr += NGW) {
            const int sb = rr >> 11, t = rr & 2047;
            const GAS f32x4* src = (const GAS f32x4*)(cache_k + (size_t)rr * 1024); GAS v4u* dst = (GAS v4u*)(KS + ((size_t)sb * TKS + t) * 1024);
#pragma unroll
            for (int j = 0; j < 2; ++j) { const f32x4 a = src[j * 128 + lane * 2], b = src[j * 128 + lane * 2 + 1]; v4u w; w.x = pk2(a[0], a[1]); w.y = pk2(a[2], a[3]); w.z = pk2(b[0], b[1]); w.w = pk2(b[2], b[3]); dst[j * 64 + lane] = w; }
        }
        for (int jb = gw; jb < 1024; jb += NGW) rope_entry(jb * 64 + lane, TAB);
      }
        if (BOTH(0)) GRID_BAR();
    }

    if (IN(1)) {
        pg8::Gemm g{XN, WIN, M, NIN, D, D}; pg8::StaticOrder S; S.init(M, NIN, G, bx);
        pg8::EpiProj E{QB, KP, KS, VTP, VTS, XR, GG, out, TAB};
#ifndef P1_REPS
#define P1_REPS 1
#endif
        for (int rep1 = 0; rep1 < P1_REPS; ++rep1)
        pg8::gemm_phase<pg8::EpiProj, pg8::StaticOrder, PG8_ALIGN, PG8_SP2>(lds, g, S, E);
        if (BOTH(1)) GRID_BAR();
    }

    if (IN(2)) {
      for (int rep2 = 0; rep2 < P2_REPS; ++rep2) {
#ifndef P2_NO_LRU
        if (args.variant != 1) {
            lru::Job J;
            if (bx < 64) { const int b = bx >> 4;
                J.row0 = b * TP; J.n = bx & 15; J.nchunks = TP / 64; J.cprev = nullptr; J.h0 = nullptr; J.conv_out = out + O_CP + (size_t)b * 3 * LW; J.h_out = out + O_LP + (size_t)b * LW;
                lru::lru_chain(lds, J, XR, GG, CAT, GWT, conv_w, conv_b, gate_a_b, gate_x_b, lru_lambda);
            } else for (int v = bx - 64; v < 512; v += G - 64) { const int sb = v >> 4;
                J.row0 = MP + sb * TS; J.n = v & 15; J.nchunks = 1; J.cprev = state_conv + (size_t)sb * 3 * LW; J.h0 = state_lru + (size_t)sb * LW;
                J.conv_out = out + O_CS + (size_t)sb * 3 * LW; J.h_out = out + O_LS + (size_t)sb * LW;
                lru::lru_chain(lds, J, XR, GG, CAT, GWT, conv_w, conv_b, gate_a_b, gate_x_b, lru_lambda); }
        }
#endif
#ifndef P2_NO_ATT
        float lam;
        { const float d1 = wave_sum(lq1[lane] * lk1[lane] + lq1[lane + 64] * lk1[lane + 64]), d2 = wave_sum(lq2[lane] * lk2[lane] + lq2[lane + 64] * lk2[lane + 64]); lam = expf(d1) - expf(d2) + LAM_INIT; }
        if (tid < 256) ((LAS float*)(lds + SUBG_OFF))[tid] = subln_g[tid] * (1.0f - LAM_INIT);
        const unsigned myq = xb_xcc_id() & 7u; unsigned qdone = 0u;
        if (args.variant != 2)
        for (;;) {
            if (tid == 0) { unsigned res = 0xffffffffu;
                for (unsigned k = 0; k < 8u; ++k) { const unsigned q = (myq + k) & 7u; if ((qdone >> q) & 1u) continue;
                    const unsigned p = __hip_atomic_fetch_add((unsigned*)(ctl + CW_QCTR + 64 * (q + 8 * (rep2 + args.qslot))), 1u, RLX_AGENT);
                    if (p < 144u) { res = q * 256u + p; break; } qdone |= 1u << q; }
                MISC[16] = res; }
            LDS_WAIT(); RAW_BAR();
            const unsigned res = (unsigned)__builtin_amdgcn_readfirstlane((int)MISC[16]);
            LDS_WAIT(); RAW_BAR();
            if (res == 0xffffffffu) break;
            const int q = (int)(res >> 8), p = (int)(res & 255u);
            att::Unit U;
            int qc = -1, pair = 0, su = -1;
            if (p < 62) { qc = 63 - (p >> 1); pair = 2 * q + (p & 1); } else if (p < 78) su = 16 * q + (p - 62); else { const int r = p - 78; qc = 32 - (r >> 1); pair = 2 * q + (r & 1); }
            if (su >= 0) { const int sb = su >> 2, kvh = su & 3; U.Kb = KS + (size_t)sb * TKS * 1024 + kvh * 256; U.Vt = VTS + (size_t)(sb * 4 + kvh) * 256 * TKS; U.ldv = TKS; U.ntiles = TKS / 64; U.qrow0 = MP + sb * TS; U.kvh = kvh; }
            else { const int b = pair >> 2, kvh = pair & 3; U.Kb = KP + (size_t)b * TP * 1024 + kvh * 256; U.Vt = VTP + (size_t)(b * 4 + kvh) * 256 * TP; U.ldv = TP; U.ntiles = qc + 1; U.qrow0 = b * TP + qc * 64; U.kvh = kvh; }
            att::attn_unit(lds, U, QB, CAT, subln_g, lam);
        }
#endif
      }
        if (BOTH(2)) GRID_BAR();
    }

    if (IN(3)) {
        pg8::Gemm g{CAT, WOUT, M, D, D, D}; pg8::StaticOrder S; S.init(M, D, G, bx);
        pg8::EpiRes1 E{x_prompt, x_sample, HN, RSS1};
        pg8::gemm_phase<pg8::EpiRes1, pg8::StaticOrder, PG8_ALIGN, PG8_SP2>(lds, g, S, E);
        {
            const int nfull = (72 * 16) % G, nidle = G - nfull;
            if (nfull > 0 && bx >= nfull) { LAS float* scr = (LAS float*)(lds + wave * 16384);
                for (int it = (bx - nfull) * NWAVES + wave; it < 256 * 128; it += nidle * NWAVES) tr_matrix_item(w_down, DFF, D, D, WDN, DFF, scr, it, lane, nullptr); }
            else if (nfull == 0) { LAS float* scr = (LAS float*)(lds + wave * 16384);
                for (int it = bx * NWAVES + wave; it < 256 * 128; it += G * NWAVES) tr_matrix_item(w_down, DFF, D, D, WDN, DFF, scr, it, lane, nullptr); } }
        if (BOTH(3)) GRID_BAR();
    }

    if (IN(4)) {
        pg8::Gemm g{HN, WUP, M, DFF, D, D}; pg8::StaticOrder S; S.init(M, DFF, G, bx);
        pg8::EpiUp E{Z};
        for (int rep4 = 0; rep4 < P4_REPS; ++rep4)
        pg8::gemm_phase<pg8::EpiUp, pg8::StaticOrder, PG8_ALIGN, PG8_SP2>(lds, g, S, E);
        if (BOTH(4)) GRID_BAR();
    }

    if (IN(5)) {
#define P5_SIGNAL(p) do { asm volatile("s_waitcnt vmcnt(0)" ::: "memory"); __syncthreads(); \
        if (tid == 0) { __builtin_amdgcn_fence(__ATOMIC_RELEASE, "agent"); asm volatile("s_waitcnt vmcnt(0)" ::: "memory"); (void)xb_add((unsigned*)(ctl + CW_P6) + (p), 1u); } } while (0)
        { const int hu = vcu, tile = hu >> 1, kh = hu & 1;
          pg8::Gemm g{Z + (size_t)MP * DFF + (size_t)kh * (DFF / 2), WDN + (size_t)kh * (DFF / 2), MS, D, DFF / 2, DFF};
          pg8::OneUnit S; S.u.pm = tile & 7; S.u.pn = tile >> 3; S.valid = (G == 256);
          pg8::EpiPart E{(float*)(ws + WS_SP) + (size_t)kh * MS * D, RSS1 + MP};
          pg8::gemm_phase<pg8::EpiPart, pg8::OneUnit, false, PG8_SP2>(lds, g, S, E); }
        P5_SIGNAL(64 * 8);
        { pg8::Gemm g{Z, WDN, MP, D, DFF, DFF}; pg8::StaticOrder S; S.init(MP, D, G, bx);
          pg8::EpiDown E{HN, RSS1};
          pg8::gemm_phase<pg8::EpiDown, pg8::StaticOrder, PG8_ALIGN, PG8_SP2>(lds, g, S, E); }
        P5_SIGNAL(64 * (bx & 7));
#undef P5_SIGNAL
        if (BOTH(5) && G != 256) GRID_BAR();
    }

    if (IN(6)) {
        const float* SP = (const float*)(ws + WS_SP);
#define P6_ROW(m_) do { const int m = (m_); \
            GAS f32x4* yr = (GAS f32x4*)(out + O_Y + (size_t)m * D) + lane; \
            const GAS v2u* hr = (const GAS v2u*)(HN + (size_t)m * D) + lane; \
            f32x4 v[16]; float s = 0.f; \
            _Pragma("unroll") for (int j = 0; j < 16; ++j) { const v2u hv = hr[64 * j]; v[j][0] = __builtin_bit_cast(float, hv.x << 16); v[j][1] = __builtin_bit_cast(float, hv.x & 0xffff0000u); v[j][2] = __builtin_bit_cast(float, hv.y << 16); v[j][3] = __builtin_bit_cast(float, hv.y & 0xffff0000u); } \
            if (m >= MP) { const GAS f32x4* p0 = (const GAS f32x4*)(SP + (size_t)(m - MP) * D) + lane; const GAS f32x4* p1 = (const GAS f32x4*)(SP + (size_t)(MS + m - MP) * D) + lane; \
                _Pragma("unroll") for (int j = 0; j < 16; ++j) v[j] = v[j] + p0[64 * j] + p1[64 * j]; } \
            _Pragma("unroll") for (int j = 0; j < 16; ++j) s += (v[j][0] * v[j][0] + v[j][1] * v[j][1]) + (v[j][2] * v[j][2] + v[j][3] * v[j][3]); \
            const float rstd = 1.0f / sqrtf(wave_sum(s) * (1.0f / D) + EPS); \
            _Pragma("unroll") for (int j = 0; j < 16; ++j) { const f32x4 gv = ((const GAS f32x4*)norm_final)[lane + 64 * j]; yr[64 * j] = v[j] * rstd * gv; } } while (0)
        if (G == 256) {
            unsigned* pc = (unsigned*)(ctl + CW_P6); unsigned* bw = (unsigned*)(ctl + CW_BAR);
            const unsigned myg = (unsigned)bx & 7u; unsigned pend = 0x1ffu;
            for (;;) {
                if (tid == 0) { unsigned res = 0xffffffffu, sp = 0u;
                    while (pend) {
                        for (unsigned k = 0; k < 9u; ++k) { const unsigned sx = (k == 0u) ? myg : (k == 1u) ? 8u : ((myg + k - 1u) & 7u);
                            if (!((pend >> sx) & 1u)) continue;
                            if (xb_ld(pc + 64 * sx) < (sx == 8u ? 256u : 32u)) continue;
                            const unsigned p = xb_add(pc + 1024 + 64 * sx, 1u);
                            if (p < 64u) { res = sx * 256u + p; break; } pend &= ~(1u << sx); }
                        if (res != 0xffffffffu || !pend) break;
                        __builtin_amdgcn_s_sleep(2);
                        if ((++sp & 255u) == 0u) { if (xb_ld(&bw[XB_TMO])) break; if (sp > XB_SPIN_CAP) { atomicAdd(&bw[XB_TMO], 1u); break; } } }
                    __builtin_amdgcn_fence(__ATOMIC_ACQUIRE, "agent"); asm volatile("s_waitcnt vmcnt(0)" ::: "memory");
                    MISC[16] = res; }
                LDS_WAIT(); RAW_BAR();
                const unsigned res = (unsigned)__builtin_amdgcn_readfirstlane((int)MISC[16]);
                LDS_WAIT(); RAW_BAR();
                if (res == 0xffffffffu) break;
                const int sx = (int)(res >> 8), r0 = (sx == 8 ? MP : sx * 2048) + 32 * (int)(res & 255u) + wave;
                P6_ROW(r0); P6_ROW(r0 + 8); P6_ROW(r0 + 16); P6_ROW(r0 + 24);
            }
        } else {
            const int gw = vcu * NWAVES + wave, NGW = G * NWAVES;
            for (int m2 = gw; m2 < M; m2 += NGW) P6_ROW(m2);
        }
#undef P6_ROW
    }
#undef IN
#undef BOTH
#undef GRID_BAR
}

extern "C" void kernel_launch(void* const* d_in, const int* in_sizes, int n_in, void* d_out, int out_size, void* d_ws, size_t ws_size, hipStream_t stream) {
    static int grid = 0;
    if (grid == 0) {
        if (n_in != 25 || in_sizes[0] != MP * D || (size_t)out_size != O_END || ws_size < WS_END) { fprintf(stderr, "kernel_launch: unexpected shapes (n_in %d, in0 %d, out %d, ws %zu); nothing launched\n", n_in, n_in > 0 ? in_sizes[0] : -1, out_size, ws_size); grid = -1; return; }
        int dev = 0, cus = 0, per_cu = 0;
        if (hipGetDevice(&dev) != hipSuccess || hipDeviceGetAttribute(&cus, hipDeviceAttributeMultiprocessorCount, dev) != hipSuccess) { grid = -1; return; }
        if (hipFuncSetAttribute((const void*)mega_fwd, hipFuncAttributeMaxDynamicSharedMemorySize, LDS_BYTES) != hipSuccess) { fprintf(stderr, "kernel_launch: hipFuncSetAttribute failed\n"); grid = -1; return; }
        if (hipOccupancyMaxActiveBlocksPerMultiprocessor(&per_cu, (const void*)mega_fwd, NWAVES * 64, LDS_BYTES) != hipSuccess || per_cu < 1) { fprintf(stderr, "kernel_launch: occupancy query reports %d workgroups per CU\n", per_cu); }
        (void)hipGetLastError();
        grid = cus;
        if (grid != 256) { fprintf(stderr, "kernel_launch: built for a 256-CU device (got %d); nothing launched\n", cus); grid = -1; return; }
    }
    if (grid < 0) return;
    if (hipMemsetAsync((char*)d_ws + WS_CTL, 0, CTL_ZERO_BYTES, stream) != hipSuccess) return;
    Args a{};
    for (int i = 0; i < 25; ++i) a.in[i] = (const float*)d_in[i];
    a.out = (float*)d_out; a.ws = (unsigned char*)d_ws;
#ifdef PROBE_SEQ
    const int seq[] = PROBE_SEQ; int nq = 0;
    for (int li = 0; li < (int)(sizeof(seq) / sizeof(seq[0])); ++li) {
        a.ph_lo = seq[li] % 10; a.ph_hi = seq[li] % 10 + 1; a.variant = seq[li] / 10; a.qslot = (seq[li] % 10 == 2) ? nq++ : 0;
#else
    for (int li = 0; li < N_LAUNCHES; ++li) {
        a.ph_lo = (N_LAUNCHES == 1) ? 0 : li; a.ph_hi = (N_LAUNCHES == 1) ? N_PHASES : li + 1;
#endif
        hipLaunchKernelGGL(mega_fwd, dim3(grid), dim3(NWAVES * 64), LDS_BYTES, stream, a);
        const hipError_t le = hipPeekAtLastError();
        if (le != hipSuccess) { fprintf(stderr, "kernel_launch: launch %d failed: %s\n", li, hipGetErrorName(le)); break; }
    }
}
```

```cpp
#include <hip/hip_runtime.h>
#include <cstdio>
#include <cstdint>
#ifndef PG8_WGM_XCD
#define PG8_WGM_XCD 1
#endif
#ifndef PG8_SUB9
#define PG8_SUB9 9
#endif
#ifndef PG8_SUB8
#define PG8_SUB8 8
#endif
namespace pg8 {
#define PG8_LAS __attribute__((address_space(3)))
typedef unsigned short bf16_t;
typedef short bf16x8 __attribute__((ext_vector_type(8)));
typedef float f32x4 __attribute__((ext_vector_type(4)));
typedef unsigned u32x4 __attribute__((ext_vector_type(4)));
constexpr int BM = 256, BK = 64, HALF = 128, HTB = HALF * BK * 2  , STAGE_BYTES = 8 * HTB, NXCD = 8, WGM = 8;

__host__ __device__ __forceinline__ int lds_byte(int r, int c) { const int st = (r >> 4) * 2 + (c >> 5), rr = r & 15, cc = c & 31, ob = rr * 64 + cc * 2; return st * 1024 + (ob ^ (((ob >> 9) & 1) << 5)); }
__host__ __device__ __forceinline__ void stage_rc(int b, int& R, int& C) { const int st = b / 1024, sb = b % 1024, swz = sb ^ (((sb >> 9) & 1) << 5); R = (st >> 1) * 16 + swz / 64; C = (st & 1) * 32 + (swz % 64) / 2; }
__host__ __device__ __forceinline__ int perm32(int rho) { const int n = rho >> 4, i = rho & 15; return 8 * (i >> 2) + 4 * n + (i & 3); }

struct Unit { int pm, pn; };
struct Gemm { const bf16_t* A; const bf16_t* Bt; int M, N, K, ld; };

struct StaticOrder {
    int nM, nN, nwg, G, c, wgm;
    __host__ __device__ void init(int M, int N, int G_, int c_) { nM = M / BM; nN = N / BM; nwg = nM * nN; G = G_; c = c_; wgm = (PG8_WGM_XCD && nM % NXCD == 0) ? nM / NXCD : WGM; if (PG8_WGM_XCD && nM % NXCD == 0 && nM / NXCD == 9) wgm = PG8_SUB9; if (PG8_WGM_XCD && nM % NXCD == 0 && nM / NXCD == 8) wgm = PG8_SUB8; }
    __host__ __device__ bool next(int i, Unit& u) const {
        const long L = (long)i * G + c; if (L >= nwg) return false;
        int wgid = (int)L; { const int q = nwg / NXCD, r = nwg % NXCD, xcd = wgid % NXCD, off = wgid / NXCD; wgid = (xcd < r ? xcd * (q + 1) : r * (q + 1) + (xcd - r) * q) + off; }
        const int nig = wgm * nN, gid = wgid / nig, fm = gid * wgm, gsz = (nM - fm) < wgm ? (nM - fm) : wgm;
        u.pm = fm + ((wgid % nig) % gsz); u.pn = (wgid % nig) / gsz; return true;
    }
    __device__ __forceinline__ void a_ready(const Unit&) const {}
    __device__ __forceinline__ void done(const Unit&) const {}
};

__device__ __forceinline__ unsigned cvt_pk_bf16(float lo, float hi) { unsigned r; asm volatile("v_cvt_pk_bf16_f32 %0, %1, %2" : "=v"(r) : "v"(lo), "v"(hi)); return r; }
typedef float f32x2 __attribute__((ext_vector_type(2)));
template <class Epi, class Sched, bool ALIGN_EPI = false, bool SP2 = false>
__device__ __forceinline__ void gemm_phase(PG8_LAS unsigned char* lds, const Gemm g, const Sched& S, const Epi& E) {
    const int tid = threadIdx.x, wid = __builtin_amdgcn_readfirstlane(tid >> 6), lane = tid & 63, wr = wid >> 2, wc = wid & 3, fr = lane & 15, fq = lane >> 4;
    const int K = g.ld, nt = g.K / BK;
    unsigned voffA[2], voffB[2];
#pragma unroll
    for (int i = 0; i < 2; ++i) { int R, C; stage_rc(tid * 16 + i * 8192, R, C); const int Rb = Epi::PERM ? ((R & ~31) + perm32(R & 31)) : R;
        voffA[i] = (unsigned)(R * K + C) * 2u; voffB[i] = (unsigned)(Rb * K + C) * 2u; }
    const size_t kstep = (size_t)(BK * 2);
    const size_t hstep = (size_t)HALF * K * 2;
    const size_t tstep = 2 * hstep;
    const unsigned ldsw = (unsigned)wid * 1024u;
    const int aoff = lds_byte(wr * 64 + fr, fq * 8), boff = lds_byte(wc * 32 + fr, fq * 8);
#define PG8_SA(b, h) (((b) * 2 + (h)) * HTB)
#define PG8_SB(b, h) ((4 + (b) * 2 + (h)) * HTB)
#define PG8_STAGE(bufoff, gbase, voff) do { _Pragma("unroll") for (int _i = 0; _i < 2; ++_i) \
        __builtin_amdgcn_global_load_lds((const unsigned*)((const char*)(gbase) + (voff)[_i]), (PG8_LAS unsigned*)(lds + (bufoff) + ldsw + _i * 8192), 16, 0, 0); } while (0)
#define PG8_LDA(dst, b, h) do { _Pragma("unroll") for (int m = 0; m < 4; ++m) _Pragma("unroll") for (int k = 0; k < 2; ++k) dst[m][k] = *(const PG8_LAS bf16x8*)(lds + PG8_SA(b, h) + aoff + m * 2048 + k * 1024); } while (0)
#define PG8_LDB(dst, b, h) do { _Pragma("unroll") for (int n = 0; n < 2; ++n) _Pragma("unroll") for (int k = 0; k < 2; ++k) dst[n][k] = *(const PG8_LAS bf16x8*)(lds + PG8_SB(b, h) + boff + n * 2048 + k * 1024); } while (0)
#ifndef PG8_MMA_ORDER
#define PG8_MMA_ORDER 0
#endif
#if PG8_MMA_ORDER == 0
#define PG8_MMA(ai, bj, At, Bt) do { __builtin_amdgcn_s_setprio(1); _Pragma("unroll") for (int m = 0; m < 4; ++m) _Pragma("unroll") for (int n = 0; n < 2; ++n) _Pragma("unroll") for (int k = 0; k < 2; ++k) \
        acc[ai][bj][m][n] = __builtin_amdgcn_mfma_f32_16x16x32_bf16(Bt[n][k], At[m][k], acc[ai][bj][m][n], 0, 0, 0); __builtin_amdgcn_s_setprio(0); } while (0)
#elif PG8_MMA_ORDER == 1
#define PG8_MMA(ai, bj, At, Bt) do { __builtin_amdgcn_s_setprio(1); _Pragma("unroll") for (int k = 0; k < 2; ++k) _Pragma("unroll") for (int n = 0; n < 2; ++n) _Pragma("unroll") for (int m = 0; m < 4; ++m) \
        acc[ai][bj][m][n] = __builtin_amdgcn_mfma_f32_16x16x32_bf16(Bt[n][k], At[m][k], acc[ai][bj][m][n], 0, 0, 0); __builtin_amdgcn_s_setprio(0); } while (0)
#elif PG8_MMA_ORDER == 3
#define PG8_MMA(ai, bj, At, Bt) do { __builtin_amdgcn_s_setprio(1); _Pragma("unroll") for (int n = 0; n < 2; ++n) _Pragma("unroll") for (int m = 0; m < 4; ++m) _Pragma("unroll") for (int k = 0; k < 2; ++k) \
        acc[ai][bj][m][n] = __builtin_amdgcn_mfma_f32_16x16x32_bf16(Bt[n][k], At[m][k], acc[ai][bj][m][n], 0, 0, 0); __builtin_amdgcn_s_setprio(0); } while (0)
#elif PG8_MMA_ORDER == 4
#define PG8_MMA(ai, bj, At, Bt) do { _Pragma("unroll") for (int m = 0; m < 4; ++m) _Pragma("unroll") for (int n = 0; n < 2; ++n) _Pragma("unroll") for (int k = 0; k < 2; ++k) \
        acc[ai][bj][m][n] = __builtin_amdgcn_mfma_f32_16x16x32_bf16(Bt[n][k], At[m][k], acc[ai][bj][m][n], 0, 0, 0); } while (0)
#else
#define PG8_MMA(ai, bj, At, Bt) do { __builtin_amdgcn_s_setprio(1); _Pragma("unroll") for (int k = 0; k < 2; ++k) _Pragma("unroll") for (int m = 0; m < 4; ++m) _Pragma("unroll") for (int n = 0; n < 2; ++n) \
        acc[ai][bj][m][n] = __builtin_amdgcn_mfma_f32_16x16x32_bf16(Bt[n][k], At[m][k], acc[ai][bj][m][n], 0, 0, 0); __builtin_amdgcn_s_setprio(0); } while (0)
#endif
#define PG8_WAIT_V(n) asm volatile("s_waitcnt vmcnt(" #n ")" ::: "memory")
#define PG8_WAIT_L(n) asm volatile("s_waitcnt lgkmcnt(" #n ")" ::: "memory")
#define PG8_BAR __builtin_amdgcn_s_barrier()
#define PG8_SCHED __builtin_amdgcn_sched_barrier(0)
    Unit cur, nxt; int ui = 0;
    if (!S.next(0, cur)) return;
    f32x4 acc[2][2][4][2];
#pragma unroll
    for (int a = 0; a < 2; ++a)
#pragma unroll
        for (int b = 0; b < 2; ++b)
#pragma unroll
            for (int m = 0; m < 4; ++m)
#pragma unroll
                for (int n = 0; n < 2; ++n) acc[a][b][m][n] = (f32x4){0.f, 0.f, 0.f, 0.f};
    bf16x8 At[4][2], B0[2][2], B1[2][2];
    const char* cA = (const char*)g.A + (size_t)cur.pm * tstep; const char* cB = (const char*)g.Bt + (size_t)cur.pn * tstep;
    S.a_ready(cur);
    if constexpr (SP2) {
        PG8_STAGE(PG8_SB(0, 0), cB, voffB); PG8_STAGE(PG8_SB(0, 1), cB + hstep, voffB); PG8_STAGE(PG8_SA(0, 0), cA, voffA); PG8_STAGE(PG8_SA(0, 1), cA + hstep, voffA);
        if (wr == 1) PG8_BAR;
        PG8_WAIT_V(2); PG8_BAR;
        PG8_STAGE(PG8_SB(1, 0), cB + kstep, voffB); PG8_STAGE(PG8_SA(1, 0), cA + kstep, voffA); PG8_STAGE(PG8_SB(1, 1), cB + hstep + kstep, voffB);
        PG8_WAIT_V(6); PG8_BAR;
    } else {
        PG8_STAGE(PG8_SB(0, 0), cB, voffB); PG8_STAGE(PG8_SA(0, 0), cA, voffA); PG8_STAGE(PG8_SB(0, 1), cB + hstep, voffB); PG8_STAGE(PG8_SA(0, 1), cA + hstep, voffA);
        if (wr == 1) PG8_BAR;
        PG8_WAIT_V(4); PG8_BAR;
        PG8_STAGE(PG8_SB(1, 0), cB + kstep, voffB); PG8_STAGE(PG8_SA(1, 0), cA + kstep, voffA); PG8_STAGE(PG8_SB(1, 1), cB + hstep + kstep, voffB);
        PG8_WAIT_V(6); PG8_BAR;
    }
    for (;;) {
        const bool has_next = S.next(ui + 1, nxt);
        const char* nA = has_next ? (const char*)g.A + (size_t)nxt.pm * tstep : cA; const char* nB = has_next ? (const char*)g.Bt + (size_t)nxt.pn * tstep : cB;
        for (int t = 0; t < nt; t += 2) {
            const bool last = (t == nt - 2);
            const char* a1 = cA + (size_t)(t + 1) * kstep;
            const char* a2 = last ? nA : cA + (size_t)(t + 2) * kstep; const char* b2 = last ? nB : cB + (size_t)(t + 2) * kstep;
            const char* a3 = a2 + kstep; const char* b3 = b2 + kstep;
            if (last && has_next) S.a_ready(nxt);
            if constexpr (SP2) {
            PG8_LDB(B0, 0, 0); PG8_LDB(B1, 0, 1); PG8_SCHED; PG8_LDA(At, 0, 0); PG8_STAGE(PG8_SA(1, 1), a1 + hstep, voffA);
            PG8_WAIT_V(8); PG8_WAIT_L(0); PG8_BAR; PG8_MMA(0, 0, At, B0); PG8_MMA(0, 1, At, B1); PG8_BAR; PG8_SCHED;
            PG8_LDA(At, 0, 1); PG8_STAGE(PG8_SB(0, 0), b2, voffB); PG8_STAGE(PG8_SB(0, 1), b2 + hstep, voffB); PG8_STAGE(PG8_SA(0, 0), a2, voffA);
            PG8_WAIT_V(8); PG8_WAIT_L(0); PG8_BAR; PG8_MMA(1, 0, At, B0); PG8_MMA(1, 1, At, B1); PG8_BAR; PG8_SCHED;
            PG8_LDB(B0, 1, 0); PG8_LDB(B1, 1, 1); PG8_SCHED; PG8_LDA(At, 1, 0); PG8_STAGE(PG8_SA(0, 1), a2 + hstep, voffA);
            PG8_WAIT_V(8); PG8_WAIT_L(0); PG8_BAR; PG8_MMA(0, 0, At, B0); PG8_MMA(0, 1, At, B1); PG8_BAR; PG8_SCHED;
            PG8_LDA(At, 1, 1); PG8_STAGE(PG8_SB(1, 0), b3, voffB); PG8_STAGE(PG8_SB(1, 1), b3 + hstep, voffB); PG8_STAGE(PG8_SA(1, 0), a3, voffA);
            PG8_WAIT_V(8); PG8_WAIT_L(0); PG8_BAR; PG8_MMA(1, 0, At, B0); PG8_MMA(1, 1, At, B1); PG8_BAR; PG8_SCHED;
            } else {
            PG8_LDB(B0, 0, 0); PG8_SCHED; PG8_LDA(At, 0, 0); PG8_STAGE(PG8_SA(1, 1), a1 + hstep, voffA);
            PG8_WAIT_L(8); PG8_BAR; PG8_WAIT_L(0); PG8_MMA(0, 0, At, B0); PG8_BAR; PG8_SCHED;
            PG8_LDB(B1, 0, 1); PG8_STAGE(PG8_SB(0, 0), b2, voffB);
            PG8_BAR; PG8_WAIT_L(0); PG8_MMA(0, 1, At, B1); PG8_BAR;
            PG8_LDA(At, 0, 1); PG8_STAGE(PG8_SA(0, 0), a2, voffA);
            PG8_BAR; PG8_WAIT_L(0); PG8_MMA(1, 0, At, B0); PG8_BAR; PG8_SCHED;
            PG8_STAGE(PG8_SB(0, 1), b2 + hstep, voffB);
            PG8_WAIT_V(6); PG8_BAR; PG8_MMA(1, 1, At, B1); PG8_BAR;
            PG8_LDB(B0, 1, 0); PG8_SCHED; PG8_LDA(At, 1, 0); PG8_STAGE(PG8_SA(0, 1), a2 + hstep, voffA);
            PG8_WAIT_L(8); PG8_BAR; PG8_WAIT_L(0); PG8_MMA(0, 0, At, B0); PG8_BAR; PG8_SCHED;
            PG8_LDB(B1, 1, 1); PG8_STAGE(PG8_SB(1, 0), b3, voffB);
            PG8_BAR; PG8_WAIT_L(0); PG8_MMA(0, 1, At, B1); PG8_BAR;
            PG8_LDA(At, 1, 1); PG8_STAGE(PG8_SA(1, 0), a3, voffA);
            PG8_BAR; PG8_WAIT_L(0); PG8_MMA(1, 0, At, B0); PG8_BAR; PG8_SCHED;
            PG8_STAGE(PG8_SB(1, 1), b3 + hstep, voffB);
            PG8_WAIT_V(6); PG8_BAR; PG8_MMA(1, 1, At, B1); PG8_BAR;
            }
        }
        if constexpr (ALIGN_EPI) { if (wr == 0) PG8_BAR; }
        if constexpr (!Epi::AFTER_DRAIN) { E(acc, cur, wr, wc, fr, fq); S.done(cur); }
        if (!has_next) break;
#pragma unroll
        for (int a = 0; a < 2; ++a)
#pragma unroll
            for (int b = 0; b < 2; ++b)
#pragma unroll
                for (int m = 0; m < 4; ++m)
#pragma unroll
                    for (int n = 0; n < 2; ++n) acc[a][b][m][n] = (f32x4){0.f, 0.f, 0.f, 0.f};
        cur = nxt; cA = nA; cB = nB; ++ui;
        if constexpr (ALIGN_EPI) { if (wr == 1) PG8_BAR; }
    }
    PG8_WAIT_V(0);
    if constexpr (!ALIGN_EPI) { if (wr == 0) PG8_BAR; }
    PG8_BAR;
    if constexpr (Epi::AFTER_DRAIN) { E.fused(acc, cur, wr, wc, fr, fq, lds, wid, lane); S.done(cur); }
#undef PG8_SA
#undef PG8_SB
#undef PG8_STAGE
#undef PG8_LDA
#undef PG8_LDB
#undef PG8_MMA
#undef PG8_WAIT_V
#undef PG8_WAIT_L
#undef PG8_BAR
#undef PG8_SCHED
}
}
#ifndef PG8_SP2
#define PG8_SP2 true
#endif
#ifndef PG8_ALIGN
#define PG8_ALIGN true
#endif

constexpr int NWAVES = 8;
#ifndef MK_N_LAUNCHES
#define MK_N_LAUNCHES 1
#endif
constexpr int N_PHASES = 7;
constexpr int N_LAUNCHES = MK_N_LAUNCHES;

constexpr int D = 4096, MP = 16384, MS = 2048, M = MP + MS;
constexpr int TP = 4096, TS = 64, PAST = 2048, TKS = PAST + TS;
constexpr int NIN = 8192, DFF = 16384, LW = 2048;
constexpr float EPS = 1e-6f;
constexpr float QSCALE = 0.08838834764831845f * 1.4426950408889634f;
constexpr float LAM_INIT = 0.2f;
constexpr size_t O_Y = 0, O_KP = 75497472, O_VP = 92274688, O_CP = 109051904, O_LP = 109076480, O_KS = 109084672, O_VS = 111181824, O_CS = 113278976, O_LS = 113475584, O_END = 113541120;

constexpr size_t MiB = 1u << 20;
constexpr size_t WS_CTL = 0, CTL_ZERO_BYTES = 1 * MiB;
constexpr size_t WS_TAB = 1 * MiB;
constexpr size_t WS_GWT = 2 * MiB;
constexpr size_t WS_WIN = 4 * MiB, WS_WOUT = 68 * MiB, WS_WUP = 100 * MiB, WS_WDN = 228 * MiB;
constexpr size_t WS_HN = 356 * MiB;
constexpr size_t WS_Z = 500 * MiB;
constexpr size_t WS_XN = 500 * MiB;
constexpr size_t WS_QB = 644 * MiB;
constexpr size_t WS_KP = 716 * MiB;
constexpr size_t WS_KS = 748 * MiB;
constexpr size_t WS_VTP = 880 * MiB;
constexpr size_t WS_VTS = 912 * MiB;
constexpr size_t WS_XR = 1044 * MiB;
constexpr size_t WS_GG = 1116 * MiB;
constexpr size_t WS_SP = 1080 * MiB;
constexpr size_t WS_END = 1188 * MiB;
constexpr int CW_TMO = 0, CW_CODE = 1, CW_QCTR = 64  , CW_BAR = 4096, CW_P6 = 8192  , CW_RSS1 = 16384  ;

constexpr int RING_BYTES = 131072, LDSCTL_OFF = RING_BYTES, MISC_OFF = LDSCTL_OFF + 320, LDSCTL_BYTES = 1024, QX_OFF = LDSCTL_OFF + LDSCTL_BYTES  , SUBG_OFF = QX_OFF + 16384  , LDS_BYTES = 151552;

#ifndef XHALF_PERMLANE
#define XHALF_PERMLANE 1
#endif
#define GAS __attribute__((address_space(1)))
#define LAS __attribute__((address_space(3)))
typedef unsigned short bf16;
typedef unsigned v4u __attribute__((ext_vector_type(4)));
typedef unsigned v2u __attribute__((ext_vector_type(2)));
typedef float f32x4 __attribute__((ext_vector_type(4)));
typedef float f32x16 __attribute__((ext_vector_type(16)));
typedef short bf16x8 __attribute__((ext_vector_type(8)));
typedef GAS unsigned gu32;
#define RLX_AGENT __ATOMIC_RELAXED, __HIP_MEMORY_SCOPE_AGENT
#define LDS_WAIT() asm volatile("s_waitcnt lgkmcnt(0)" ::: "memory")
#define VM_WAIT() asm volatile("s_waitcnt vmcnt(0)" ::: "memory")
#define RAW_BAR() __builtin_amdgcn_s_barrier()
__device__ __forceinline__ unsigned f2bf(float f) { unsigned u = __builtin_bit_cast(unsigned, f); return (u + 0x7fffu + ((u >> 16) & 1u)) >> 16; }
__device__ __forceinline__ unsigned pk2(float lo, float hi) { return f2bf(lo) | (f2bf(hi) << 16); }
typedef __bf16 hwbf16x2 __attribute__((ext_vector_type(2)));
typedef float f32x2v __attribute__((ext_vector_type(2)));
__device__ __forceinline__ unsigned cvt2bf(float lo, float hi) { const f32x2v v = {lo, hi}; return __builtin_bit_cast(unsigned, __builtin_convertvector(v, hwbf16x2)); }
__device__ __forceinline__ float xhalf_max(float v) {
#if XHALF_PERMLANE
    const unsigned u = __builtin_bit_cast(unsigned, v); const auto r = __builtin_amdgcn_permlane32_swap(u, u, false, false);
    return fmaxf(__builtin_bit_cast(float, r[0]), __builtin_bit_cast(float, r[1]));
#else
    return fmaxf(v, __shfl_xor(v, 32));
#endif
}
__device__ __forceinline__ float bf2f(unsigned short b) { return __builtin_bit_cast(float, (unsigned)b << 16); }
__device__ __forceinline__ float wave_sum(float v) {
#pragma unroll
    for (int o = 1; o < 64; o <<= 1) v += __shfl_xor(v, o);
    return v;
}

#define XB_TMO      128
#define XB_XCNT(j)  (256  + 64 * (j))
#define XB_XSUB(j)  (1280 + 64 * (j))
#define XB_XGEN(j)  (2304 + 64 * (j))
#define XB_TOP      3328
#define XB_TOPGEN   3392
#define XCD_BAR_WORDS 3456
#define XB_SPIN_CAP (1u << 18)

__device__ __forceinline__ unsigned xb_ld(unsigned* p)              { return __hip_atomic_load(p, __ATOMIC_RELAXED, __HIP_MEMORY_SCOPE_AGENT); }
__device__ __forceinline__ unsigned xb_add(unsigned* p, unsigned v) { return __hip_atomic_fetch_add(p, v, __ATOMIC_RELAXED, __HIP_MEMORY_SCOPE_AGENT); }
__device__ __forceinline__ unsigned xb_xcc_id() { return (unsigned)__builtin_amdgcn_s_getreg((3 << 11) | 20) & 0xFu; }
#define XB_SPIN(cond, bar) do { unsigned _sp = 0; while (cond) { __builtin_amdgcn_s_sleep(1); \
    if ((++_sp & 255u) == 0u) { if (xb_ld(&(bar)[XB_TMO])) break; if (_sp > XB_SPIN_CAP) { atomicAdd(&(bar)[XB_TMO], 1u); break; } } } } while (0)

struct XcdBarrier {
    unsigned* bar; unsigned x;
    volatile LAS unsigned* st;
};

__device__ __forceinline__ XcdBarrier xcd_barrier_post(unsigned* bar, volatile LAS unsigned* st) {
    XcdBarrier b; b.bar = bar; b.x = xb_xcc_id(); b.st = st;
    if (threadIdx.x == 0) (void)xb_add(&bar[XB_XCNT(b.x)], 1u);
    return b;
}
__device__ __forceinline__ void xcd_barrier_complete(unsigned* bar, unsigned x, unsigned& nloc, unsigned& nx) {
    const unsigned G = gridDim.x * gridDim.y * gridDim.z;
    unsigned sum, cnt, mine, sp = 0u;
    for (;;) {
        sum = 0u; cnt = 0u; mine = 0u;
#pragma unroll
        for (unsigned j = 0; j < 16; ++j) { const unsigned c = xb_ld(&bar[XB_XCNT(j)]); sum += c; cnt += (c > 0u) ? 1u : 0u; mine = (j == x) ? c : mine; }
        if (sum == G) break;
        __builtin_amdgcn_s_sleep(1);
        if ((++sp & 255u) == 0u) { if (xb_ld(&bar[XB_TMO])) break; if (sp > XB_SPIN_CAP) { atomicAdd(&bar[XB_TMO], 1u); break; } }
    }
    nloc = mine > 0u ? mine : 1u; nx = cnt > 0u ? cnt : 1u;
}

__device__ __forceinline__ void xcd_barrier(const XcdBarrier& b) {
    asm volatile("s_waitcnt vmcnt(0)" ::: "memory");
    __syncthreads();
    if (threadIdx.x == 0) {
        unsigned* bar = b.bar;
        __builtin_amdgcn_s_waitcnt(0);
        unsigned nloc = b.st[0], nx = b.st[1];
        if (nloc == 0u) { xcd_barrier_complete(bar, b.x, nloc, nx); b.st[0] = nloc; b.st[1] = nx; }
        const unsigned old = xb_add(&bar[XB_XSUB(b.x)], 1u);
        const unsigned gen = old / nloc;
        if (old + 1u == (gen + 1u) * nloc) {
            __builtin_amdgcn_fence(__ATOMIC_RELEASE, "agent");
            asm volatile("s_waitcnt vmcnt(0)" ::: "memory");
            const unsigned og = xb_add(&bar[XB_TOP], 1u);
            const unsigned tg = og / nx;
            if (og + 1u == (tg + 1u) * nx) xb_add(&bar[XB_TOPGEN], 1u);
            else XB_SPIN(xb_ld(&bar[XB_TOPGEN]) == tg, bar);
            __builtin_amdgcn_fence(__ATOMIC_ACQUIRE, "agent");
            xb_add(&bar[XB_XGEN(b.x)], 1u);
            asm volatile("s_waitcnt vmcnt(0)" ::: "memory");
        } else {
            XB_SPIN(xb_ld(&bar[XB_XGEN(b.x)]) == gen, bar);
            __builtin_amdgcn_fence(__ATOMIC_ACQUIRE, "agent");
            asm volatile("s_waitcnt vmcnt(0)" ::: "memory");
        }
    }
    __syncthreads();
}

struct Args { const float* in[25]; float* out; unsigned char* ws; int ph_lo, ph_hi, qslot, variant; };

namespace pg8 {
struct EpiProj {
    static constexpr bool PERM = true, AFTER_DRAIN = false;
    bf16_t *QB, *KP, *KS, *VTP, *VTS, *XR, *GG; float* out; const float* tab;
    __device__ __forceinline__ void operator()(const f32x4 (&acc)[2][2][4][2], const Unit& u, int wr, int wc, int fr, int fq) const {
        const int pn = u.pn; const bool prompt = u.pm < 64;
        const int rbase = u.pm * BM + wr * 64 + fr, cbase = wc * 32 + 8 * fq;
#pragma unroll
        for (int ai = 0; ai < 2; ++ai)
#pragma unroll
            for (int m = 0; m < 4; ++m) {
                const int r = rbase + ai * HALF + m * 16;
                f32x4 v[2][2];
#pragma unroll
                for (int bj = 0; bj < 2; ++bj)
#pragma unroll
                    for (int n = 0; n < 2; ++n) v[bj][n] = acc[ai][bj][m][n];
                if (pn < 12) {
                    if (wc == 0) {
                        const int pos = prompt ? (r & 4095) : (PAST + (r & 63));
                        const float* tc = tab + pos * 16 + 8 * (fq & 1);
#pragma unroll
                        for (int n = 0; n < 2; ++n) {
                            const f32x4 cs = *(const f32x4*)(tc + 4 * n), sn = *(const f32x4*)(tc + 65536 + 4 * n);
#pragma unroll
                            for (int bj = 0; bj < 2; ++bj) {
                                const f32x4 x = v[bj][n]; f32x4 p;
#pragma unroll
                                for (int i = 0; i < 4; ++i) p[i] = __shfl_xor(x[i], 32);
                                v[bj][n] = (fq < 2) ? (x * cs - p * sn) : (x * cs + p * sn);
                            }
                        }
                    }
                    if (pn < 8) {
                        bf16_t* dst = QB + (size_t)r * 2048 + pn * 256 + cbase;
#pragma unroll
                        for (int bj = 0; bj < 2; ++bj) { const f32x4 a = v[bj][0] * QSCALE, b = v[bj][1] * QSCALE; u32x4 w; w.x = cvt_pk_bf16(a[0], a[1]); w.y = cvt_pk_bf16(a[2], a[3]); w.z = cvt_pk_bf16(b[0], b[1]); w.w = cvt_pk_bf16(b[2], b[3]);
                            *(u32x4*)(dst + bj * HALF) = w; }
                    } else {
                        const int kvh = pn - 8;
                        float* fo = out + (prompt ? (O_KP + (size_t)r * 1024) : (O_KS + (size_t)(r - MP) * 1024)) + kvh * 256 + cbase;
                        bf16_t* dst = (prompt ? (KP + (size_t)r * 1024) : (KS + ((size_t)((r - MP) >> 6) * TKS + PAST + (r & 63)) * 1024)) + kvh * 256 + cbase;
#pragma unroll
                        for (int bj = 0; bj < 2; ++bj) { const f32x4 a = v[bj][0], b = v[bj][1]; *(f32x4*)(fo + bj * HALF) = a; *(f32x4*)(fo + bj * HALF + 4) = b;
                            u32x4 w; w.x = cvt_pk_bf16(a[0], a[1]); w.y = cvt_pk_bf16(a[2], a[3]); w.z = cvt_pk_bf16(b[0], b[1]); w.w = cvt_pk_bf16(b[2], b[3]); *(u32x4*)(dst + bj * HALF) = w; }
                    }
                } else if (pn < 16) {
                    const int kvh = pn - 12;
                    float* fo = out + (prompt ? (O_VP + (size_t)r * 1024) : (O_VS + (size_t)(r - MP) * 1024)) + kvh * 256 + cbase;
                    bf16_t* vt; size_t ldv;
                    if (prompt) { vt = VTP + ((size_t)((r >> 12) * 4 + kvh) * 256) * TP + (r & 4095); ldv = TP; }
                    else { vt = VTS + ((size_t)(((r - MP) >> 6) * 4 + kvh) * 256) * TKS + PAST + (r & 63); ldv = TKS; }
#pragma unroll
                    for (int bj = 0; bj < 2; ++bj) { const f32x4 a = v[bj][0], b = v[bj][1]; *(f32x4*)(fo + bj * HALF) = a; *(f32x4*)(fo + bj * HALF + 4) = b;
                        bf16_t* vp = vt + (size_t)(bj * HALF + cbase) * ldv;
#pragma unroll
                        for (int i = 0; i < 4; ++i) { vp[(size_t)i * ldv] = (bf16_t)f2bf(a[i]); vp[(size_t)(4 + i) * ldv] = (bf16_t)f2bf(b[i]); } }
                } else if (pn < 24) {
                    bf16_t* dst = XR + (size_t)r * 2048 + (pn - 16) * 256 + cbase;
#pragma unroll
                    for (int bj = 0; bj < 2; ++bj) { const f32x4 a = v[bj][0], b = v[bj][1]; u32x4 w; w.x = cvt_pk_bf16(a[0], a[1]); w.y = cvt_pk_bf16(a[2], a[3]); w.z = cvt_pk_bf16(b[0], b[1]); w.w = cvt_pk_bf16(b[2], b[3]);
                        *(u32x4*)(dst + bj * HALF) = w; }
                } else {
                    bf16_t* dst = GG + (size_t)r * 2048 + (pn - 24) * 256 + cbase;
#pragma unroll
                    for (int bj = 0; bj < 2; ++bj) { f32x4 a = v[bj][0], b = v[bj][1];
#pragma unroll
                        for (int i = 0; i < 4; ++i) { { const float x = a[i], y = 1.5957691216f * (x + 0.044715f * x * x * x); a[i] = x / (1.0f + __expf(-y)); }
                                                      { const float x = b[i], y = 1.5957691216f * (x + 0.044715f * x * x * x); b[i] = x / (1.0f + __expf(-y)); } }
                        u32x4 w; w.x = cvt_pk_bf16(a[0], a[1]); w.y = cvt_pk_bf16(a[2], a[3]); w.z = cvt_pk_bf16(b[0], b[1]); w.w = cvt_pk_bf16(b[2], b[3]); *(u32x4*)(dst + bj * HALF) = w; }
                }
            }
    }
};
struct EpiRes1 {
    static constexpr bool PERM = true, AFTER_DRAIN = false;
    const float *xp, *xs; bf16_t* HN; float* rss;
    __device__ __forceinline__ void operator()(const f32x4 (&acc)[2][2][4][2], const Unit& u, int wr, int wc, int fr, int fq) const {
        const int rbase = u.pm * BM + wr * 64 + fr, col0 = u.pn * BM + wc * 32 + 8 * fq; const bool prompt = u.pm < 64;
#pragma unroll
        for (int ai = 0; ai < 2; ++ai)
#pragma unroll
            for (int m = 0; m < 4; ++m) {
                const int r = rbase + ai * HALF + m * 16;
                const float* xr = (prompt ? xp + (size_t)r * D : xs + (size_t)(r - MP) * D) + col0;
                bf16_t* hb = HN + (size_t)r * D + col0; float ss = 0.f;
#pragma unroll
                for (int bj = 0; bj < 2; ++bj) { const f32x4 a = acc[ai][bj][m][0] + *(const f32x4*)(xr + bj * HALF), b = acc[ai][bj][m][1] + *(const f32x4*)(xr + bj * HALF + 4);
                    ss += (a[0] * a[0] + a[1] * a[1]) + (a[2] * a[2] + a[3] * a[3]) + (b[0] * b[0] + b[1] * b[1]) + (b[2] * b[2] + b[3] * b[3]);
                    u32x4 w; w.x = cvt_pk_bf16(a[0], a[1]); w.y = cvt_pk_bf16(a[2], a[3]); w.z = cvt_pk_bf16(b[0], b[1]); w.w = cvt_pk_bf16(b[2], b[3]); *(u32x4*)(hb + bj * HALF) = w; }
                ss += __shfl_xor(ss, 16); ss += __shfl_xor(ss, 32);
                if (fq == 0) atomicAdd(rss + r, ss);
            }
    }
};
struct EpiUp {
    static constexpr bool PERM = true, AFTER_DRAIN = false;
    bf16_t* Z;
    __device__ __forceinline__ void operator()(const f32x4 (&acc)[2][2][4][2], const Unit& u, int wr, int wc, int fr, int fq) const {
        const int rbase = u.pm * BM + wr * 64 + fr, col0 = u.pn * BM + wc * 32 + 8 * fq;
#pragma unroll
        for (int ai = 0; ai < 2; ++ai)
#pragma unroll
            for (int m = 0; m < 4; ++m) {
                bf16_t* dst = Z + (size_t)(rbase + ai * HALF + m * 16) * DFF + col0;
#pragma unroll
                for (int bj = 0; bj < 2; ++bj) { f32x4 a = acc[ai][bj][m][0], b = acc[ai][bj][m][1];
#pragma unroll
                    for (int i = 0; i < 4; ++i) { const float x = fmaxf(a[i], 0.f), y = fmaxf(b[i], 0.f); a[i] = x * x; b[i] = y * y; }
                    u32x4 w; w.x = cvt_pk_bf16(a[0], a[1]); w.y = cvt_pk_bf16(a[2], a[3]); w.z = cvt_pk_bf16(b[0], b[1]); w.w = cvt_pk_bf16(b[2], b[3]); *(u32x4*)(dst + bj * HALF) = w; }
            }
    }
};
struct EpiDown {
    static constexpr bool PERM = true, AFTER_DRAIN = false;
    bf16_t* h; const float* rss;
    __device__ __forceinline__ void operator()(const f32x4 (&acc)[2][2][4][2], const Unit& u, int wr, int wc, int fr, int fq) const {
        const int rbase = u.pm * BM + wr * 64 + fr, col0 = u.pn * BM + wc * 32 + 8 * fq;
#pragma unroll
        for (int ai = 0; ai < 2; ++ai)
#pragma unroll
            for (int m = 0; m < 4; ++m) {
                const int r = rbase + ai * HALF + m * 16;
                bf16_t* ho = h + (size_t)r * D + col0; const float sc = 1.0f / (rss[r] * (1.0f / D) + EPS);
#pragma unroll
                for (int bj = 0; bj < 2; ++bj) { const u32x4 hv = *(const u32x4*)(ho + bj * HALF);
                    f32x4 a = acc[ai][bj][m][0] * sc, b = acc[ai][bj][m][1] * sc;
                    a[0] += __builtin_bit_cast(float, hv.x << 16); a[1] += __builtin_bit_cast(float, hv.x & 0xffff0000u); a[2] += __builtin_bit_cast(float, hv.y << 16); a[3] += __builtin_bit_cast(float, hv.y & 0xffff0000u);
                    b[0] += __builtin_bit_cast(float, hv.z << 16); b[1] += __builtin_bit_cast(float, hv.z & 0xffff0000u); b[2] += __builtin_bit_cast(float, hv.w << 16); b[3] += __builtin_bit_cast(float, hv.w & 0xffff0000u);
                    u32x4 w; w.x = cvt_pk_bf16(a[0], a[1]); w.y = cvt_pk_bf16(a[2], a[3]); w.z = cvt_pk_bf16(b[0], b[1]); w.w = cvt_pk_bf16(b[2], b[3]); *(u32x4*)(ho + bj * HALF) = w; }
            }
    }
};
struct EpiPart {
    static constexpr bool PERM = true, AFTER_DRAIN = false;
    float* S; const float* rss;
    __device__ __forceinline__ void operator()(const f32x4 (&acc)[2][2][4][2], const Unit& u, int wr, int wc, int fr, int fq) const {
        const int rbase = u.pm * BM + wr * 64 + fr, col0 = u.pn * BM + wc * 32 + 8 * fq;
#pragma unroll
        for (int ai = 0; ai < 2; ++ai)
#pragma unroll
            for (int m = 0; m < 4; ++m) {
                const int r = rbase + ai * HALF + m * 16;
                float* so = S + (size_t)r * D + col0; const float sc = 1.0f / (rss[r] * (1.0f / D) + EPS);
#pragma unroll
                for (int bj = 0; bj < 2; ++bj) { *(f32x4*)(so + bj * HALF) = acc[ai][bj][m][0] * sc; *(f32x4*)(so + bj * HALF + 4) = acc[ai][bj][m][1] * sc; }
            }
    }
};
struct OneUnit {
    Unit u; bool valid;
    __device__ __forceinline__ bool next(int i, Unit& o) const { if (i > 0 || !valid) return false; o = u; return true; }
    __device__ __forceinline__ void a_ready(const Unit&) const {}
    __device__ __forceinline__ void done(const Unit&) const {}
};
}

__device__ __forceinline__ void tr_item(const float* W, int ldw, bf16* WT, size_t ldt, LAS float* scr, int k0, int n0, int lane, const float* kscale) {
#pragma unroll
    for (int i = 0; i < 8; ++i) { const int kk = 8 * i + (lane >> 3), c4 = 4 * (lane & 7); f32x4 v = *(const GAS f32x4*)(W + (size_t)(k0 + kk) * ldw + n0 + c4); if (kscale) v = v * kscale[k0 + kk];
        LAS float* d = scr + kk * 33 + c4; d[0] = v[0]; d[1] = v[1]; d[2] = v[2]; d[3] = v[3]; }
    LDS_WAIT(); asm volatile("" ::: "memory");
    const int c = lane & 7;
#pragma unroll
    for (int j = 0; j < 4; ++j) { const int n = (lane >> 3) + 8 * j; const LAS float* s = scr + (8 * c) * 33 + n;
        v4u o; o.x = pk2(s[0 * 33], s[1 * 33]); o.y = pk2(s[2 * 33], s[3 * 33]); o.z = pk2(s[4 * 33], s[5 * 33]); o.w = pk2(s[6 * 33], s[7 * 33]);
        *(GAS v4u*)(WT + (size_t)(n0 + n) * ldt + k0 + 8 * c) = o; }
    LDS_WAIT(); asm volatile("" ::: "memory");
}
__device__ __forceinline__ void tr_matrix_item(const float* W, int K, int N, int ldw, bf16* WT, size_t ldt, LAS float* scr, int item, int lane, const float* kscale) {
    const int nblk = N / 32, kb = item / nblk, nb = item % nblk; (void)K;
    tr_item(W, ldw, WT, ldt, scr, 64 * kb, 32 * nb, lane, kscale);
}
__device__ __forceinline__ void rope_entry(int idx, float* tab) {
    const float invt[16] = {1.0f, 0.44036659598350525f, 0.1939227432012558f, 0.08539710193872452f, 0.03760603070259094f, 0.016560440883040428f, 0.007292664609849453f, 0.0032114461064338684f,
                            0.0014142135623842478f, 0.0006227724370546639f, 0.00027424818836152554f, 0.00012076973507646471f, 5.3182957344688475e-05f, 2.34199997066753e-05f, 1.0313385246263351e-05f, 4.541670477919979e-06f};
    const int pos = idx >> 4, j = idx & 15;
    float inv = invt[0];
#pragma unroll
    for (int k = 1; k < 16; ++k) inv = (j == k) ? invt[k] : inv;
    const float angf = (float)pos * inv;
    const double x = (double)angf, q = __builtin_rint(x * 0.63661977236758134308), r = __builtin_fma(-q, 1.57079632679489661923, x) - q * 6.123233995736766e-17, r2 = r * r;
    double s = r2 * (1.0 / 6227020800.0) - 1.0 / 39916800.0; s = s * r2 + 1.0 / 362880.0; s = s * r2 - 1.0 / 5040.0; s = s * r2 + 1.0 / 120.0; s = s * r2 - 1.0 / 6.0; s = s * r2 * r + r;
    double c = r2 * (1.0 / 87178291200.0) - 1.0 / 479001600.0; c = c * r2 + 1.0 / 3628800.0; c = c * r2 - 1.0 / 40320.0; c = c * r2 + 1.0 / 720.0; c = c * r2 - 1.0 / 24.0; c = c * r2 + 0.5; c = 1.0 - c * r2;
    const int qi = ((int)q) & 3;
    const double sn = (qi == 0) ? s : (qi == 1) ? c : (qi == 2) ? -s : -c, cs = (qi == 0) ? c : (qi == 1) ? -s : (qi == 2) ? -c : s;
    tab[idx] = (float)cs; tab[65536 + idx] = (float)sn;
}

namespace att {
#ifndef ATT_QKD
#define ATT_QKD 2
#endif
#ifndef ATT_PVD
#define ATT_PVD 4
#endif
#ifndef ATT_SCHED_BETA
#define ATT_SCHED_BETA
#endif
constexpr int KT_BYTES = 32768, STAGE = 65536;
struct Unit { const bf16* Kb; const bf16* Vt; int ldv, ntiles, qrow0, kvh; };
__device__ __forceinline__ void attn_unit(LAS unsigned char* lds, const Unit& U, const bf16* QB, bf16* CAT, const float* subg, float lam) {
    int tid = threadIdx.x; asm volatile("" : "+v"(tid));
    const int lane = tid & 63, wid = __builtin_amdgcn_readfirstlane(tid >> 6);
    const int g = wid >> 2, c = (wid >> 1) & 1, qs = wid & 1, ql = lane & 31, h = lane >> 5;
    const int qrow = U.qrow0 + qs * 32 + ql;
    bf16x8 qf[6];
    LAS bf16x8* qx = (LAS bf16x8*)(lds + QX_OFF) + tid;
    { const bf16* qp = QB + (size_t)qrow * 2048 + (U.kvh * 2 + g) * 256 + c * 128 + 8 * h;
#pragma unroll
      for (int ks = 0; ks < 6; ++ks) qf[ks] = *(const GAS bf16x8*)(qp + 16 * ks);
      qx[0] = *(const GAS bf16x8*)(qp + 96); qx[512] = *(const GAS bf16x8*)(qp + 112); }
    const int kr = tid >> 5, kcc = (tid & 31) ^ (kr & 15);
    const unsigned koff = (unsigned)(kr * 1024 + kcc * 8) * 2u;
    const int ve = tid >> 3, vcc = (tid & 7) ^ ((ve >> 1) & 7);
    const unsigned voff = (unsigned)(ve * U.ldv + vcc * 8) * 2u;
    const char* kb0 = (const char*)U.Kb; const char* vb0 = (const char*)U.Vt;
    const size_t vstep = (size_t)128 * U.ldv;
#ifndef ATT_DMA_REP
#define ATT_DMA_REP 1
#endif
#define ATT_ISSUE_K(t, st) do { const char* kp_ = kb0 + (size_t)(t) * 131072; \
        _Pragma("unroll") for (int j2_ = 0; j2_ < 4 * ATT_DMA_REP; ++j2_) { const int j_ = j2_ & 3; __builtin_amdgcn_global_load_lds((const unsigned*)(kp_ + (size_t)j_ * 32768 + koff), (LAS unsigned*)(lds + (st) * STAGE + wid * 1024 + j_ * 8192), 16, 0, 0); } } while (0)
#define ATT_ISSUE_V(t, st) do { const char* vp_ = vb0 + (size_t)(t) * 128; \
        _Pragma("unroll") for (int j2_ = 0; j2_ < 4 * ATT_DMA_REP; ++j2_) { const int j_ = j2_ & 3; __builtin_amdgcn_global_load_lds((const unsigned*)(vp_ + j_ * vstep + voff), (LAS unsigned*)(lds + (st) * STAGE + KT_BYTES + wid * 1024 + j_ * 8192), 16, 0, 0); } } while (0)
    const int kap = (ql & 0x13) | ((ql & 4) << 1) | ((ql & 8) >> 1);
    const unsigned kaddr0 = (unsigned)(kap * 512 + c * 256 + 16 * ((kap & 15) ^ h));
    const unsigned vaddr0 = (unsigned)(KT_BYTES + ql * 128 + 16 * (((ql >> 1) & 7) ^ h));
    f32x16 O[8];
#pragma unroll
    for (int e = 0; e < 8; ++e)
#pragma unroll
        for (int i = 0; i < 16; ++i) O[e][i] = 0.f;
    float mrun = 0.f, lrun = 0.f;
    ATT_ISSUE_K(0, 0); ATT_ISSUE_V(0, 0);
    VM_WAIT(); RAW_BAR();
    if (g == 1) RAW_BAR();
    const int nt = U.ntiles;
    for (int t = 0; t < nt; ++t) {
        const int st = t & 1, tn = (t + 1 < nt) ? t + 1 : t;
        const unsigned ka = kaddr0 + (unsigned)st * STAGE, va = vaddr0 + (unsigned)st * STAGE;
        const unsigned ka5 = ka >> 5, kal = ka & 31u, va5 = va >> 5, val = va & 31u;
#define ATT_KF(beta, ks) (*(const LAS bf16x8*)(lds + ((((ka5 ^ (unsigned)(ks)) << 5) | kal) + 16384u * (beta))))
#define ATT_VF(e, s) (*(const LAS bf16x8*)(lds + ((((va5 ^ (unsigned)(s)) << 5) | val) + 4096u * (e))))
#pragma unroll
        for (int beta = 0; beta < 2; ++beta) {
            if (g == 1) __builtin_amdgcn_s_setprio(1);
            f32x16 S;
#pragma unroll
            for (int i = 0; i < 16; ++i) S[i] = -mrun;
            { bf16x8 kf[8];
#pragma unroll
              for (int ks = 0; ks < 8; ++ks) kf[ks] = ATT_KF(beta, ks);
#pragma unroll
              for (int ks = 0; ks < 8; ++ks) S = __builtin_amdgcn_mfma_f32_32x32x16_bf16(kf[ks], (ks < 6) ? qf[ks < 6 ? ks : 0] : qx[(ks - 6) * 512], S, 0, 0, 0);
              __builtin_amdgcn_sched_group_barrier(0x100, ATT_QKD + 2, 0);
#pragma unroll
              for (int ks = 0; ks < 8 - ATT_QKD; ++ks) { __builtin_amdgcn_sched_group_barrier(0x8, 1, 0); __builtin_amdgcn_sched_group_barrier(0x100, 1, 0); }
              __builtin_amdgcn_sched_group_barrier(0x8, ATT_QKD, 0); }
            float mx = fmaxf(fmaxf(S[0], S[1]), S[2]);
#pragma unroll
            for (int i = 3; i < 15; i += 2) mx = fmaxf(fmaxf(mx, S[i]), S[i + 1]);
            mx = fmaxf(mx, S[15]);
            mx = xhalf_max(mx);
            const bool first = (t == 0) && (beta == 0);
            if (first || __any(mx > 8.0f)) {
                const float d = first ? mx : fmaxf(mx, 0.f);
                if (!first) { const float al = __builtin_amdgcn_exp2f(-d); lrun *= al;
#pragma unroll
                    for (int e = 0; e < 8; ++e) O[e] = O[e] * al; }
                mrun += d;
#pragma unroll
                for (int i = 0; i < 16; ++i) S[i] -= d;
            }
            float ps = 0.f; bf16x8 pb[2];
#pragma unroll
            for (int j = 0; j < 2; ++j) { v4u w;
#pragma unroll
                for (int k = 0; k < 4; ++k) { const float p0 = __builtin_amdgcn_exp2f(S[8 * j + 2 * k]), p1 = __builtin_amdgcn_exp2f(S[8 * j + 2 * k + 1]); ps += p0 + p1; w[k] = cvt2bf(p0, p1); }
                pb[j] = __builtin_bit_cast(bf16x8, w); }
            lrun += ps;
            if (beta == 0) ATT_ISSUE_K(tn, st ^ 1);
            if (g == 1) __builtin_amdgcn_s_setprio(0);
            if (beta == 1) { if (ATT_DMA_REP == 1) asm volatile("s_waitcnt vmcnt(4)" ::: "memory"); else asm volatile("s_waitcnt vmcnt(8)" ::: "memory"); }
            LDS_WAIT(); RAW_BAR();
            { bf16x8 vf[8][2];
#pragma unroll
              for (int e = 0; e < 8; ++e)
#pragma unroll
                  for (int j = 0; j < 2; ++j) vf[e][j] = ATT_VF(e, 2 * beta + j);
#pragma unroll
              for (int e = 0; e < 8; ++e)
#pragma unroll
                  for (int j = 0; j < 2; ++j) O[e] = __builtin_amdgcn_mfma_f32_32x32x16_bf16(vf[e][j], pb[j], O[e], 0, 0, 0);
              __builtin_amdgcn_sched_group_barrier(0x100, ATT_PVD, 0);
#pragma unroll
              for (int e = 0; e < 16 - ATT_PVD; ++e) { __builtin_amdgcn_sched_group_barrier(0x8, 1, 0); __builtin_amdgcn_sched_group_barrier(0x100, 1, 0); }
              __builtin_amdgcn_sched_group_barrier(0x8, ATT_PVD, 0); }
            if (beta == 0) ATT_ISSUE_V(tn, st ^ 1);
            if (beta == 1) VM_WAIT();
            LDS_WAIT(); RAW_BAR();
        }
    }
    if (g == 0) RAW_BAR();
#undef ATT_KF
#undef ATT_VF
#undef ATT_ISSUE_K
#undef ATT_ISSUE_V
    lrun += __shfl_xor(lrun, 32);
    const float inv = 1.0f / lrun;
    LAS float* X = (LAS float*)(lds + (g * 2 + qs) * 32768);
    if (c == 1) {
#pragma unroll
        for (int e = 0; e < 8; ++e)
#pragma unroll
            for (int i = 0; i < 16; ++i) X[(e * 16 + i) * 64 + lane] = O[e][i] * inv;
    }
    LDS_WAIT(); RAW_BAR();
    if (c == 0) {
        float ss = 0.f;
#pragma unroll
        for (int e = 0; e < 8; ++e) {
#pragma unroll
            for (int i = 0; i < 16; ++i) { const float o = O[e][i] * inv - lam * X[(e * 16 + i) * 64 + lane]; O[e][i] = o; ss += o * o; }
            asm volatile("" : "+v"(ss) :: "memory"); }
        ss += __shfl_xor(ss, 32);
        const float rs = 1.0f / sqrtf(ss * (1.0f / 256.0f) + EPS);
        bf16* orow = CAT + (size_t)qrow * D + (U.kvh * 2 + g) * 256 + 4 * h;
#pragma unroll
        for (int e = 0; e < 8; ++e) {
#pragma unroll
            for (int i4 = 0; i4 < 4; ++i4) { const int e0 = 32 * e + 8 * i4; const f32x4 gv = *(const LAS f32x4*)(lds + SUBG_OFF + (e0 + 4 * h) * 4);
                v2u w; w.x = pk2(O[e][4 * i4] * rs * gv[0], O[e][4 * i4 + 1] * rs * gv[1]); w.y = pk2(O[e][4 * i4 + 2] * rs * gv[2], O[e][4 * i4 + 3] * rs * gv[3]);
                *(GAS v2u*)(orow + e0) = w; }
            asm volatile("" ::: "memory"); }
    }
    LDS_WAIT(); RAW_BAR();
}
}

namespace lru {
constexpr int XCB_PITCH = 272;
__device__ __forceinline__ float sigm(float x) { return __builtin_amdgcn_rcpf(1.0f + __expf(-x)); }
__device__ __forceinline__ float em1_small(float x) { float p = 1.0f / 5040.0f; p = p * x + 1.0f / 720.0f; p = p * x + 1.0f / 120.0f; p = p * x + 1.0f / 24.0f; p = p * x + 1.0f / 6.0f; p = p * x + 0.5f; p = p * x + 1.0f; return p * x; }
struct Job { int row0, n, nchunks; const float* cprev; const float* h0; float* conv_out; float* h_out; };
__device__ __forceinline__ void lru_chain(LAS unsigned char* lds, const Job& J, const bf16* XR, const bf16* GG, bf16* CAT, const bf16* GWT, const float* conv_w, const float* conv_b,
                                          const float* ga_b, const float* gx_b, const float* lam) {
    const int tid = threadIdx.x, lane = tid & 63, wid = __builtin_amdgcn_readfirstlane(tid >> 6);
    const int nl = lane & 15, g4 = lane >> 4, ch = 16 * wid + nl, gch = J.n * 128 + ch;
    LAS unsigned char* XCB = lds;
    const float w0 = conv_w[gch], w1 = conv_w[2048 + gch], w2 = conv_w[4096 + gch], w3 = conv_w[6144 + gch], cb = conv_b[gch];
    const float ba = ga_b[gch], bxv = gx_b[gch], sp = log1pf(__expf(-lam[gch]));
    bf16x8 bfr[2][4];
#pragma unroll
    for (int gt = 0; gt < 2; ++gt)
#pragma unroll
        for (int ks = 0; ks < 4; ++ks) bfr[gt][ks] = *(const GAS bf16x8*)(GWT + ((size_t)(J.n * 256 + gt * 128 + ch)) * 128 + 32 * ks + 8 * g4);
    float hin = J.h0 ? J.h0[gch] : 0.f;
    float x[19], ggv[16];
    { const bf16* xp = XR + (size_t)(J.row0 + 16 * g4 - 3) * 2048 + gch;
#pragma unroll
      for (int j = 0; j < 19; ++j) { if (j < 3) x[j] = (g4 == 0) ? (J.cprev ? J.cprev[j * 2048 + gch] : 0.f) : bf2f(xp[(size_t)j * 2048]); else x[j] = bf2f(xp[(size_t)j * 2048]); }
      const bf16* gp = GG + (size_t)(J.row0 + 16 * g4) * 2048 + gch;
#pragma unroll
      for (int i = 0; i < 16; ++i) ggv[i] = bf2f(gp[(size_t)i * 2048]); }
    for (int cs = 0; cs < J.nchunks; ++cs) {
        const int t0 = J.row0 + 64 * cs;
        float xc[16], gcur[16];
#pragma unroll
        for (int i = 0; i < 16; ++i) { float v = cb + x[i] * w0; v += x[i + 1] * w1; v += x[i + 2] * w2; v += x[i + 3] * w3; xc[i] = v; gcur[i] = ggv[i];
            *(LAS unsigned short*)(XCB + (16 * g4 + i) * XCB_PITCH + 2 * ch) = (unsigned short)f2bf(v); }
        if (cs == J.nchunks - 1 && g4 == 3) { J.conv_out[gch] = x[16]; J.conv_out[2048 + gch] = x[17]; J.conv_out[4096 + gch] = x[18]; }
        if (cs + 1 < J.nchunks) { const bf16* xp = XR + (size_t)(t0 + 64 + 16 * g4 - 3) * 2048 + gch;
#pragma unroll
            for (int j = 0; j < 19; ++j) x[j] = bf2f(xp[(size_t)j * 2048]);
            const bf16* gp = GG + (size_t)(t0 + 64 + 16 * g4) * 2048 + gch;
#pragma unroll
            for (int i = 0; i < 16; ++i) ggv[i] = bf2f(gp[(size_t)i * 2048]); }
        LDS_WAIT(); RAW_BAR();
        pg8::f32x4 acc[4][2];
        { const int trow = 16 * (nl >> 2) + (nl & 3);
#pragma unroll
          for (int rb = 0; rb < 4; ++rb) { acc[rb][0] = (pg8::f32x4){0.f, 0.f, 0.f, 0.f}; acc[rb][1] = (pg8::f32x4){0.f, 0.f, 0.f, 0.f};
#pragma unroll
              for (int ks = 0; ks < 4; ++ks) { const bf16x8 af = *(const LAS bf16x8*)(XCB + (trow + 4 * rb) * XCB_PITCH + (32 * ks + 8 * g4) * 2);
                  acc[rb][0] = __builtin_amdgcn_mfma_f32_16x16x32_bf16(af, bfr[0][ks], acc[rb][0], 0, 0, 0); acc[rb][1] = __builtin_amdgcn_mfma_f32_16x16x32_bf16(af, bfr[1][ks], acc[rb][1], 0, 0, 0); } } }
        LDS_WAIT(); RAW_BAR();
        float Hl[16], Pc[16]; float H = 0.f, P = 1.f;
#pragma unroll
        for (int rb = 0; rb < 4; ++rb)
#pragma unroll
            for (int i = 0; i < 4; ++i) { const int j = 4 * rb + i;
                const float r = sigm(acc[rb][0][i] + ba), ig = sigm(acc[rb][1][i] + bxv), la = -8.0f * r * sp, la2 = la + la;
                const float a = (la > -0.25f) ? 1.0f + em1_small(la) : __expf(la), m2 = (la2 > -0.25f) ? -em1_small(la2) : 1.0f - __expf(la2), u = __builtin_amdgcn_sqrtf(m2) * (ig * xc[j]);
                H = a * H + u; P *= a; Hl[j] = H; Pc[j] = P; }
        float Pt = 1.f, Ht = 0.f, Pp = 1.f, Hp = 0.f;
#pragma unroll
        for (int s = 0; s < 4; ++s) { const float ps = __shfl(P, nl + 16 * s), hs = __shfl(H, nl + 16 * s); if (s == g4) { Pp = Pt; Hp = Ht; } Ht = ps * Ht + hs; Pt *= ps; }
        { const float hs = Pp * hin + Hp;
          bf16* op = CAT + (size_t)(t0 + 16 * g4) * D + 2048 + gch;
#pragma unroll
          for (int j = 0; j < 16; ++j) op[(size_t)j * D] = (bf16)f2bf((Hl[j] + Pc[j] * hs) * gcur[j]); }
        hin = Pt * hin + Ht;
    }
    if (g4 == 0) J.h_out[gch] = hin;
}
}

__global__ void __launch_bounds__(NWAVES * 64, 2) mega_fwd(Args args) {
    extern __shared__ __attribute__((aligned(16))) unsigned char lds_raw[];
    LAS unsigned char* lds = (LAS unsigned char*)lds_raw;
    volatile LAS unsigned* MISC = (volatile LAS unsigned*)(lds + MISC_OFF);
    const int tid = threadIdx.x, lane = tid & 63, wave = __builtin_amdgcn_readfirstlane(tid >> 6);
    const int G = gridDim.x, bx = blockIdx.x;
    const int vcu = (G % 8 == 0) ? (bx % 8) * (G / 8) + bx / 8 : bx;
    unsigned char* ws = args.ws;
    gu32* ctl = (gu32*)(ws + WS_CTL);
    float* out = args.out;
    const float* x_prompt = args.in[0]; const float* x_sample = args.in[1]; const float* cache_k = args.in[2]; const float* cache_v = args.in[3];
    const float* state_conv = args.in[4]; const float* state_lru = args.in[5]; const float* norm_mix = args.in[6]; const float* w_in = args.in[7];
    const float* conv_w = args.in[8]; const float* conv_b = args.in[9]; const float* gate_a_w = args.in[10]; const float* gate_a_b = args.in[11];
    const float* gate_x_w = args.in[12]; const float* gate_x_b = args.in[13]; const float* lru_lambda = args.in[14];
    const float* lq1 = args.in[15]; const float* lk1 = args.in[16]; const float* lq2 = args.in[17]; const float* lk2 = args.in[18]; const float* subln_g = args.in[19];
    const float* w_out = args.in[20]; const float* norm_mlp = args.in[21]; const float* w_up = args.in[22]; const float* w_down = args.in[23]; const float* norm_final = args.in[24];
    bf16* WIN = (bf16*)(ws + WS_WIN); bf16* WOUT = (bf16*)(ws + WS_WOUT); bf16* WUP = (bf16*)(ws + WS_WUP); bf16* WDN = (bf16*)(ws + WS_WDN);
    bf16* HN = (bf16*)(ws + WS_HN); bf16* Z = (bf16*)(ws + WS_Z); bf16* XN = (bf16*)(ws + WS_XN); bf16* CAT = XN; bf16* QB = (bf16*)(ws + WS_QB);
    bf16* KP = (bf16*)(ws + WS_KP); bf16* KS = (bf16*)(ws + WS_KS); bf16* VTP = (bf16*)(ws + WS_VTP); bf16* VTS = (bf16*)(ws + WS_VTS);
    bf16* XR = (bf16*)(ws + WS_XR); bf16* GG = (bf16*)(ws + WS_GG); bf16* GWT = (bf16*)(ws + WS_GWT); float* TAB = (float*)(ws + WS_TAB);
    float* RSS1 = (float*)(ws + WS_CTL) + CW_RSS1;

    for (int u = tid; u < LDSCTL_BYTES / 4; u += NWAVES * 64) ((LAS unsigned*)(lds + LDSCTL_OFF))[u] = 0u;
    __syncthreads();
    XcdBarrier bar; bar.bar = (unsigned*)(ctl + CW_BAR); bar.x = 0; bar.st = nullptr;
    if (N_LAUNCHES == 1) bar = xcd_barrier_post((unsigned*)(ctl + CW_BAR), MISC + 8);
#define GRID_BAR() do { if (N_LAUNCHES == 1) xcd_barrier(bar); } while (0)
    const int lo = args.ph_lo, hi = args.ph_hi;
#ifndef PH_MASK
#define PH_MASK 0x7f
#endif
#define IN(k) (((PH_MASK >> (k)) & 1) && lo <= (k) && (k) < hi)
#define BOTH(k) (IN(k) && IN((k) + 1))

#ifndef P0_REPS
#define P0_REPS 1
#endif
#ifndef P2_REPS
#define P2_REPS 1
#endif
#ifndef P4_REPS
#define P4_REPS 1
#endif
    if (IN(0)) {
      for (int rep0 = 0; rep0 < P0_REPS; ++rep0) {
        LAS float* scr = (LAS float*)(lds + wave * 16384);
        const int gw = vcu * NWAVES + wave, NGW = G * NWAVES;
        constexpr int I_IN = 64 * 256, I_OUT = 64 * 128, I_UP = 64 * 512, I_CV = 128 * 256, I_GW = 32 * 8;
        constexpr int NITEMS = I_IN + I_OUT + I_UP + I_CV + I_GW;
        for (int it = gw; it < NITEMS; it += NGW) {
            int r = it;
            if (r < I_IN) { tr_matrix_item(w_in, D, NIN, NIN, WIN, D, scr, r, lane, nullptr); continue; } r -= I_IN;
            if (r < I_OUT) { tr_matrix_item(w_out, D, D, D, WOUT, D, scr, r, lane, nullptr); continue; } r -= I_OUT;
            if (r < I_UP) { tr_matrix_item(w_up, D, DFF, DFF, WUP, D, scr, r, lane, norm_mlp); continue; } r -= I_UP;
            if (r < I_CV) { const int sl = r >> 8, sb = sl >> 2, kvh = sl & 3;
                tr_matrix_item(cache_v + (size_t)sb * PAST * 1024 + kvh * 256, PAST, 256, 1024, VTS + (size_t)sl * 256 * TKS, TKS, scr, r & 255, lane, nullptr); continue; } r -= I_CV;
            { const int gi = r >> 3, gt = gi >> 4, nb = gi & 15;
              tr_matrix_item((gt ? gate_x_w : gate_a_w) + (size_t)nb * 16384, 128, 128, 128, GWT + (size_t)(nb * 256 + gt * 128) * 128, 128, scr, r & 7, lane, nullptr); }
        }
        for (int m = gw; m < M; m += NGW) {
            const GAS f32x4* xr = (const GAS f32x4*)(m < MP ? x_prompt + (size_t)m * D : x_sample + (size_t)(m - MP) * D) + lane;
            f32x4 v[16]; float s = 0.f;
#pragma unroll
            for (int j = 0; j < 16; ++j) { v[j] = xr[64 * j]; s += (v[j][0] * v[j][0] + v[j][1] * v[j][1]) + (v[j][2] * v[j][2] + v[j][3] * v[j][3]); }
            const float rstd = 1.0f / sqrtf(wave_sum(s) * (1.0f / D) + EPS);
            GAS v2u* o8 = (GAS v2u*)(XN + (size_t)m * D) + lane;
#pragma unroll
            for (int j = 0; j < 16; ++j) { const f32x4 gv = ((const GAS f32x4*)norm_mix)[lane + 64 * j]; v2u w; w.x = pk2(v[j][0] * rstd * gv[0], v[j][1] * rstd * gv[1]); w.y = pk2(v[j][2] * rstd * gv[2], v[j][3] * rstd * gv[3]); o8[64 * j] = w; }
        }
        for (int rr = gw; rr < 32 * PAST; rr += NGW) {
            const int sb = rr >> 11, t = rr & 2047;
            const GAS f32x4* src = (const GAS f32x4*)(cache_k + (size_t)rr * 1024); GAS v4u* dst = (GAS v4u*)(KS + ((size_t)sb * TKS + t) * 1024);
#pragma unroll
            for (int j = 0; j < 2; ++j) { const f32x4 a = src[j * 128 + lane * 2], b = src[j * 128 + lane * 2 + 1]; v4u w; w.x = pk2(a[0], a[1]); w.y = pk2(a[2], a[3]); w.z = pk2(b[0], b[1]); w.w = pk2(b[2], b[3]); dst[j * 64 + lane] = w; }
        }
        for (int jb = gw; jb < 1024; jb += NGW) rope_entry(jb * 64 + lane, TAB);
      }
        if (BOTH(0)) GRID_BAR();
    }

    if (IN(1)) {
        pg8::Gemm g{XN, WIN, M, NIN, D, D}; pg8::StaticOrder S; S.init(M, NIN, G, bx);
        pg8::EpiProj E{QB, KP, KS, VTP, VTS, XR, GG, out, TAB};
#ifndef P1_REPS
#define P1_REPS 1
#endif
        for (int rep1 = 0; rep1 < P1_REPS; ++rep1)
        pg8::gemm_phase<pg8::EpiProj, pg8::StaticOrder, PG8_ALIGN, PG8_SP2>(lds, g, S, E);
        if (BOTH(1)) GRID_BAR();
    }

    if (IN(2)) {
      for (int rep2 = 0; rep2 < P2_REPS; ++rep2) {
#ifndef P2_NO_LRU
        if (args.variant != 1) {
            lru::Job J;
            if (bx < 64) { const int b = bx >> 4;
                J.row0 = b * TP; J.n = bx & 15; J.nchunks = TP / 64; J.cprev = nullptr; J.h0 = nullptr; J.conv_out = out + O_CP + (size_t)b * 3 * LW; J.h_out = out + O_LP + (size_t)b * LW;
                lru::lru_chain(lds, J, XR, GG, CAT, GWT, conv_w, conv_b, gate_a_b, gate_x_b, lru_lambda);
            } else for (int v = bx - 64; v < 512; v += G - 64) { const int sb = v >> 4;
                J.row0 = MP + sb * TS; J.n = v & 15; J.nchunks = 1; J.cprev = state_conv + (size_t)sb * 3 * LW; J.h0 = state_lru + (size_t)sb * LW;
                J.conv_out = out + O_CS + (size_t)sb * 3 * LW; J.h_out = out + O_LS + (size_t)sb * LW;
                lru::lru_chain(lds, J, XR, GG, CAT, GWT, conv_w, conv_b, gate_a_b, gate_x_b, lru_lambda); }
        }
#endif
#ifndef P2_NO_ATT
        float lam;
        { const float d1 = wave_sum(lq1[lane] * lk1[lane] + lq1[lane + 64] * lk1[lane + 64]), d2 = wave_sum(lq2[lane] * lk2[lane] + lq2[lane + 64] * lk2[lane + 64]); lam = expf(d1) - expf(d2) + LAM_INIT; }
        if (tid < 256) ((LAS float*)(lds + SUBG_OFF))[tid] = subln_g[tid] * (1.0f - LAM_INIT);
        const unsigned myq = xb_xcc_id() & 7u; unsigned qdone = 0u;
        if (args.variant != 2)
        for (;;) {
            if (tid == 0) { unsigned res = 0xffffffffu;
                for (unsigned k = 0; k < 8u; ++k) { const unsigned q = (myq + k) & 7u; if ((qdone >> q) & 1u) continue;
                    const unsigned p = __hip_atomic_fetch_add((unsigned*)(ctl + CW_QCTR + 64 * (q + 8 * (rep2 + args.qslot))), 1u, RLX_AGENT);
                    if (p < 144u) { res = q * 256u + p; break; } qdone |= 1u << q; }
                MISC[16] = res; }
            LDS_WAIT(); RAW_BAR();
            const unsigned res = (unsigned)__builtin_amdgcn_readfirstlane((int)MISC[16]);
            LDS_WAIT(); RAW_BAR();
            if (res == 0xffffffffu) break;
            const int q = (int)(res >> 8), p = (int)(res & 255u);
            att::Unit U;
            int qc = -1, pair = 0, su = -1;
            if (p < 62) { qc = 63 - (p >> 1); pair = 2 * q + (p & 1); } else if (p < 78) su = 16 * q + (p - 62); else { const int r = p - 78; qc = 32 - (r >> 1); pair = 2 * q + (r & 1); }
            if (su >= 0) { const int sb = su >> 2, kvh = su & 3; U.Kb = KS + (size_t)sb * TKS * 1024 + kvh * 256; U.Vt = VTS + (size_t)(sb * 4 + kvh) * 256 * TKS; U.ldv = TKS; U.ntiles = TKS / 64; U.qrow0 = MP + sb * TS; U.kvh = kvh; }
            else { const int b = pair >> 2, kvh = pair & 3; U.Kb = KP + (size_t)b * TP * 1024 + kvh * 256; U.Vt = VTP + (size_t)(b * 4 + kvh) * 256 * TP; U.ldv = TP; U.ntiles = qc + 1; U.qrow0 = b * TP + qc * 64; U.kvh = kvh; }
            att::attn_unit(lds, U, QB, CAT, subln_g, lam);
        }
#endif
      }
        if (BOTH(2)) GRID_BAR();
    }

    if (IN(3)) {
        pg8::Gemm g{CAT, WOUT, M, D, D, D}; pg8::StaticOrder S; S.init(M, D, G, bx);
        pg8::EpiRes1 E{x_prompt, x_sample, HN, RSS1};
        pg8::gemm_phase<pg8::EpiRes1, pg8::StaticOrder, PG8_ALIGN, PG8_SP2>(lds, g, S, E);
        {
            const int nfull = (72 * 16) % G, nidle = G - nfull;
            if (nfull > 0 && bx >= nfull) { LAS float* scr = (LAS float*)(lds + wave * 16384);
                for (int it = (bx - nfull) * NWAVES + wave; it < 256 * 128; it += nidle * NWAVES) tr_matrix_item(w_down, DFF, D, D, WDN, DFF, scr, it, lane, nullptr); }
            else if (nfull == 0) { LAS float* scr = (LAS float*)(lds + wave * 16384);
                for (int it = bx * NWAVES + wave; it < 256 * 128; it += G * NWAVES) tr_matrix_item(w_down, DFF, D, D, WDN, DFF, scr, it, lane, nullptr); } }
        if (BOTH(3)) GRID_BAR();
    }

    if (IN(4)) {
        pg8::Gemm g{HN, WUP, M, DFF, D, D}; pg8::StaticOrder S; S.init(M, DFF, G, bx);
        pg8::EpiUp E{Z};
        for (int rep4 = 0; rep4 < P4_REPS; ++rep4)
        pg8::gemm_phase<pg8::EpiUp, pg8::StaticOrder, PG8_ALIGN, PG8_SP2>(lds, g, S, E);
        if (BOTH(4)) GRID_BAR();
    }

    if (IN(5)) {
#define P5_SIGNAL(p) do { asm volatile("s_waitcnt vmcnt(0)" ::: "memory"); __syncthreads(); \
        if (tid == 0) { __builtin_amdgcn_fence(__ATOMIC_RELEASE, "agent"); asm volatile("s_waitcnt vmcnt(0)" ::: "memory"); (void)xb_add((unsigned*)(ctl + CW_P6) + (p), 1u); } } while (0)
        { const int hu = vcu, tile = hu >> 1, kh = hu & 1;
          pg8::Gemm g{Z + (size_t)MP * DFF + (size_t)kh * (DFF / 2), WDN + (size_t)kh * (DFF / 2), MS, D, DFF / 2, DFF};
          pg8::OneUnit S; S.u.pm = tile & 7; S.u.pn = tile >> 3; S.valid = (G == 256);
          pg8::EpiPart E{(float*)(ws + WS_SP) + (size_t)kh * MS * D, RSS1 + MP};
          pg8::gemm_phase<pg8::EpiPart, pg8::OneUnit, false, PG8_SP2>(lds, g, S, E); }
        P5_SIGNAL(64 * 8);
        { pg8::Gemm g{Z, WDN, MP, D, DFF, DFF}; pg8::StaticOrder S; S.init(MP, D, G, bx);
          pg8::EpiDown E{HN, RSS1};
          pg8::gemm_phase<pg8::EpiDown, pg8::StaticOrder, PG8_ALIGN, PG8_SP2>(lds, g, S, E); }
        P5_SIGNAL(64 * (bx & 7));
#undef P5_SIGNAL
        if (BOTH(5) && G != 256) GRID_BAR();
    }

    if (IN(6)) {
        const float* SP = (const float*)(ws + WS_SP);
#define P6_ROW(m_) do { const int m = (m_); \
            GAS f32x4* yr = (GAS f32x4*)(out + O_Y + (size_t)m * D) + lane; \
            const GAS v2u* hr = (const GAS v2u*)(HN + (size_t)m * D) + lane; \
            f32x4 v[16]; float s = 0.f; \
            _Pragma("unroll") for (int j = 0; j < 16; ++j) { const v2u hv = hr[64 * j]; v[j][0] = __builtin_bit_cast(float, hv.x << 16); v[j][1] = __builtin_bit_cast(float, hv.x & 0xffff0000u); v[j][2] = __builtin_bit_cast(float, hv.y << 16); v[j][3] = __builtin_bit_cast(float, hv.y & 0xffff0000u); } \
            if (m >= MP) { const GAS f32x4* p0 = (const GAS f32x4*)(SP + (size_t)(m - MP) * D) + lane; const GAS f32x4* p1 = (const GAS f32x4*)(SP + (size_t)(MS + m - MP) * D) + lane; \
                _Pragma("unroll") for (int j = 0; j < 16; ++j) v[j] = v[j] + p0[64 * j] + p1[64 * j]; } \
            _Pragma("unroll") for (int j = 0; j < 16; ++j) s += (v[j][0] * v[j][0] + v[j][1] * v[j][1]) + (v[j][2] * v[j][2] + v[j][3] * v[j][3]); \
            const float rstd = 1.0f / sqrtf(wave_sum(s) * (1.0f / D) + EPS); \
            _Pragma("unroll") for (int j = 0; j < 16; ++j) { const f32x4 gv = ((const GAS f32x4*)norm_final)[lane + 64 * j]; yr[64 * j] = v[j] * rstd * gv; } } while (0)
        if (G == 256) {
            unsigned* pc = (unsigned*)(ctl + CW_P6); unsigned* bw = (unsigned*)(ctl + CW_BAR);
            const unsigned myg = (unsigned)bx & 7u; unsigned pend = 0x1ffu, cur = 9u, nxt = 0u;
            for (;;) {
                if (tid == 0) { unsigned res = 0xffffffffu, sp = 0u;
                    if (cur < 9u) { if (nxt < 128u) res = cur * 256u + nxt; else { pend &= ~(1u << cur); cur = 9u; } }
                    if (res == 0xffffffffu) {
                        while (pend) {
                            for (unsigned k = 0; k < 9u; ++k) { const unsigned sx = (k == 0u) ? myg : (k == 1u) ? 8u : ((myg + k - 1u) & 7u);
                                if (!((pend >> sx) & 1u)) continue;
                                if (xb_ld(pc + 64 * sx) < (sx == 8u ? 256u : 32u)) continue;
                                const unsigned p = xb_add(pc + 1024 + 64 * sx, 1u);
                                if (p < 128u) { res = sx * 256u + p; cur = sx; break; } pend &= ~(1u << sx); }
                            if (res != 0xffffffffu || !pend) break;
                            __builtin_amdgcn_s_sleep(2);
                            if ((++sp & 255u) == 0u) { if (xb_ld(&bw[XB_TMO])) break; if (sp > XB_SPIN_CAP) { atomicAdd(&bw[XB_TMO], 1u); break; } } }
                        __builtin_amdgcn_fence(__ATOMIC_ACQUIRE, "agent"); asm volatile("s_waitcnt vmcnt(0)" ::: "memory"); }
                    MISC[16] = res;
                    if (res != 0xffffffffu) nxt = xb_add(pc + 1024 + 64 * cur, 1u); }
                LDS_WAIT(); RAW_BAR();
                const unsigned res = (unsigned)__builtin_amdgcn_readfirstlane((int)MISC[16]);
                LDS_WAIT(); RAW_BAR();
                if (res == 0xffffffffu) break;
                const int sx = (int)(res >> 8), r0 = (sx == 8 ? MP : sx * 2048) + 16 * (int)(res & 255u) + wave;
                P6_ROW(r0); P6_ROW(r0 + 8);
            }
        } else {
            const int gw = vcu * NWAVES + wave, NGW = G * NWAVES;
            for (int m2 = gw; m2 < M; m2 += NGW) P6_ROW(m2);
        }
#undef P6_ROW
    }
#undef IN
#undef BOTH
#undef GRID_BAR
}

extern "C" void kernel_launch(void* const* d_in, const int* in_sizes, int n_in, void* d_out, int out_size, void* d_ws, size_t ws_size, hipStream_t stream) {
    static int grid = 0;
    if (grid == 0) {
        if (n_in != 25 || in_sizes[0] != MP * D || (size_t)out_size != O_END || ws_size < WS_END) { fprintf(stderr, "kernel_launch: unexpected shapes (n_in %d, in0 %d, out %d, ws %zu); nothing launched\n", n_in, n_in > 0 ? in_sizes[0] : -1, out_size, ws_size); grid = -1; return; }
        int dev = 0, cus = 0, per_cu = 0;
        if (hipGetDevice(&dev) != hipSuccess || hipDeviceGetAttribute(&cus, hipDeviceAttributeMultiprocessorCount, dev) != hipSuccess) { grid = -1; return; }
        if (hipFuncSetAttribute((const void*)mega_fwd, hipFuncAttributeMaxDynamicSharedMemorySize, LDS_BYTES) != hipSuccess) { fprintf(stderr, "kernel_launch: hipFuncSetAttribute failed\n"); grid = -1; return; }
        if (hipOccupancyMaxActiveBlocksPerMultiprocessor(&per_cu, (const void*)mega_fwd, NWAVES * 64, LDS_BYTES) != hipSuccess || per_cu < 1) { fprintf(stderr, "kernel_launch: occupancy query reports %d workgroups per CU\n", per_cu); }
        (void)hipGetLastError();
        grid = cus;
        if (grid != 256) { fprintf(stderr, "kernel_launch: built for a 256-CU device (got %d); nothing launched\n", cus); grid = -1; return; }
    }
    if (grid < 0) return;
    if (hipMemsetAsync((char*)d_ws + WS_CTL, 0, CTL_ZERO_BYTES, stream) != hipSuccess) return;
    Args a{};
    for (int i = 0; i < 25; ++i) a.in[i] = (const float*)d_in[i];
    a.out = (float*)d_out; a.ws = (unsigned char*)d_ws;
#ifdef PROBE_SEQ
    const int seq[] = PROBE_SEQ; int nq = 0;
    for (int li = 0; li < (int)(sizeof(seq) / sizeof(seq[0])); ++li) {
        a.ph_lo = seq[li] % 10; a.ph_hi = seq[li] % 10 + 1; a.variant = seq[li] / 10; a.qslot = (seq[li] % 10 == 2) ? nq++ : 0;
#else
    for (int li = 0; li < N_LAUNCHES; ++li) {
        a.ph_lo = (N_LAUNCHES == 1) ? 0 : li; a.ph_hi = (N_LAUNCHES == 1) ? N_PHASES : li + 1;
#endif
        hipLaunchKernelGGL(mega_fwd, dim3(grid), dim3(NWAVES * 64), LDS_BYTES, stream, a);
        const hipError_t le = hipPeekAtLastError();
        if (le != hipSuccess) { fprintf(stderr, "kernel_launch: launch %d failed: %s\n", li, hipGetErrorName(le)); break; }
    }
}
```

```cpp
#include <hip/hip_runtime.h>
#include <cstdio>
#include <cstdint>
#ifndef PG8_WGM_XCD
#define PG8_WGM_XCD 1
#endif
#ifndef PG8_SUB9
#define PG8_SUB9 9
#endif
#ifndef PG8_SUB8
#define PG8_SUB8 8
#endif
namespace pg8 {
#define PG8_LAS __attribute__((address_space(3)))
typedef unsigned short bf16_t;
typedef short bf16x8 __attribute__((ext_vector_type(8)));
typedef float f32x4 __attribute__((ext_vector_type(4)));
typedef unsigned u32x4 __attribute__((ext_vector_type(4)));
constexpr int BM = 256, BK = 64, HALF = 128, HTB = HALF * BK * 2  , STAGE_BYTES = 8 * HTB, NXCD = 8, WGM = 8;

__host__ __device__ __forceinline__ int lds_byte(int r, int c) { const int st = (r >> 4) * 2 + (c >> 5), rr = r & 15, cc = c & 31, ob = rr * 64 + cc * 2; return st * 1024 + (ob ^ (((ob >> 9) & 1) << 5)); }
__host__ __device__ __forceinline__ void stage_rc(int b, int& R, int& C) { const int st = b / 1024, sb = b % 1024, swz = sb ^ (((sb >> 9) & 1) << 5); R = (st >> 1) * 16 + swz / 64; C = (st & 1) * 32 + (swz % 64) / 2; }
__host__ __device__ __forceinline__ int perm32(int rho) { const int n = rho >> 4, i = rho & 15; return 8 * (i >> 2) + 4 * n + (i & 3); }

struct Unit { int pm, pn; };
struct Gemm { const bf16_t* A; const bf16_t* Bt; int M, N, K, ld; };

struct StaticOrder {
    int nM, nN, nwg, G, c, wgm;
    __host__ __device__ void init(int M, int N, int G_, int c_) { nM = M / BM; nN = N / BM; nwg = nM * nN; G = G_; c = c_; wgm = (PG8_WGM_XCD && nM % NXCD == 0) ? nM / NXCD : WGM; if (PG8_WGM_XCD && nM % NXCD == 0 && nM / NXCD == 9) wgm = PG8_SUB9; if (PG8_WGM_XCD && nM % NXCD == 0 && nM / NXCD == 8) wgm = PG8_SUB8; }
    __host__ __device__ bool next(int i, Unit& u) const {
        const long L = (long)i * G + c; if (L >= nwg) return false;
        int wgid = (int)L; { const int q = nwg / NXCD, r = nwg % NXCD, xcd = wgid % NXCD, off = wgid / NXCD; wgid = (xcd < r ? xcd * (q + 1) : r * (q + 1) + (xcd - r) * q) + off; }
        const int nig = wgm * nN, gid = wgid / nig, fm = gid * wgm, gsz = (nM - fm) < wgm ? (nM - fm) : wgm;
        u.pm = fm + ((wgid % nig) % gsz); u.pn = (wgid % nig) / gsz; return true;
    }
    __device__ __forceinline__ void a_ready(const Unit&) const {}
    __device__ __forceinline__ void done(const Unit&) const {}
};

__device__ __forceinline__ unsigned cvt_pk_bf16(float lo, float hi) { unsigned r; asm volatile("v_cvt_pk_bf16_f32 %0, %1, %2" : "=v"(r) : "v"(lo), "v"(hi)); return r; }
typedef float f32x2 __attribute__((ext_vector_type(2)));
template <class Epi, class Sched, bool ALIGN_EPI = false, bool SP2 = false>
__device__ __forceinline__ void gemm_phase(PG8_LAS unsigned char* lds, const Gemm g, const Sched& S, const Epi& E) {
    const int tid = threadIdx.x, wid = __builtin_amdgcn_readfirstlane(tid >> 6), lane = tid & 63, wr = wid >> 2, wc = wid & 3, fr = lane & 15, fq = lane >> 4;
    const int K = g.ld, nt = g.K / BK;
    unsigned voffA[2], voffB[2];
#pragma unroll
    for (int i = 0; i < 2; ++i) { int R, C; stage_rc(tid * 16 + i * 8192, R, C); const int Rb = Epi::PERM ? ((R & ~31) + perm32(R & 31)) : R;
        voffA[i] = (unsigned)(R * K + C) * 2u; voffB[i] = (unsigned)(Rb * K + C) * 2u; }
    const size_t kstep = (size_t)(BK * 2);
    const size_t hstep = (size_t)HALF * K * 2;
    const size_t tstep = 2 * hstep;
    const unsigned ldsw = (unsigned)wid * 1024u;
    const int aoff = lds_byte(wr * 64 + fr, fq * 8), boff = lds_byte(wc * 32 + fr, fq * 8);
#define PG8_SA(b, h) (((b) * 2 + (h)) * HTB)
#define PG8_SB(b, h) ((4 + (b) * 2 + (h)) * HTB)
#define PG8_STAGE(bufoff, gbase, voff) do { _Pragma("unroll") for (int _i = 0; _i < 2; ++_i) \
        __builtin_amdgcn_global_load_lds((const unsigned*)((const char*)(gbase) + (voff)[_i]), (PG8_LAS unsigned*)(lds + (bufoff) + ldsw + _i * 8192), 16, 0, 0); } while (0)
#define PG8_LDA(dst, b, h) do { _Pragma("unroll") for (int m = 0; m < 4; ++m) _Pragma("unroll") for (int k = 0; k < 2; ++k) dst[m][k] = *(const PG8_LAS bf16x8*)(lds + PG8_SA(b, h) + aoff + m * 2048 + k * 1024); } while (0)
#define PG8_LDB(dst, b, h) do { _Pragma("unroll") for (int n = 0; n < 2; ++n) _Pragma("unroll") for (int k = 0; k < 2; ++k) dst[n][k] = *(const PG8_LAS bf16x8*)(lds + PG8_SB(b, h) + boff + n * 2048 + k * 1024); } while (0)
#ifndef PG8_MMA_ORDER
#define PG8_MMA_ORDER 0
#endif
#if PG8_MMA_ORDER == 0
#define PG8_MMA(ai, bj, At, Bt) do { __builtin_amdgcn_s_setprio(1); _Pragma("unroll") for (int m = 0; m < 4; ++m) _Pragma("unroll") for (int n = 0; n < 2; ++n) _Pragma("unroll") for (int k = 0; k < 2; ++k) \
        acc[ai][bj][m][n] = __builtin_amdgcn_mfma_f32_16x16x32_bf16(Bt[n][k], At[m][k], acc[ai][bj][m][n], 0, 0, 0); __builtin_amdgcn_s_setprio(0); } while (0)
#elif PG8_MMA_ORDER == 1
#define PG8_MMA(ai, bj, At, Bt) do { __builtin_amdgcn_s_setprio(1); _Pragma("unroll") for (int k = 0; k < 2; ++k) _Pragma("unroll") for (int n = 0; n < 2; ++n) _Pragma("unroll") for (int m = 0; m < 4; ++m) \
        acc[ai][bj][m][n] = __builtin_amdgcn_mfma_f32_16x16x32_bf16(Bt[n][k], At[m][k], acc[ai][bj][m][n], 0, 0, 0); __builtin_amdgcn_s_setprio(0); } while (0)
#elif PG8_MMA_ORDER == 3
#define PG8_MMA(ai, bj, At, Bt) do { __builtin_amdgcn_s_setprio(1); _Pragma("unroll") for (int n = 0; n < 2; ++n) _Pragma("unroll") for (int m = 0; m < 4; ++m) _Pragma("unroll") for (int k = 0; k < 2; ++k) \
        acc[ai][bj][m][n] = __builtin_amdgcn_mfma_f32_16x16x32_bf16(Bt[n][k], At[m][k], acc[ai][bj][m][n], 0, 0, 0); __builtin_amdgcn_s_setprio(0); } while (0)
#elif PG8_MMA_ORDER == 4
#define PG8_MMA(ai, bj, At, Bt) do { _Pragma("unroll") for (int m = 0; m < 4; ++m) _Pragma("unroll") for (int n = 0; n < 2; ++n) _Pragma("unroll") for (int k = 0; k < 2; ++k) \
        acc[ai][bj][m][n] = __builtin_amdgcn_mfma_f32_16x16x32_bf16(Bt[n][k], At[m][k], acc[ai][bj][m][n], 0, 0, 0); } while (0)
#else
#define PG8_MMA(ai, bj, At, Bt) do { __builtin_amdgcn_s_setprio(1); _Pragma("unroll") for (int k = 0; k < 2; ++k) _Pragma("unroll") for (int m = 0; m < 4; ++m) _Pragma("unroll") for (int n = 0; n < 2; ++n) \
        acc[ai][bj][m][n] = __builtin_amdgcn_mfma_f32_16x16x32_bf16(Bt[n][k], At[m][k], acc[ai][bj][m][n], 0, 0, 0); __builtin_amdgcn_s_setprio(0); } while (0)
#endif
#define PG8_WAIT_V(n) asm volatile("s_waitcnt vmcnt(" #n ")" ::: "memory")
#define PG8_WAIT_L(n) asm volatile("s_waitcnt lgkmcnt(" #n ")" ::: "memory")
#define PG8_BAR __builtin_amdgcn_s_barrier()
#define PG8_SCHED __builtin_amdgcn_sched_barrier(0)
    Unit cur, nxt; int ui = 0;
    if (!S.next(0, cur)) return;
    f32x4 acc[2][2][4][2];
#pragma unroll
    for (int a = 0; a < 2; ++a)
#pragma unroll
        for (int b = 0; b < 2; ++b)
#pragma unroll
            for (int m = 0; m < 4; ++m)
#pragma unroll
                for (int n = 0; n < 2; ++n) acc[a][b][m][n] = (f32x4){0.f, 0.f, 0.f, 0.f};
    bf16x8 At[4][2], B0[2][2], B1[2][2];
    const char* cA = (const char*)g.A + (size_t)cur.pm * tstep; const char* cB = (const char*)g.Bt + (size_t)cur.pn * tstep;
    S.a_ready(cur);
    if constexpr (SP2) {
        PG8_STAGE(PG8_SB(0, 0), cB, voffB); PG8_STAGE(PG8_SB(0, 1), cB + hstep, voffB); PG8_STAGE(PG8_SA(0, 0), cA, voffA); PG8_STAGE(PG8_SA(0, 1), cA + hstep, voffA);
        if (wr == 1) PG8_BAR;
        PG8_WAIT_V(2); PG8_BAR;
        PG8_STAGE(PG8_SB(1, 0), cB + kstep, voffB); PG8_STAGE(PG8_SA(1, 0), cA + kstep, voffA); PG8_STAGE(PG8_SB(1, 1), cB + hstep + kstep, voffB);
        PG8_WAIT_V(6); PG8_BAR;
    } else {
        PG8_STAGE(PG8_SB(0, 0), cB, voffB); PG8_STAGE(PG8_SA(0, 0), cA, voffA); PG8_STAGE(PG8_SB(0, 1), cB + hstep, voffB); PG8_STAGE(PG8_SA(0, 1), cA + hstep, voffA);
        if (wr == 1) PG8_BAR;
        PG8_WAIT_V(4); PG8_BAR;
        PG8_STAGE(PG8_SB(1, 0), cB + kstep, voffB); PG8_STAGE(PG8_SA(1, 0), cA + kstep, voffA); PG8_STAGE(PG8_SB(1, 1), cB + hstep + kstep, voffB);
        PG8_WAIT_V(6); PG8_BAR;
    }
    for (;;) {
        const bool has_next = S.next(ui + 1, nxt);
        const char* nA = has_next ? (const char*)g.A + (size_t)nxt.pm * tstep : cA; const char* nB = has_next ? (const char*)g.Bt + (size_t)nxt.pn * tstep : cB;
        for (int t = 0; t < nt; t += 2) {
            const bool last = (t == nt - 2);
            const char* a1 = cA + (size_t)(t + 1) * kstep;
            const char* a2 = last ? nA : cA + (size_t)(t + 2) * kstep; const char* b2 = last ? nB : cB + (size_t)(t + 2) * kstep;
            const char* a3 = a2 + kstep; const char* b3 = b2 + kstep;
            if (last && has_next) S.a_ready(nxt);
            if constexpr (SP2) {
            PG8_LDB(B0, 0, 0); PG8_LDB(B1, 0, 1); PG8_SCHED; PG8_LDA(At, 0, 0); PG8_STAGE(PG8_SA(1, 1), a1 + hstep, voffA);
            PG8_WAIT_V(8); PG8_WAIT_L(0); PG8_BAR; PG8_MMA(0, 0, At, B0); PG8_MMA(0, 1, At, B1); PG8_BAR; PG8_SCHED;
            PG8_LDA(At, 0, 1); PG8_STAGE(PG8_SB(0, 0), b2, voffB); PG8_STAGE(PG8_SB(0, 1), b2 + hstep, voffB); PG8_STAGE(PG8_SA(0, 0), a2, voffA);
            PG8_WAIT_V(8); PG8_WAIT_L(0); PG8_BAR; PG8_MMA(1, 0, At, B0); PG8_MMA(1, 1, At, B1); PG8_BAR; PG8_SCHED;
            PG8_LDB(B0, 1, 0); PG8_LDB(B1, 1, 1); PG8_SCHED; PG8_LDA(At, 1, 0); PG8_STAGE(PG8_SA(0, 1), a2 + hstep, voffA);
            PG8_WAIT_V(8); PG8_WAIT_L(0); PG8_BAR; PG8_MMA(0, 0, At, B0); PG8_MMA(0, 1, At, B1); PG8_BAR; PG8_SCHED;
            PG8_LDA(At, 1, 1); PG8_STAGE(PG8_SB(1, 0), b3, voffB); PG8_STAGE(PG8_SB(1, 1), b3 + hstep, voffB); PG8_STAGE(PG8_SA(1, 0), a3, voffA);
            PG8_WAIT_V(8); PG8_WAIT_L(0); PG8_BAR; PG8_MMA(1, 0, At, B0); PG8_MMA(1, 1, At, B1); PG8_BAR; PG8_SCHED;
            } else {
            PG8_LDB(B0, 0, 0); PG8_SCHED; PG8_LDA(At, 0, 0); PG8_STAGE(PG8_SA(1, 1), a1 + hstep, voffA);
            PG8_WAIT_L(8); PG8_BAR; PG8_WAIT_L(0); PG8_MMA(0, 0, At, B0); PG8_BAR; PG8_SCHED;
            PG8_LDB(B1, 0, 1); PG8_STAGE(PG8_SB(0, 0), b2, voffB);
            PG8_BAR; PG8_WAIT_L(0); PG8_MMA(0, 1, At, B1); PG8_BAR;
            PG8_LDA(At, 0, 1); PG8_STAGE(PG8_SA(0, 0), a2, voffA);
            PG8_BAR; PG8_WAIT_L(0); PG8_MMA(1, 0, At, B0); PG8_BAR; PG8_SCHED;
            PG8_STAGE(PG8_SB(0, 1), b2 + hstep, voffB);
            PG8_WAIT_V(6); PG8_BAR; PG8_MMA(1, 1, At, B1); PG8_BAR;
            PG8_LDB(B0, 1, 0); PG8_SCHED; PG8_LDA(At, 1, 0); PG8_STAGE(PG8_SA(0, 1), a2 + hstep, voffA);
            PG8_WAIT_L(8); PG8_BAR; PG8_WAIT_L(0); PG8_MMA(0, 0, At, B0); PG8_BAR; PG8_SCHED;
            PG8_LDB(B1, 1, 1); PG8_STAGE(PG8_SB(1, 0), b3, voffB);
            PG8_BAR; PG8_WAIT_L(0); PG8_MMA(0, 1, At, B1); PG8_BAR;
            PG8_LDA(At, 1, 1); PG8_STAGE(PG8_SA(1, 0), a3, voffA);
            PG8_BAR; PG8_WAIT_L(0); PG8_MMA(1, 0, At, B0); PG8_BAR; PG8_SCHED;
            PG8_STAGE(PG8_SB(1, 1), b3 + hstep, voffB);
            PG8_WAIT_V(6); PG8_BAR; PG8_MMA(1, 1, At, B1); PG8_BAR;
            }
        }
        if constexpr (ALIGN_EPI) { if (wr == 0) PG8_BAR; }
        if constexpr (!Epi::AFTER_DRAIN) { E(acc, cur, wr, wc, fr, fq); S.done(cur); }
        if (!has_next) break;
#pragma unroll
        for (int a = 0; a < 2; ++a)
#pragma unroll
            for (int b = 0; b < 2; ++b)
#pragma unroll
                for (int m = 0; m < 4; ++m)
#pragma unroll
                    for (int n = 0; n < 2; ++n) acc[a][b][m][n] = (f32x4){0.f, 0.f, 0.f, 0.f};
        cur = nxt; cA = nA; cB = nB; ++ui;
        if constexpr (ALIGN_EPI) { if (wr == 1) PG8_BAR; }
    }
    PG8_WAIT_V(0);
    if constexpr (!ALIGN_EPI) { if (wr == 0) PG8_BAR; }
    PG8_BAR;
    if constexpr (Epi::AFTER_DRAIN) { E.fused(acc, cur, wr, wc, fr, fq, lds, wid, lane); S.done(cur); }
#undef PG8_SA
#undef PG8_SB
#undef PG8_STAGE
#undef PG8_LDA
#undef PG8_LDB
#undef PG8_MMA
#undef PG8_WAIT_V
#undef PG8_WAIT_L
#undef PG8_BAR
#undef PG8_SCHED
}
}
#ifndef PG8_SP2
#define PG8_SP2 true
#endif
#ifndef PG8_ALIGN
#define PG8_ALIGN true
#endif

constexpr int NWAVES = 8;
#ifndef MK_N_LAUNCHES
#define MK_N_LAUNCHES 1
#endif
constexpr int N_PHASES = 7;
constexpr int N_LAUNCHES = MK_N_LAUNCHES;

constexpr int D = 4096, MP = 16384, MS = 2048, M = MP + MS;
constexpr int TP = 4096, TS = 64, PAST = 2048, TKS = PAST + TS;
constexpr int NIN = 8192, DFF = 16384, LW = 2048;
constexpr float EPS = 1e-6f;
constexpr float QSCALE = 0.08838834764831845f * 1.4426950408889634f;
constexpr float LAM_INIT = 0.2f;
constexpr size_t O_Y = 0, O_KP = 75497472, O_VP = 92274688, O_CP = 109051904, O_LP = 109076480, O_KS = 109084672, O_VS = 111181824, O_CS = 113278976, O_LS = 113475584, O_END = 113541120;

constexpr size_t MiB = 1u << 20;
constexpr size_t WS_CTL = 0, CTL_ZERO_BYTES = 1 * MiB;
constexpr size_t WS_TAB = 1 * MiB;
constexpr size_t WS_GWT = 2 * MiB;
constexpr size_t WS_WIN = 4 * MiB, WS_WOUT = 68 * MiB, WS_WUP = 100 * MiB, WS_WDN = 228 * MiB;
constexpr size_t WS_HN = 356 * MiB;
constexpr size_t WS_Z = 500 * MiB;
constexpr size_t WS_XN = 500 * MiB;
constexpr size_t WS_QB = 644 * MiB;
constexpr size_t WS_KP = 716 * MiB;
constexpr size_t WS_KS = 748 * MiB;
constexpr size_t WS_VTP = 880 * MiB;
constexpr size_t WS_VTS = 912 * MiB;
constexpr size_t WS_XR = 1044 * MiB;
constexpr size_t WS_GG = 1116 * MiB;
constexpr size_t WS_SP = 1080 * MiB;
constexpr size_t WS_END = 1188 * MiB;
constexpr int CW_TMO = 0, CW_CODE = 1, CW_QCTR = 64  , CW_BAR = 4096, CW_P6 = 8192  , CW_RSS1 = 16384  ;

constexpr int RING_BYTES = 131072, LDSCTL_OFF = RING_BYTES, MISC_OFF = LDSCTL_OFF + 320, LDSCTL_BYTES = 1024, QX_OFF = LDSCTL_OFF + LDSCTL_BYTES  , SUBG_OFF = QX_OFF + 16384  , LDS_BYTES = 151552;

#ifndef XHALF_PERMLANE
#define XHALF_PERMLANE 1
#endif
#define GAS __attribute__((address_space(1)))
#define LAS __attribute__((address_space(3)))
typedef unsigned short bf16;
typedef unsigned v4u __attribute__((ext_vector_type(4)));
typedef unsigned v2u __attribute__((ext_vector_type(2)));
typedef float f32x4 __attribute__((ext_vector_type(4)));
typedef float f32x16 __attribute__((ext_vector_type(16)));
typedef short bf16x8 __attribute__((ext_vector_type(8)));
typedef GAS unsigned gu32;
#define RLX_AGENT __ATOMIC_RELAXED, __HIP_MEMORY_SCOPE_AGENT
#define LDS_WAIT() asm volatile("s_waitcnt lgkmcnt(0)" ::: "memory")
#define VM_WAIT() asm volatile("s_waitcnt vmcnt(0)" ::: "memory")
#define RAW_BAR() __builtin_amdgcn_s_barrier()
__device__ __forceinline__ unsigned f2bf(float f) { unsigned u = __builtin_bit_cast(unsigned, f); return (u + 0x7fffu + ((u >> 16) & 1u)) >> 16; }
__device__ __forceinline__ unsigned pk2(float lo, float hi) { return f2bf(lo) | (f2bf(hi) << 16); }
typedef __bf16 hwbf16x2 __attribute__((ext_vector_type(2)));
typedef float f32x2v __attribute__((ext_vector_type(2)));
__device__ __forceinline__ unsigned cvt2bf(float lo, float hi) { const f32x2v v = {lo, hi}; return __builtin_bit_cast(unsigned, __builtin_convertvector(v, hwbf16x2)); }
__device__ __forceinline__ float xhalf_max(float v) {
#if XHALF_PERMLANE
    const unsigned u = __builtin_bit_cast(unsigned, v); const auto r = __builtin_amdgcn_permlane32_swap(u, u, false, false);
    return fmaxf(__builtin_bit_cast(float, r[0]), __builtin_bit_cast(float, r[1]));
#else
    return fmaxf(v, __shfl_xor(v, 32));
#endif
}
__device__ __forceinline__ float bf2f(unsigned short b) { return __builtin_bit_cast(float, (unsigned)b << 16); }
__device__ __forceinline__ float wave_sum(float v) {
#pragma unroll
    for (int o = 1; o < 64; o <<= 1) v += __shfl_xor(v, o);
    return v;
}

#define XB_TMO      128
#define XB_XCNT(j)  (256  + 64 * (j))
#define XB_XSUB(j)  (1280 + 64 * (j))
#define XB_XGEN(j)  (2304 + 64 * (j))
#define XB_TOP      3328
#define XB_TOPGEN   3392
#define XCD_BAR_WORDS 3456
#define XB_SPIN_CAP (1u << 18)

__device__ __forceinline__ unsigned xb_ld(unsigned* p)              { return __hip_atomic_load(p, __ATOMIC_RELAXED, __HIP_MEMORY_SCOPE_AGENT); }
__device__ __forceinline__ unsigned xb_add(unsigned* p, unsigned v) { return __hip_atomic_fetch_add(p, v, __ATOMIC_RELAXED, __HIP_MEMORY_SCOPE_AGENT); }
__device__ __forceinline__ unsigned xb_xcc_id() { return (unsigned)__builtin_amdgcn_s_getreg((3 << 11) | 20) & 0xFu; }
#define XB_SPIN(cond, bar) do { unsigned _sp = 0; while (cond) { __builtin_amdgcn_s_sleep(1); \
    if ((++_sp & 255u) == 0u) { if (xb_ld(&(bar)[XB_TMO])) break; if (_sp > XB_SPIN_CAP) { atomicAdd(&(bar)[XB_TMO], 1u); break; } } } } while (0)

struct XcdBarrier {
    unsigned* bar; unsigned x;
    volatile LAS unsigned* st;
};

__device__ __forceinline__ XcdBarrier xcd_barrier_post(unsigned* bar, volatile LAS unsigned* st) {
    XcdBarrier b; b.bar = bar; b.x = xb_xcc_id(); b.st = st;
    if (threadIdx.x == 0) (void)xb_add(&bar[XB_XCNT(b.x)], 1u);
    return b;
}
__device__ __forceinline__ void xcd_barrier_complete(unsigned* bar, unsigned x, unsigned& nloc, unsigned& nx) {
    const unsigned G = gridDim.x * gridDim.y * gridDim.z;
    unsigned sum, cnt, mine, sp = 0u;
    for (;;) {
        sum = 0u; cnt = 0u; mine = 0u;
#pragma unroll
        for (unsigned j = 0; j < 16; ++j) { const unsigned c = xb_ld(&bar[XB_XCNT(j)]); sum += c; cnt += (c > 0u) ? 1u : 0u; mine = (j == x) ? c : mine; }
        if (sum == G) break;
        __builtin_amdgcn_s_sleep(1);
        if ((++sp & 255u) == 0u) { if (xb_ld(&bar[XB_TMO])) break; if (sp > XB_SPIN_CAP) { atomicAdd(&bar[XB_TMO], 1u); break; } }
    }
    nloc = mine > 0u ? mine : 1u; nx = cnt > 0u ? cnt : 1u;
}

__device__ __forceinline__ void xcd_barrier(const XcdBarrier& b) {
    asm volatile("s_waitcnt vmcnt(0)" ::: "memory");
    __syncthreads();
    if (threadIdx.x == 0) {
        unsigned* bar = b.bar;
        __builtin_amdgcn_s_waitcnt(0);
        unsigned nloc = b.st[0], nx = b.st[1];
        if (nloc == 0u) { xcd_barrier_complete(bar, b.x, nloc, nx); b.st[0] = nloc; b.st[1] = nx; }
        const unsigned old = xb_add(&bar[XB_XSUB(b.x)], 1u);
        const unsigned gen = old / nloc;
        if (old + 1u == (gen + 1u) * nloc) {
            __builtin_amdgcn_fence(__ATOMIC_RELEASE, "agent");
            asm volatile("s_waitcnt vmcnt(0)" ::: "memory");
            const unsigned og = xb_add(&bar[XB_TOP], 1u);
            const unsigned tg = og / nx;
            if (og + 1u == (tg + 1u) * nx) xb_add(&bar[XB_TOPGEN], 1u);
            else XB_SPIN(xb_ld(&bar[XB_TOPGEN]) == tg, bar);
            __builtin_amdgcn_fence(__ATOMIC_ACQUIRE, "agent");
            xb_add(&bar[XB_XGEN(b.x)], 1u);
            asm volatile("s_waitcnt vmcnt(0)" ::: "memory");
        } else {
            XB_SPIN(xb_ld(&bar[XB_XGEN(b.x)]) == gen, bar);
            __builtin_amdgcn_fence(__ATOMIC_ACQUIRE, "agent");
            asm volatile("s_waitcnt vmcnt(0)" ::: "memory");
        }
    }
    __syncthreads();
}

struct Args { const float* in[25]; float* out; unsigned char* ws; int ph_lo, ph_hi, qslot, variant; };

namespace pg8 {
struct EpiProj {
    static constexpr bool PERM = true, AFTER_DRAIN = false;
    bf16_t *QB, *KP, *KS, *VTP, *VTS, *XR, *GG; float* out; const float* tab;
    __device__ __forceinline__ void operator()(const f32x4 (&acc)[2][2][4][2], const Unit& u, int wr, int wc, int fr, int fq) const {
        const int pn = u.pn; const bool prompt = u.pm < 64;
        const int rbase = u.pm * BM + wr * 64 + fr, cbase = wc * 32 + 8 * fq;
#pragma unroll
        for (int ai = 0; ai < 2; ++ai)
#pragma unroll
            for (int m = 0; m < 4; ++m) {
                const int r = rbase + ai * HALF + m * 16;
                f32x4 v[2][2];
#pragma unroll
                for (int bj = 0; bj < 2; ++bj)
#pragma unroll
                    for (int n = 0; n < 2; ++n) v[bj][n] = acc[ai][bj][m][n];
                if (pn < 12) {
                    if (wc == 0) {
                        const int pos = prompt ? (r & 4095) : (PAST + (r & 63));
                        const float* tc = tab + pos * 16 + 8 * (fq & 1);
#pragma unroll
                        for (int n = 0; n < 2; ++n) {
                            const f32x4 cs = *(const f32x4*)(tc + 4 * n), sn = *(const f32x4*)(tc + 65536 + 4 * n);
#pragma unroll
                            for (int bj = 0; bj < 2; ++bj) {
                                const f32x4 x = v[bj][n]; f32x4 p;
#pragma unroll
                                for (int i = 0; i < 4; ++i) p[i] = __shfl_xor(x[i], 32);
                                v[bj][n] = (fq < 2) ? (x * cs - p * sn) : (x * cs + p * sn);
                            }
                        }
                    }
                    if (pn < 8) {
                        bf16_t* dst = QB + (size_t)r * 2048 + pn * 256 + cbase;
#pragma unroll
                        for (int bj = 0; bj < 2; ++bj) { const f32x4 a = v[bj][0] * QSCALE, b = v[bj][1] * QSCALE; u32x4 w; w.x = cvt_pk_bf16(a[0], a[1]); w.y = cvt_pk_bf16(a[2], a[3]); w.z = cvt_pk_bf16(b[0], b[1]); w.w = cvt_pk_bf16(b[2], b[3]);
                            *(u32x4*)(dst + bj * HALF) = w; }
                    } else {
                        const int kvh = pn - 8;
                        float* fo = out + (prompt ? (O_KP + (size_t)r * 1024) : (O_KS + (size_t)(r - MP) * 1024)) + kvh * 256 + cbase;
                        bf16_t* dst = (prompt ? (KP + (size_t)r * 1024) : (KS + ((size_t)((r - MP) >> 6) * TKS + PAST + (r & 63)) * 1024)) + kvh * 256 + cbase;
#pragma unroll
                        for (int bj = 0; bj < 2; ++bj) { const f32x4 a = v[bj][0], b = v[bj][1]; *(f32x4*)(fo + bj * HALF) = a; *(f32x4*)(fo + bj * HALF + 4) = b;
                            u32x4 w; w.x = cvt_pk_bf16(a[0], a[1]); w.y = cvt_pk_bf16(a[2], a[3]); w.z = cvt_pk_bf16(b[0], b[1]); w.w = cvt_pk_bf16(b[2], b[3]); *(u32x4*)(dst + bj * HALF) = w; }
                    }
                } else if (pn < 16) {
                    const int kvh = pn - 12;
                    float* fo = out + (prompt ? (O_VP + (size_t)r * 1024) : (O_VS + (size_t)(r - MP) * 1024)) + kvh * 256 + cbase;
                    bf16_t* vt; size_t ldv;
                    if (prompt) { vt = VTP + ((size_t)((r >> 12) * 4 + kvh) * 256) * TP + (r & 4095); ldv = TP; }
                    else { vt = VTS + ((size_t)(((r - MP) >> 6) * 4 + kvh) * 256) * TKS + PAST + (r & 63); ldv = TKS; }
#pragma unroll
                    for (int bj = 0; bj < 2; ++bj) { const f32x4 a = v[bj][0], b = v[bj][1]; *(f32x4*)(fo + bj * HALF) = a; *(f32x4*)(fo + bj * HALF + 4) = b;
                        bf16_t* vp = vt + (size_t)(bj * HALF + cbase) * ldv;
#pragma unroll
                        for (int i = 0; i < 4; ++i) { vp[(size_t)i * ldv] = (bf16_t)f2bf(a[i]); vp[(size_t)(4 + i) * ldv] = (bf16_t)f2bf(b[i]); } }
                } else if (pn < 24) {
                    bf16_t* dst = XR + (size_t)r * 2048 + (pn - 16) * 256 + cbase;
#pragma unroll
                    for (int bj = 0; bj < 2; ++bj) { const f32x4 a = v[bj][0], b = v[bj][1]; u32x4 w; w.x = cvt_pk_bf16(a[0], a[1]); w.y = cvt_pk_bf16(a[2], a[3]); w.z = cvt_pk_bf16(b[0], b[1]); w.w = cvt_pk_bf16(b[2], b[3]);
                        *(u32x4*)(dst + bj * HALF) = w; }
                } else {
                    bf16_t* dst = GG + (size_t)r * 2048 + (pn - 24) * 256 + cbase;
#pragma unroll
                    for (int bj = 0; bj < 2; ++bj) { f32x4 a = v[bj][0], b = v[bj][1];
#pragma unroll
                        for (int i = 0; i < 4; ++i) { { const float x = a[i], y = 1.5957691216f * (x + 0.044715f * x * x * x); a[i] = x / (1.0f + __expf(-y)); }
                                                      { const float x = b[i], y = 1.5957691216f * (x + 0.044715f * x * x * x); b[i] = x / (1.0f + __expf(-y)); } }
                        u32x4 w; w.x = cvt_pk_bf16(a[0], a[1]); w.y = cvt_pk_bf16(a[2], a[3]); w.z = cvt_pk_bf16(b[0], b[1]); w.w = cvt_pk_bf16(b[2], b[3]); *(u32x4*)(dst + bj * HALF) = w; }
                }
            }
    }
};
struct EpiRes1 {
    static constexpr bool PERM = true, AFTER_DRAIN = false;
    const float *xp, *xs; bf16_t* HN; float* rss;
    __device__ __forceinline__ void operator()(const f32x4 (&acc)[2][2][4][2], const Unit& u, int wr, int wc, int fr, int fq) const {
        const int rbase = u.pm * BM + wr * 64 + fr, col0 = u.pn * BM + wc * 32 + 8 * fq; const bool prompt = u.pm < 64;
#pragma unroll
        for (int ai = 0; ai < 2; ++ai)
#pragma unroll
            for (int m = 0; m < 4; ++m) {
                const int r = rbase + ai * HALF + m * 16;
                const float* xr = (prompt ? xp + (size_t)r * D : xs + (size_t)(r - MP) * D) + col0;
                bf16_t* hb = HN + (size_t)r * D + col0; float ss = 0.f;
#pragma unroll
                for (int bj = 0; bj < 2; ++bj) { const f32x4 a = acc[ai][bj][m][0] + *(const f32x4*)(xr + bj * HALF), b = acc[ai][bj][m][1] + *(const f32x4*)(xr + bj * HALF + 4);
                    ss += (a[0] * a[0] + a[1] * a[1]) + (a[2] * a[2] + a[3] * a[3]) + (b[0] * b[0] + b[1] * b[1]) + (b[2] * b[2] + b[3] * b[3]);
                    u32x4 w; w.x = cvt_pk_bf16(a[0], a[1]); w.y = cvt_pk_bf16(a[2], a[3]); w.z = cvt_pk_bf16(b[0], b[1]); w.w = cvt_pk_bf16(b[2], b[3]); *(u32x4*)(hb + bj * HALF) = w; }
                ss += __shfl_xor(ss, 16); ss += __shfl_xor(ss, 32);
                if (fq == 0) atomicAdd(rss + r, ss);
            }
    }
};
struct EpiUp {
    static constexpr bool PERM = true, AFTER_DRAIN = false;
    bf16_t* Z;
    __device__ __forceinline__ void operator()(const f32x4 (&acc)[2][2][4][2], const Unit& u, int wr, int wc, int fr, int fq) const {
        const int rbase = u.pm * BM + wr * 64 + fr, col0 = u.pn * BM + wc * 32 + 8 * fq;
#pragma unroll
        for (int ai = 0; ai < 2; ++ai)
#pragma unroll
            for (int m = 0; m < 4; ++m) {
                bf16_t* dst = Z + (size_t)(rbase + ai * HALF + m * 16) * DFF + col0;
#pragma unroll
                for (int bj = 0; bj < 2; ++bj) { f32x4 a = acc[ai][bj][m][0], b = acc[ai][bj][m][1];
#pragma unroll
                    for (int i = 0; i < 4; ++i) { const float x = fmaxf(a[i], 0.f), y = fmaxf(b[i], 0.f); a[i] = x * x; b[i] = y * y; }
                    u32x4 w; w.x = cvt_pk_bf16(a[0], a[1]); w.y = cvt_pk_bf16(a[2], a[3]); w.z = cvt_pk_bf16(b[0], b[1]); w.w = cvt_pk_bf16(b[2], b[3]); *(u32x4*)(dst + bj * HALF) = w; }
            }
    }
};
struct EpiDown {
    static constexpr bool PERM = true, AFTER_DRAIN = false;
    bf16_t* h; const float* rss;
    __device__ __forceinline__ void operator()(const f32x4 (&acc)[2][2][4][2], const Unit& u, int wr, int wc, int fr, int fq) const {
        const int rbase = u.pm * BM + wr * 64 + fr, col0 = u.pn * BM + wc * 32 + 8 * fq;
#pragma unroll
        for (int ai = 0; ai < 2; ++ai)
#pragma unroll
            for (int m = 0; m < 4; ++m) {
                const int r = rbase + ai * HALF + m * 16;
                bf16_t* ho = h + (size_t)r * D + col0; const float sc = 1.0f / (rss[r] * (1.0f / D) + EPS);
#pragma unroll
                for (int bj = 0; bj < 2; ++bj) { const u32x4 hv = *(const u32x4*)(ho + bj * HALF);
                    f32x4 a = acc[ai][bj][m][0] * sc, b = acc[ai][bj][m][1] * sc;
                    a[0] += __builtin_bit_cast(float, hv.x << 16); a[1] += __builtin_bit_cast(float, hv.x & 0xffff0000u); a[2] += __builtin_bit_cast(float, hv.y << 16); a[3] += __builtin_bit_cast(float, hv.y & 0xffff0000u);
                    b[0] += __builtin_bit_cast(float, hv.z << 16); b[1] += __builtin_bit_cast(float, hv.z & 0xffff0000u); b[2] += __builtin_bit_cast(float, hv.w << 16); b[3] += __builtin_bit_cast(float, hv.w & 0xffff0000u);
                    u32x4 w; w.x = cvt_pk_bf16(a[0], a[1]); w.y = cvt_pk_bf16(a[2], a[3]); w.z = cvt_pk_bf16(b[0], b[1]); w.w = cvt_pk_bf16(b[2], b[3]); *(u32x4*)(ho + bj * HALF) = w; }
            }
    }
};
struct EpiPart {
    static constexpr bool PERM = true, AFTER_DRAIN = false;
    float* S; const float* rss;
    __device__ __forceinline__ void operator()(const f32x4 (&acc)[2][2][4][2], const Unit& u, int wr, int wc, int fr, int fq) const {
        const int rbase = u.pm * BM + wr * 64 + fr, col0 = u.pn * BM + wc * 32 + 8 * fq;
#pragma unroll
        for (int ai = 0; ai < 2; ++ai)
#pragma unroll
            for (int m = 0; m < 4; ++m) {
                const int r = rbase + ai * HALF + m * 16;
                float* so = S + (size_t)r * D + col0; const float sc = 1.0f / (rss[r] * (1.0f / D) + EPS);
#pragma unroll
                for (int bj = 0; bj < 2; ++bj) { *(f32x4*)(so + bj * HALF) = acc[ai][bj][m][0] * sc; *(f32x4*)(so + bj * HALF + 4) = acc[ai][bj][m][1] * sc; }
            }
    }
};
struct OneUnit {
    Unit u; bool valid;
    __device__ __forceinline__ bool next(int i, Unit& o) const { if (i > 0 || !valid) return false; o = u; return true; }
    __device__ __forceinline__ void a_ready(const Unit&) const {}
    __device__ __forceinline__ void done(const Unit&) const {}
};
}

__device__ __forceinline__ void tr_item(const float* W, int ldw, bf16* WT, size_t ldt, LAS float* scr, int k0, int n0, int lane, const float* kscale) {
#pragma unroll
    for (int i = 0; i < 8; ++i) { const int kk = 8 * i + (lane >> 3), c4 = 4 * (lane & 7); f32x4 v = *(const GAS f32x4*)(W + (size_t)(k0 + kk) * ldw + n0 + c4); if (kscale) v = v * kscale[k0 + kk];
        LAS float* d = scr + kk * 33 + c4; d[0] = v[0]; d[1] = v[1]; d[2] = v[2]; d[3] = v[3]; }
    LDS_WAIT(); asm volatile("" ::: "memory");
    const int c = lane & 7;
#pragma unroll
    for (int j = 0; j < 4; ++j) { const int n = (lane >> 3) + 8 * j; const LAS float* s = scr + (8 * c) * 33 + n;
        v4u o; o.x = pk2(s[0 * 33], s[1 * 33]); o.y = pk2(s[2 * 33], s[3 * 33]); o.z = pk2(s[4 * 33], s[5 * 33]); o.w = pk2(s[6 * 33], s[7 * 33]);
        *(GAS v4u*)(WT + (size_t)(n0 + n) * ldt + k0 + 8 * c) = o; }
    LDS_WAIT(); asm volatile("" ::: "memory");
}
__device__ __forceinline__ void tr_matrix_item(const float* W, int K, int N, int ldw, bf16* WT, size_t ldt, LAS float* scr, int item, int lane, const float* kscale) {
    const int nblk = N / 32, kb = item / nblk, nb = item % nblk; (void)K;
    tr_item(W, ldw, WT, ldt, scr, 64 * kb, 32 * nb, lane, kscale);
}
__device__ __forceinline__ void rope_entry(int idx, float* tab) {
    const float invt[16] = {1.0f, 0.44036659598350525f, 0.1939227432012558f, 0.08539710193872452f, 0.03760603070259094f, 0.016560440883040428f, 0.007292664609849453f, 0.0032114461064338684f,
                            0.0014142135623842478f, 0.0006227724370546639f, 0.00027424818836152554f, 0.00012076973507646471f, 5.3182957344688475e-05f, 2.34199997066753e-05f, 1.0313385246263351e-05f, 4.541670477919979e-06f};
    const int pos = idx >> 4, j = idx & 15;
    float inv = invt[0];
#pragma unroll
    for (int k = 1; k < 16; ++k) inv = (j == k) ? invt[k] : inv;
    const float angf = (float)pos * inv;
    const double x = (double)angf, q = __builtin_rint(x * 0.63661977236758134308), r = __builtin_fma(-q, 1.57079632679489661923, x) - q * 6.123233995736766e-17, r2 = r * r;
    double s = r2 * (1.0 / 6227020800.0) - 1.0 / 39916800.0; s = s * r2 + 1.0 / 362880.0; s = s * r2 - 1.0 / 5040.0; s = s * r2 + 1.0 / 120.0; s = s * r2 - 1.0 / 6.0; s = s * r2 * r + r;
    double c = r2 * (1.0 / 87178291200.0) - 1.0 / 479001600.0; c = c * r2 + 1.0 / 3628800.0; c = c * r2 - 1.0 / 40320.0; c = c * r2 + 1.0 / 720.0; c = c * r2 - 1.0 / 24.0; c = c * r2 + 0.5; c = 1.0 - c * r2;
    const int qi = ((int)q) & 3;
    const double sn = (qi == 0) ? s : (qi == 1) ? c : (qi == 2) ? -s : -c, cs = (qi == 0) ? c : (qi == 1) ? -s : (qi == 2) ? -c : s;
    tab[idx] = (float)cs; tab[65536 + idx] = (float)sn;
}

namespace att {
#ifndef ATT_QKD
#define ATT_QKD 2
#endif
#ifndef ATT_PVD
#define ATT_PVD 4
#endif
#ifndef ATT_SCHED_BETA
#define ATT_SCHED_BETA
#endif
constexpr int KT_BYTES = 32768, STAGE = 65536;
struct Unit { const bf16* Kb; const bf16* Vt; int ldv, ntiles, qrow0, kvh; };
__device__ __forceinline__ void attn_unit(LAS unsigned char* lds, const Unit& U, const bf16* QB, bf16* CAT, const float* subg, float lam) {
    int tid = threadIdx.x; asm volatile("" : "+v"(tid));
    const int lane = tid & 63, wid = __builtin_amdgcn_readfirstlane(tid >> 6);
    const int g = wid >> 2, c = (wid >> 1) & 1, qs = wid & 1, ql = lane & 31, h = lane >> 5;
    const int qrow = U.qrow0 + qs * 32 + ql;
    bf16x8 qf[6];
    LAS bf16x8* qx = (LAS bf16x8*)(lds + QX_OFF) + tid;
    { const bf16* qp = QB + (size_t)qrow * 2048 + (U.kvh * 2 + g) * 256 + c * 128 + 8 * h;
#pragma unroll
      for (int ks = 0; ks < 6; ++ks) qf[ks] = *(const GAS bf16x8*)(qp + 16 * ks);
      qx[0] = *(const GAS bf16x8*)(qp + 96); qx[512] = *(const GAS bf16x8*)(qp + 112); }
    const int kr = tid >> 5, kcc = (tid & 31) ^ (kr & 15);
    const unsigned koff = (unsigned)(kr * 1024 + kcc * 8) * 2u;
    const int ve = tid >> 3, vcc = (tid & 7) ^ ((ve >> 1) & 7);
    const unsigned voff = (unsigned)(ve * U.ldv + vcc * 8) * 2u;
    const char* kb0 = (const char*)U.Kb; const char* vb0 = (const char*)U.Vt;
    const size_t vstep = (size_t)128 * U.ldv;
#ifndef ATT_DMA_REP
#define ATT_DMA_REP 1
#endif
#define ATT_ISSUE_K(t, st) do { const char* kp_ = kb0 + (size_t)(t) * 131072; \
        _Pragma("unroll") for (int j2_ = 0; j2_ < 4 * ATT_DMA_REP; ++j2_) { const int j_ = j2_ & 3; __builtin_amdgcn_global_load_lds((const unsigned*)(kp_ + (size_t)j_ * 32768 + koff), (LAS unsigned*)(lds + (st) * STAGE + wid * 1024 + j_ * 8192), 16, 0, 0); } } while (0)
#define ATT_ISSUE_V(t, st) do { const char* vp_ = vb0 + (size_t)(t) * 128; \
        _Pragma("unroll") for (int j2_ = 0; j2_ < 4 * ATT_DMA_REP; ++j2_) { const int j_ = j2_ & 3; __builtin_amdgcn_global_load_lds((const unsigned*)(vp_ + j_ * vstep + voff), (LAS unsigned*)(lds + (st) * STAGE + KT_BYTES + wid * 1024 + j_ * 8192), 16, 0, 0); } } while (0)
    const int kap = (ql & 0x13) | ((ql & 4) << 1) | ((ql & 8) >> 1);
    const unsigned kaddr0 = (unsigned)(kap * 512 + c * 256 + 16 * ((kap & 15) ^ h));
    const unsigned vaddr0 = (unsigned)(KT_BYTES + ql * 128 + 16 * (((ql >> 1) & 7) ^ h));
    f32x16 O[8];
#pragma unroll
    for (int e = 0; e < 8; ++e)
#pragma unroll
        for (int i = 0; i < 16; ++i) O[e][i] = 0.f;
    float mrun = 0.f, lrun = 0.f;
    ATT_ISSUE_K(0, 0); ATT_ISSUE_V(0, 0);
    VM_WAIT(); RAW_BAR();
    if (g == 1) RAW_BAR();
    const int nt = U.ntiles;
    for (int t = 0; t < nt; ++t) {
        const int st = t & 1, tn = (t + 1 < nt) ? t + 1 : t;
        const unsigned ka = kaddr0 + (unsigned)st * STAGE, va = vaddr0 + (unsigned)st * STAGE;
        const unsigned ka5 = ka >> 5, kal = ka & 31u, va5 = va >> 5, val = va & 31u;
#define ATT_KF(beta, ks) (*(const LAS bf16x8*)(lds + ((((ka5 ^ (unsigned)(ks)) << 5) | kal) + 16384u * (beta))))
#define ATT_VF(e, s) (*(const LAS bf16x8*)(lds + ((((va5 ^ (unsigned)(s)) << 5) | val) + 4096u * (e))))
#pragma unroll
        for (int beta = 0; beta < 2; ++beta) {
            if (g == 1) __builtin_amdgcn_s_setprio(1);
            f32x16 S;
#pragma unroll
            for (int i = 0; i < 16; ++i) S[i] = -mrun;
            { bf16x8 kf[8];
#pragma unroll
              for (int ks = 0; ks < 8; ++ks) kf[ks] = ATT_KF(beta, ks);
#pragma unroll
              for (int ks = 0; ks < 8; ++ks) S = __builtin_amdgcn_mfma_f32_32x32x16_bf16(kf[ks], (ks < 6) ? qf[ks < 6 ? ks : 0] : qx[(ks - 6) * 512], S, 0, 0, 0);
              __builtin_amdgcn_sched_group_barrier(0x100, ATT_QKD + 2, 0);
#pragma unroll
              for (int ks = 0; ks < 8 - ATT_QKD; ++ks) { __builtin_amdgcn_sched_group_barrier(0x8, 1, 0); __builtin_amdgcn_sched_group_barrier(0x100, 1, 0); }
              __builtin_amdgcn_sched_group_barrier(0x8, ATT_QKD, 0); }
            float mx = fmaxf(fmaxf(S[0], S[1]), S[2]);
#pragma unroll
            for (int i = 3; i < 15; i += 2) mx = fmaxf(fmaxf(mx, S[i]), S[i + 1]);
            mx = fmaxf(mx, S[15]);
            mx = xhalf_max(mx);
            const bool first = (t == 0) && (beta == 0);
            if (first || __any(mx > 8.0f)) {
                const float d = first ? mx : fmaxf(mx, 0.f);
                if (!first) { const float al = __builtin_amdgcn_exp2f(-d); lrun *= al;
#pragma unroll
                    for (int e = 0; e < 8; ++e) O[e] = O[e] * al; }
                mrun += d;
#pragma unroll
                for (int i = 0; i < 16; ++i) S[i] -= d;
            }
            float ps = 0.f; bf16x8 pb[2];
#pragma unroll
            for (int j = 0; j < 2; ++j) { v4u w;
#pragma unroll
                for (int k = 0; k < 4; ++k) { const float p0 = __builtin_amdgcn_exp2f(S[8 * j + 2 * k]), p1 = __builtin_amdgcn_exp2f(S[8 * j + 2 * k + 1]); ps += p0 + p1; w[k] = cvt2bf(p0, p1); }
                pb[j] = __builtin_bit_cast(bf16x8, w); }
            lrun += ps;
            if (beta == 0) ATT_ISSUE_K(tn, st ^ 1);
            if (g == 1) __builtin_amdgcn_s_setprio(0);
            if (beta == 1) { if (ATT_DMA_REP == 1) asm volatile("s_waitcnt vmcnt(4)" ::: "memory"); else asm volatile("s_waitcnt vmcnt(8)" ::: "memory"); }
            LDS_WAIT(); RAW_BAR();
            { bf16x8 vf[8][2];
#pragma unroll
              for (int e = 0; e < 8; ++e)
#pragma unroll
                  for (int j = 0; j < 2; ++j) vf[e][j] = ATT_VF(e, 2 * beta + j);
#pragma unroll
              for (int e = 0; e < 8; ++e)
#pragma unroll
                  for (int j = 0; j < 2; ++j) O[e] = __builtin_amdgcn_mfma_f32_32x32x16_bf16(vf[e][j], pb[j], O[e], 0, 0, 0);
              __builtin_amdgcn_sched_group_barrier(0x100, ATT_PVD, 0);
#pragma unroll
              for (int e = 0; e < 16 - ATT_PVD; ++e) { __builtin_amdgcn_sched_group_barrier(0x8, 1, 0); __builtin_amdgcn_sched_group_barrier(0x100, 1, 0); }
              __builtin_amdgcn_sched_group_barrier(0x8, ATT_PVD, 0); }
            if (beta == 0) ATT_ISSUE_V(tn, st ^ 1);
            if (beta == 1) VM_WAIT();
            LDS_WAIT(); RAW_BAR();
        }
    }
    if (g == 0) RAW_BAR();
#undef ATT_KF
#undef ATT_VF
#undef ATT_ISSUE_K
#undef ATT_ISSUE_V
    lrun += __shfl_xor(lrun, 32);
    const float inv = 1.0f / lrun;
    LAS float* X = (LAS float*)(lds + (g * 2 + qs) * 32768);
    if (c == 1) {
#pragma unroll
        for (int e = 0; e < 8; ++e)
#pragma unroll
            for (int i = 0; i < 16; ++i) X[(e * 16 + i) * 64 + lane] = O[e][i] * inv;
    }
    LDS_WAIT(); RAW_BAR();
    if (c == 0) {
        float ss = 0.f;
#pragma unroll
        for (int e = 0; e < 8; ++e) {
#pragma unroll
            for (int i = 0; i < 16; ++i) { const float o = O[e][i] * inv - lam * X[(e * 16 + i) * 64 + lane]; O[e][i] = o; ss += o * o; }
            asm volatile("" : "+v"(ss) :: "memory"); }
        ss += __shfl_xor(ss, 32);
        const float rs = 1.0f / sqrtf(ss * (1.0f / 256.0f) + EPS);
        bf16* orow = CAT + (size_t)qrow * D + (U.kvh * 2 + g) * 256 + 4 * h;
#pragma unroll
        for (int e = 0; e < 8; ++e) {
#pragma unroll
            for (int i4 = 0; i4 < 4; ++i4) { const int e0 = 32 * e + 8 * i4; const f32x4 gv = *(const LAS f32x4*)(lds + SUBG_OFF + (e0 + 4 * h) * 4);
                v2u w; w.x = pk2(O[e][4 * i4] * rs * gv[0], O[e][4 * i4 + 1] * rs * gv[1]); w.y = pk2(O[e][4 * i4 + 2] * rs * gv[2], O[e][4 * i4 + 3] * rs * gv[3]);
                *(GAS v2u*)(orow + e0) = w; }
            asm volatile("" ::: "memory"); }
    }
    LDS_WAIT(); RAW_BAR();
}
}

namespace lru {
constexpr int XCB_PITCH = 272;
__device__ __forceinline__ float sigm(float x) { return __builtin_amdgcn_rcpf(1.0f + __expf(-x)); }
__device__ __forceinline__ float em1_small(float x) { float p = 1.0f / 5040.0f; p = p * x + 1.0f / 720.0f; p = p * x + 1.0f / 120.0f; p = p * x + 1.0f / 24.0f; p = p * x + 1.0f / 6.0f; p = p * x + 0.5f; p = p * x + 1.0f; return p * x; }
struct Job { int row0, n, nchunks; const float* cprev; const float* h0; float* conv_out; float* h_out; };
__device__ __forceinline__ void lru_chain(LAS unsigned char* lds, const Job& J, const bf16* XR, const bf16* GG, bf16* CAT, const bf16* GWT, const float* conv_w, const float* conv_b,
                                          const float* ga_b, const float* gx_b, const float* lam) {
    const int tid = threadIdx.x, lane = tid & 63, wid = __builtin_amdgcn_readfirstlane(tid >> 6);
    const int nl = lane & 15, g4 = lane >> 4, ch = 16 * wid + nl, gch = J.n * 128 + ch;
    LAS unsigned char* XCB = lds;
    const float w0 = conv_w[gch], w1 = conv_w[2048 + gch], w2 = conv_w[4096 + gch], w3 = conv_w[6144 + gch], cb = conv_b[gch];
    const float ba = ga_b[gch], bxv = gx_b[gch], sp = log1pf(__expf(-lam[gch]));
    bf16x8 bfr[2][4];
#pragma unroll
    for (int gt = 0; gt < 2; ++gt)
#pragma unroll
        for (int ks = 0; ks < 4; ++ks) bfr[gt][ks] = *(const GAS bf16x8*)(GWT + ((size_t)(J.n * 256 + gt * 128 + ch)) * 128 + 32 * ks + 8 * g4);
    float hin = J.h0 ? J.h0[gch] : 0.f;
    float x[19], ggv[16];
    { const bf16* xp = XR + (size_t)(J.row0 + 16 * g4 - 3) * 2048 + gch;
#pragma unroll
      for (int j = 0; j < 19; ++j) { if (j < 3) x[j] = (g4 == 0) ? (J.cprev ? J.cprev[j * 2048 + gch] : 0.f) : bf2f(xp[(size_t)j * 2048]); else x[j] = bf2f(xp[(size_t)j * 2048]); }
      const bf16* gp = GG + (size_t)(J.row0 + 16 * g4) * 2048 + gch;
#pragma unroll
      for (int i = 0; i < 16; ++i) ggv[i] = bf2f(gp[(size_t)i * 2048]); }
    for (int cs = 0; cs < J.nchunks; ++cs) {
        const int t0 = J.row0 + 64 * cs;
        float xc[16], gcur[16];
#pragma unroll
        for (int i = 0; i < 16; ++i) { float v = cb + x[i] * w0; v += x[i + 1] * w1; v += x[i + 2] * w2; v += x[i + 3] * w3; xc[i] = v; gcur[i] = ggv[i];
            *(LAS unsigned short*)(XCB + (16 * g4 + i) * XCB_PITCH + 2 * ch) = (unsigned short)f2bf(v); }
        if (cs == J.nchunks - 1 && g4 == 3) { J.conv_out[gch] = x[16]; J.conv_out[2048 + gch] = x[17]; J.conv_out[4096 + gch] = x[18]; }
        if (cs + 1 < J.nchunks) { const bf16* xp = XR + (size_t)(t0 + 64 + 16 * g4 - 3) * 2048 + gch;
#pragma unroll
            for (int j = 0; j < 19; ++j) x[j] = bf2f(xp[(size_t)j * 2048]);
            const bf16* gp = GG + (size_t)(t0 + 64 + 16 * g4) * 2048 + gch;
#pragma unroll
            for (int i = 0; i < 16; ++i) ggv[i] = bf2f(gp[(size_t)i * 2048]); }
        LDS_WAIT(); RAW_BAR();
        pg8::f32x4 acc[4][2];
        { const int trow = 16 * (nl >> 2) + (nl & 3);
#pragma unroll
          for (int rb = 0; rb < 4; ++rb) { acc[rb][0] = (pg8::f32x4){0.f, 0.f, 0.f, 0.f}; acc[rb][1] = (pg8::f32x4){0.f, 0.f, 0.f, 0.f};
#pragma unroll
              for (int ks = 0; ks < 4; ++ks) { const bf16x8 af = *(const LAS bf16x8*)(XCB + (trow + 4 * rb) * XCB_PITCH + (32 * ks + 8 * g4) * 2);
                  acc[rb][0] = __builtin_amdgcn_mfma_f32_16x16x32_bf16(af, bfr[0][ks], acc[rb][0], 0, 0, 0); acc[rb][1] = __builtin_amdgcn_mfma_f32_16x16x32_bf16(af, bfr[1][ks], acc[rb][1], 0, 0, 0); } } }
        LDS_WAIT(); RAW_BAR();
        float Hl[16], Pc[16]; float H = 0.f, P = 1.f;
#pragma unroll
        for (int rb = 0; rb < 4; ++rb)
#pragma unroll
            for (int i = 0; i < 4; ++i) { const int j = 4 * rb + i;
                const float r = sigm(acc[rb][0][i] + ba), ig = sigm(acc[rb][1][i] + bxv), la = -8.0f * r * sp, la2 = la + la;
                const float a = (la > -0.25f) ? 1.0f + em1_small(la) : __expf(la), m2 = (la2 > -0.25f) ? -em1_small(la2) : 1.0f - __expf(la2), u = __builtin_amdgcn_sqrtf(m2) * (ig * xc[j]);
                H = a * H + u; P *= a; Hl[j] = H; Pc[j] = P; }
        float Pt = 1.f, Ht = 0.f, Pp = 1.f, Hp = 0.f;
#pragma unroll
        for (int s = 0; s < 4; ++s) { const float ps = __shfl(P, nl + 16 * s), hs = __shfl(H, nl + 16 * s); if (s == g4) { Pp = Pt; Hp = Ht; } Ht = ps * Ht + hs; Pt *= ps; }
        { const float hs = Pp * hin + Hp;
          bf16* op = CAT + (size_t)(t0 + 16 * g4) * D + 2048 + gch;
#pragma unroll
          for (int j = 0; j < 16; ++j) op[(size_t)j * D] = (bf16)f2bf((Hl[j] + Pc[j] * hs) * gcur[j]); }
        hin = Pt * hin + Ht;
    }
    if (g4 == 0) J.h_out[gch] = hin;
}
}

__global__ void __launch_bounds__(NWAVES * 64, 2) mega_fwd(Args args) {
    extern __shared__ __attribute__((aligned(16))) unsigned char lds_raw[];
    LAS unsigned char* lds = (LAS unsigned char*)lds_raw;
    volatile LAS unsigned* MISC = (volatile LAS unsigned*)(lds + MISC_OFF);
    const int tid = threadIdx.x, lane = tid & 63, wave = __builtin_amdgcn_readfirstlane(tid >> 6);
    const int G = gridDim.x, bx = blockIdx.x;
    const int vcu = (G % 8 == 0) ? (bx % 8) * (G / 8) + bx / 8 : bx;
    unsigned char* ws = args.ws;
    gu32* ctl = (gu32*)(ws + WS_CTL);
    float* out = args.out;
    const float* x_prompt = args.in[0]; const float* x_sample = args.in[1]; const float* cache_k = args.in[2]; const float* cache_v = args.in[3];
    const float* state_conv = args.in[4]; const float* state_lru = args.in[5]; const float* norm_mix = args.in[6]; const float* w_in = args.in[7];
    const float* conv_w = args.in[8]; const float* conv_b = args.in[9]; const float* gate_a_w = args.in[10]; const float* gate_a_b = args.in[11];
    const float* gate_x_w = args.in[12]; const float* gate_x_b = args.in[13]; const float* lru_lambda = args.in[14];
    const float* lq1 = args.in[15]; const float* lk1 = args.in[16]; const float* lq2 = args.in[17]; const float* lk2 = args.in[18]; const float* subln_g = args.in[19];
    const float* w_out = args.in[20]; const float* norm_mlp = args.in[21]; const float* w_up = args.in[22]; const float* w_down = args.in[23]; const float* norm_final = args.in[24];
    bf16* WIN = (bf16*)(ws + WS_WIN); bf16* WOUT = (bf16*)(ws + WS_WOUT); bf16* WUP = (bf16*)(ws + WS_WUP); bf16* WDN = (bf16*)(ws + WS_WDN);
    bf16* HN = (bf16*)(ws + WS_HN); bf16* Z = (bf16*)(ws + WS_Z); bf16* XN = (bf16*)(ws + WS_XN); bf16* CAT = XN; bf16* QB = (bf16*)(ws + WS_QB);
    bf16* KP = (bf16*)(ws + WS_KP); bf16* KS = (bf16*)(ws + WS_KS); bf16* VTP = (bf16*)(ws + WS_VTP); bf16* VTS = (bf16*)(ws + WS_VTS);
    bf16* XR = (bf16*)(ws + WS_XR); bf16* GG = (bf16*)(ws + WS_GG); bf16* GWT = (bf16*)(ws + WS_GWT); float* TAB = (float*)(ws + WS_TAB);
    float* RSS1 = (float*)(ws + WS_CTL) + CW_RSS1;

    for (int u = tid; u < LDSCTL_BYTES / 4; u += NWAVES * 64) ((LAS unsigned*)(lds + LDSCTL_OFF))[u] = 0u;
    __syncthreads();
    XcdBarrier bar; bar.bar = (unsigned*)(ctl + CW_BAR); bar.x = 0; bar.st = nullptr;
    if (N_LAUNCHES == 1) bar = xcd_barrier_post((unsigned*)(ctl + CW_BAR), MISC + 8);
#define GRID_BAR() do { if (N_LAUNCHES == 1) xcd_barrier(bar); } while (0)
    const int lo = args.ph_lo, hi = args.ph_hi;
#ifndef PH_MASK
#define PH_MASK 0x7f
#endif
#define IN(k) (((PH_MASK >> (k)) & 1) && lo <= (k) && (k) < hi)
#define BOTH(k) (IN(k) && IN((k) + 1))

#ifndef P0_REPS
#define P0_REPS 1
#endif
#ifndef P2_REPS
#define P2_REPS 1
#endif
#ifndef P4_REPS
#define P4_REPS 1
#endif
    if (IN(0)) {
      for (int rep0 = 0; rep0 < P0_REPS; ++rep0) {
        LAS float* scr = (LAS float*)(lds + wave * 16384);
        const int gw = vcu * NWAVES + wave, NGW = G * NWAVES;
        constexpr int I_IN = 64 * 256, I_OUT = 64 * 128, I_UP = 64 * 512, I_CV = 128 * 256, I_GW = 32 * 8;
        constexpr int NITEMS = I_IN + I_OUT + I_UP + I_CV + I_GW;
        for (int it = gw; it < NITEMS; it += NGW) {
            int r = it;
            if (r < I_IN) { tr_matrix_item(w_in, D, NIN, NIN, WIN, D, scr, r, lane, nullptr); continue; } r -= I_IN;
            if (r < I_OUT) { tr_matrix_item(w_out, D, D, D, WOUT, D, scr, r, lane, nullptr); continue; } r -= I_OUT;
            if (r < I_UP) { tr_matrix_item(w_up, D, DFF, DFF, WUP, D, scr, r, lane, norm_mlp); continue; } r -= I_UP;
            if (r < I_CV) { const int sl = r >> 8, sb = sl >> 2, kvh = sl & 3;
                tr_matrix_item(cache_v + (size_t)sb * PAST * 1024 + kvh * 256, PAST, 256, 1024, VTS + (size_t)sl * 256 * TKS, TKS, scr, r & 255, lane, nullptr); continue; } r -= I_CV;
            { const int gi = r >> 3, gt = gi >> 4, nb = gi & 15;
              tr_matrix_item((gt ? gate_x_w : gate_a_w) + (size_t)nb * 16384, 128, 128, 128, GWT + (size_t)(nb * 256 + gt * 128) * 128, 128, scr, r & 7, lane, nullptr); }
        }
        for (int m = gw; m < M; m += NGW) {
            const GAS f32x4* xr = (const GAS f32x4*)(m < MP ? x_prompt + (size_t)m * D : x_sample + (size_t)(m - MP) * D) + lane;
            f32x4 v[16]; float s = 0.f;
#pragma unroll
            for (int j = 0; j < 16; ++j) { v[j] = xr[64 * j]; s += (v[j][0] * v[j][0] + v[j][1] * v[j][1]) + (v[j][2] * v[j][2] + v[j][3] * v[j][3]); }
            const float rstd = 1.0f / sqrtf(wave_sum(s) * (1.0f / D) + EPS);
            GAS v2u* o8 = (GAS v2u*)(XN + (size_t)m * D) + lane;
#pragma unroll
            for (int j = 0; j < 16; ++j) { const f32x4 gv = ((const GAS f32x4*)norm_mix)[lane + 64 * j]; v2u w; w.x = pk2(v[j][0] * rstd * gv[0], v[j][1] * rstd * gv[1]); w.y = pk2(v[j][2] * rstd * gv[2], v[j][3] * rstd * gv[3]); o8[64 * j] = w; }
        }
        for (int rr = gw; rr < 32 * PAST; rr += NGW) {
            const int sb = rr >> 11, t = rr & 2047;
            const GAS f32x4* src = (const GAS f32x4*)(cache_k + (size_t)rr * 1024); GAS v4u* dst = (GAS v4u*)(KS + ((size_t)sb * TKS + t) * 1024);
#pragma unroll
            for (int j = 0; j < 2; ++j) { const f32x4 a = src[j * 128 + lane * 2], b = src[j * 128 + lane * 2 + 1]; v4u w; w.x = pk2(a[0], a[1]); w.y = pk2(a[2], a[3]); w.z = pk2(b[0], b[1]); w.w = pk2(b[2], b[3]); dst[j * 64 + lane] = w; }
        }
        for (int jb = gw; jb < 1024; jb += NGW) rope_entry(jb * 64 + lane, TAB);
      }
        if (BOTH(0)) GRID_BAR();
    }

    if (IN(1)) {
        pg8::Gemm g{XN, WIN, M, NIN, D, D}; pg8::StaticOrder S; S.init(M, NIN, G, bx);
        pg8::EpiProj E{QB, KP, KS, VTP, VTS, XR, GG, out, TAB};
#ifndef P1_REPS
#define P1_REPS 1
#endif
        for (int rep1 = 0; rep1 < P1_REPS; ++rep1)
        pg8::gemm_phase<pg8::EpiProj, pg8::StaticOrder, PG8_ALIGN, PG8_SP2>(lds, g, S, E);
        if (BOTH(1)) GRID_BAR();
    }

    if (IN(2)) {
      for (int rep2 = 0; rep2 < P2_REPS; ++rep2) {
#ifndef P2_NO_LRU
        if (args.variant != 1) {
            lru::Job J;
            if (bx < 64) { const int b = bx >> 4;
                J.row0 = b * TP; J.n = bx & 15; J.nchunks = TP / 64; J.cprev = nullptr; J.h0 = nullptr; J.conv_out = out + O_CP + (size_t)b * 3 * LW; J.h_out = out + O_LP + (size_t)b * LW;
                lru::lru_chain(lds, J, XR, GG, CAT, GWT, conv_w, conv_b, gate_a_b, gate_x_b, lru_lambda);
            } else for (int v = bx - 64; v < 512; v += G - 64) { const int sb = v >> 4;
                J.row0 = MP + sb * TS; J.n = v & 15; J.nchunks = 1; J.cprev = state_conv + (size_t)sb * 3 * LW; J.h0 = state_lru + (size_t)sb * LW;
                J.conv_out = out + O_CS + (size_t)sb * 3 * LW; J.h_out = out + O_LS + (size_t)sb * LW;
                lru::lru_chain(lds, J, XR, GG, CAT, GWT, conv_w, conv_b, gate_a_b, gate_x_b, lru_lambda); }
        }
#endif
#ifndef P2_NO_ATT
        float lam;
        { const float d1 = wave_sum(lq1[lane] * lk1[lane] + lq1[lane + 64] * lk1[lane + 64]), d2 = wave_sum(lq2[lane] * lk2[lane] + lq2[lane + 64] * lk2[lane + 64]); lam = expf(d1) - expf(d2) + LAM_INIT; }
        if (tid < 256) ((LAS float*)(lds + SUBG_OFF))[tid] = subln_g[tid] * (1.0f - LAM_INIT);
        const unsigned myq = xb_xcc_id() & 7u; unsigned qdone = 0u;
        if (args.variant != 2)
        for (;;) {
            if (tid == 0) { unsigned res = 0xffffffffu;
                for (unsigned k = 0; k < 8u; ++k) { const unsigned q = (myq + k) & 7u; if ((qdone >> q) & 1u) continue;
                    const unsigned p = __hip_atomic_fetch_add((unsigned*)(ctl + CW_QCTR + 64 * (q + 8 * (rep2 + args.qslot))), 1u, RLX_AGENT);
                    if (p < 144u) { res = q * 256u + p; break; } qdone |= 1u << q; }
                MISC[16] = res; }
            LDS_WAIT(); RAW_BAR();
            const unsigned res = (unsigned)__builtin_amdgcn_readfirstlane((int)MISC[16]);
            LDS_WAIT(); RAW_BAR();
            if (res == 0xffffffffu) break;
            const int q = (int)(res >> 8), p = (int)(res & 255u);
            att::Unit U;
            int qc = -1, pair = 0, su = -1;
            if (p < 62) { qc = 63 - (p >> 1); pair = 2 * q + (p & 1); } else if (p < 78) su = 16 * q + (p - 62); else { const int r = p - 78; qc = 32 - (r >> 1); pair = 2 * q + (r & 1); }
            if (su >= 0) { const int sb = su >> 2, kvh = su & 3; U.Kb = KS + (size_t)sb * TKS * 1024 + kvh * 256; U.Vt = VTS + (size_t)(sb * 4 + kvh) * 256 * TKS; U.ldv = TKS; U.ntiles = TKS / 64; U.qrow0 = MP + sb * TS; U.kvh = kvh; }
            else { const int b = pair >> 2, kvh = pair & 3; U.Kb = KP + (size_t)b * TP * 1024 + kvh * 256; U.Vt = VTP + (size_t)(b * 4 + kvh) * 256 * TP; U.ldv = TP; U.ntiles = qc + 1; U.qrow0 = b * TP + qc * 64; U.kvh = kvh; }
            att::attn_unit(lds, U, QB, CAT, subln_g, lam);
        }
#endif
      }
        if (BOTH(2)) GRID_BAR();
    }

    if (IN(3)) {
        pg8::Gemm g{CAT, WOUT, M, D, D, D}; pg8::StaticOrder S; S.init(M, D, G, bx);
        pg8::EpiRes1 E{x_prompt, x_sample, HN, RSS1};
        pg8::gemm_phase<pg8::EpiRes1, pg8::StaticOrder, PG8_ALIGN, PG8_SP2>(lds, g, S, E);
        {
            const int nfull = (72 * 16) % G, nidle = G - nfull;
            if (nfull > 0 && bx >= nfull) { LAS float* scr = (LAS float*)(lds + wave * 16384);
                for (int it = (bx - nfull) * NWAVES + wave; it < 256 * 128; it += nidle * NWAVES) tr_matrix_item(w_down, DFF, D, D, WDN, DFF, scr, it, lane, nullptr); }
            else if (nfull == 0) { LAS float* scr = (LAS float*)(lds + wave * 16384);
                for (int it = bx * NWAVES + wave; it < 256 * 128; it += G * NWAVES) tr_matrix_item(w_down, DFF, D, D, WDN, DFF, scr, it, lane, nullptr); } }
        if (BOTH(3)) GRID_BAR();
    }

    if (IN(4)) {
        pg8::Gemm g{HN, WUP, M, DFF, D, D}; pg8::StaticOrder S; S.init(M, DFF, G, bx);
        pg8::EpiUp E{Z};
        for (int rep4 = 0; rep4 < P4_REPS; ++rep4)
        pg8::gemm_phase<pg8::EpiUp, pg8::StaticOrder, PG8_ALIGN, PG8_SP2>(lds, g, S, E);
        if (BOTH(4)) GRID_BAR();
    }

    if (IN(5)) {
#define P5_SIGNAL(p) do { asm volatile("s_waitcnt vmcnt(0)" ::: "memory"); __syncthreads(); \
        if (tid == 0) { __builtin_amdgcn_fence(__ATOMIC_RELEASE, "agent"); asm volatile("s_waitcnt vmcnt(0)" ::: "memory"); (void)xb_add((unsigned*)(ctl + CW_P6) + (p), 1u); } } while (0)
        { const int hu = vcu, tile = hu >> 1, kh = hu & 1;
          pg8::Gemm g{Z + (size_t)MP * DFF + (size_t)kh * (DFF / 2), WDN + (size_t)kh * (DFF / 2), MS, D, DFF / 2, DFF};
          pg8::OneUnit S; S.u.pm = tile & 7; S.u.pn = tile >> 3; S.valid = (G == 256);
          pg8::EpiPart E{(float*)(ws + WS_SP) + (size_t)kh * MS * D, RSS1 + MP};
          pg8::gemm_phase<pg8::EpiPart, pg8::OneUnit, false, PG8_SP2>(lds, g, S, E); }
        P5_SIGNAL(64 * 8);
        { pg8::Gemm g{Z, WDN, MP, D, DFF, DFF}; pg8::StaticOrder S; S.init(MP, D, G, bx);
          pg8::EpiDown E{HN, RSS1};
          pg8::gemm_phase<pg8::EpiDown, pg8::StaticOrder, PG8_ALIGN, PG8_SP2>(lds, g, S, E); }
        P5_SIGNAL(64 * (bx & 7));
#undef P5_SIGNAL
        if (BOTH(5) && G != 256) GRID_BAR();
    }

    if (IN(6)) {
        const float* SP = (const float*)(ws + WS_SP);
#define P6_ROW(m_) do { const int m = (m_); \
            GAS f32x4* yr = (GAS f32x4*)(out + O_Y + (size_t)m * D) + lane; \
            const GAS v2u* hr = (const GAS v2u*)(HN + (size_t)m * D) + lane; \
            f32x4 v[16]; float s = 0.f; \
            _Pragma("unroll") for (int j = 0; j < 16; ++j) { const v2u hv = hr[64 * j]; v[j][0] = __builtin_bit_cast(float, hv.x << 16); v[j][1] = __builtin_bit_cast(float, hv.x & 0xffff0000u); v[j][2] = __builtin_bit_cast(float, hv.y << 16); v[j][3] = __builtin_bit_cast(float, hv.y & 0xffff0000u); } \
            if (m >= MP) { const GAS f32x4* p0 = (const GAS f32x4*)(SP + (size_t)(m - MP) * D) + lane; const GAS f32x4* p1 = (const GAS f32x4*)(SP + (size_t)(MS + m - MP) * D) + lane; \
                _Pragma("unroll") for (int j = 0; j < 16; ++j) v[j] = v[j] + p0[64 * j] + p1[64 * j]; } \
            _Pragma("unroll") for (int j = 0; j < 16; ++j) s += (v[j][0] * v[j][0] + v[j][1] * v[j][1]) + (v[j][2] * v[j][2] + v[j][3] * v[j][3]); \
            const float rstd = 1.0f / sqrtf(wave_sum(s) * (1.0f / D) + EPS); \
            _Pragma("unroll") for (int j = 0; j < 16; ++j) { const f32x4 gv = ((const GAS f32x4*)norm_final)[lane + 64 * j]; yr[64 * j] = v[j] * rstd * gv; } } while (0)
        if (G == 256) {
            unsigned* pc = (unsigned*)(ctl + CW_P6); unsigned* bw = (unsigned*)(ctl + CW_BAR);
            const unsigned myg = (unsigned)bx & 7u; unsigned pend = 0x1ffu;
            for (;;) {
                if (tid == 0) { unsigned res = 0xffffffffu, sp = 0u;
                    while (pend) {
                        for (unsigned k = 0; k < 9u; ++k) { const unsigned sx = (k == 0u) ? myg : (k == 1u) ? 8u : ((myg + k - 1u) & 7u);
                            if (!((pend >> sx) & 1u)) continue;
                            if (xb_ld(pc + 64 * sx) < (sx == 8u ? 256u : 32u)) continue;
                            const unsigned p = xb_add(pc + 1024 + 64 * sx, 1u);
                            if (p < 128u) { res = sx * 256u + p; break; } pend &= ~(1u << sx); }
                        if (res != 0xffffffffu || !pend) break;
                        __builtin_amdgcn_s_sleep(2);
                        if ((++sp & 255u) == 0u) { if (xb_ld(&bw[XB_TMO])) break; if (sp > XB_SPIN_CAP) { atomicAdd(&bw[XB_TMO], 1u); break; } } }
                    __builtin_amdgcn_fence(__ATOMIC_ACQUIRE, "agent"); asm volatile("s_waitcnt vmcnt(0)" ::: "memory");
                    MISC[16] = res; }
                LDS_WAIT(); RAW_BAR();
                const unsigned res = (unsigned)__builtin_amdgcn_readfirstlane((int)MISC[16]);
                LDS_WAIT(); RAW_BAR();
                if (res == 0xffffffffu) break;
                const int sx = (int)(res >> 8), r0 = (sx == 8 ? MP : sx * 2048) + 16 * (int)(res & 255u) + wave;
                P6_ROW(r0); P6_ROW(r0 + 8);
            }
        } else {
            const int gw = vcu * NWAVES + wave, NGW = G * NWAVES;
            for (int m2 = gw; m2 < M; m2 += NGW) P6_ROW(m2);
        }
#undef P6_ROW
    }
#undef IN
#undef BOTH
#undef GRID_BAR
}

extern "C" void kernel_launch(void* const* d_in, const int* in_sizes, int n_in, void* d_out, int out_size, void* d_ws, size_t ws_size, hipStream_t stream) {
    static int grid = 0;
    if (grid == 0) {
        if (n_in != 25 || in_sizes[0] != MP * D || (size_t)out_size != O_END || ws_size < WS_END) { fprintf(stderr, "kernel_launch: unexpected shapes (n_in %d, in0 %d, out %d, ws %zu); nothing launched\n", n_in, n_in > 0 ? in_sizes[0] : -1, out_size, ws_size); grid = -1; return; }
        int dev = 0, cus = 0, per_cu = 0;
        if (hipGetDevice(&dev) != hipSuccess || hipDeviceGetAttribute(&cus, hipDeviceAttributeMultiprocessorCount, dev) != hipSuccess) { grid = -1; return; }
        if (hipFuncSetAttribute((const void*)mega_fwd, hipFuncAttributeMaxDynamicSharedMemorySize, LDS_BYTES) != hipSuccess) { fprintf(stderr, "kernel_launch: hipFuncSetAttribute failed\n"); grid = -1; return; }
        if (hipOccupancyMaxActiveBlocksPerMultiprocessor(&per_cu, (const void*)mega_fwd, NWAVES * 64, LDS_BYTES) != hipSuccess || per_cu < 1) { fprintf(stderr, "kernel_launch: occupancy query reports %d workgroups per CU\n", per_cu); }
        (void)hipGetLastError();
        grid = cus;
        if (grid != 256) { fprintf(stderr, "kernel_launch: built for a 256-CU device (got %d); nothing launched\n", cus); grid = -1; return; }
    }
    if (grid < 0) return;
    if (hipMemsetAsync((char*)d_ws + WS_CTL, 0, CTL_ZERO_BYTES, stream) != hipSuccess) return;
    Args a{};
    for (int i = 0; i < 25; ++i) a.in[i] = (const float*)d_in[i];
    a.out = (float*)d_out; a.ws = (unsigned char*)d_ws;
#ifdef PROBE_SEQ
    const int seq[] = PROBE_SEQ; int nq = 0;
    for (int li = 0; li < (int)(sizeof(seq) / sizeof(seq[0])); ++li) {
        a.ph_lo = seq[li] % 10; a.ph_hi = seq[li] % 10 + 1; a.variant = seq[li] / 10; a.qslot = (seq[li] % 10 == 2) ? nq++ : 0;
#else
    for (int li = 0; li < N_LAUNCHES; ++li) {
        a.ph_lo = (N_LAUNCHES == 1) ? 0 : li; a.ph_hi = (N_LAUNCHES == 1) ? N_PHASES : li + 1;
#endif
        hipLaunchKernelGGL(mega_fwd, dim3(grid), dim3(NWAVES * 64), LDS_BYTES, stream, a);
        const hipError_t le = hipPeekAtLastError();
        if (le != hipSuccess) { fprintf(stderr, "kernel_launch: launch %d failed: %s\n", li, hipGetErrorName(le)); break; }
    }
}
```

```cpp
#include <hip/hip_runtime.h>
#include <cstdio>
#include <cstdint>
#ifndef PG8_WGM_XCD
#define PG8_WGM_XCD 1
#endif
#ifndef PG8_SUB9
#define PG8_SUB9 9
#endif
#ifndef PG8_SUB8
#define PG8_SUB8 8
#endif
namespace pg8 {
#define PG8_LAS __attribute__((address_space(3)))
typedef unsigned short bf16_t;
typedef short bf16x8 __attribute__((ext_vector_type(8)));
typedef float f32x4 __attribute__((ext_vector_type(4)));
typedef unsigned u32x4 __attribute__((ext_vector_type(4)));
constexpr int BM = 256, BK = 64, HALF = 128, HTB = HALF * BK * 2  , STAGE_BYTES = 8 * HTB, NXCD = 8, WGM = 8;

__host__ __device__ __forceinline__ int lds_byte(int r, int c) { const int st = (r >> 4) * 2 + (c >> 5), rr = r & 15, cc = c & 31, ob = rr * 64 + cc * 2; return st * 1024 + (ob ^ (((ob >> 9) & 1) << 5)); }
__host__ __device__ __forceinline__ void stage_rc(int b, int& R, int& C) { const int st = b / 1024, sb = b % 1024, swz = sb ^ (((sb >> 9) & 1) << 5); R = (st >> 1) * 16 + swz / 64; C = (st & 1) * 32 + (swz % 64) / 2; }
__host__ __device__ __forceinline__ int perm32(int rho) { const int n = rho >> 4, i = rho & 15; return 8 * (i >> 2) + 4 * n + (i & 3); }

struct Unit { int pm, pn; };
struct Gemm { const bf16_t* A; const bf16_t* Bt; int M, N, K, ld; };

struct StaticOrder {
    int nM, nN, nwg, G, c, wgm;
    __host__ __device__ void init(int M, int N, int G_, int c_) { nM = M / BM; nN = N / BM; nwg = nM * nN; G = G_; c = c_; wgm = (PG8_WGM_XCD && nM % NXCD == 0) ? nM / NXCD : WGM; if (PG8_WGM_XCD && nM % NXCD == 0 && nM / NXCD == 9) wgm = PG8_SUB9; if (PG8_WGM_XCD && nM % NXCD == 0 && nM / NXCD == 8) wgm = PG8_SUB8; }
    __host__ __device__ bool next(int i, Unit& u) const {
        const long L = (long)i * G + c; if (L >= nwg) return false;
        int wgid = (int)L; { const int q = nwg / NXCD, r = nwg % NXCD, xcd = wgid % NXCD, off = wgid / NXCD; wgid = (xcd < r ? xcd * (q + 1) : r * (q + 1) + (xcd - r) * q) + off; }
        const int nig = wgm * nN, gid = wgid / nig, fm = gid * wgm, gsz = (nM - fm) < wgm ? (nM - fm) : wgm;
        u.pm = fm + ((wgid % nig) % gsz); u.pn = (wgid % nig) / gsz; return true;
    }
    __device__ __forceinline__ void a_ready(const Unit&) const {}
    __device__ __forceinline__ void done(const Unit&) const {}
};

__device__ __forceinline__ unsigned cvt_pk_bf16(float lo, float hi) { unsigned r; asm volatile("v_cvt_pk_bf16_f32 %0, %1, %2" : "=v"(r) : "v"(lo), "v"(hi)); return r; }
typedef float f32x2 __attribute__((ext_vector_type(2)));
template <class Epi, class Sched, bool ALIGN_EPI = false, bool SP2 = false>
__device__ __forceinline__ void gemm_phase(PG8_LAS unsigned char* lds, const Gemm g, const Sched& S, const Epi& E) {
    const int tid = threadIdx.x, wid = __builtin_amdgcn_readfirstlane(tid >> 6), lane = tid & 63, wr = wid >> 2, wc = wid & 3, fr = lane & 15, fq = lane >> 4;
    const int K = g.ld, nt = g.K / BK;
    unsigned voffA[2], voffB[2];
#pragma unroll
    for (int i = 0; i < 2; ++i) { int R, C; stage_rc(tid * 16 + i * 8192, R, C); const int Rb = Epi::PERM ? ((R & ~31) + perm32(R & 31)) : R;
        voffA[i] = (unsigned)(R * K + C) * 2u; voffB[i] = (unsigned)(Rb * K + C) * 2u; }
    const size_t kstep = (size_t)(BK * 2);
    const size_t hstep = (size_t)HALF * K * 2;
    const size_t tstep = 2 * hstep;
    const unsigned ldsw = (unsigned)wid * 1024u;
    const int aoff = lds_byte(wr * 64 + fr, fq * 8), boff = lds_byte(wc * 32 + fr, fq * 8);
#define PG8_SA(b, h) (((b) * 2 + (h)) * HTB)
#define PG8_SB(b, h) ((4 + (b) * 2 + (h)) * HTB)
#define PG8_STAGE(bufoff, gbase, voff) do { _Pragma("unroll") for (int _i = 0; _i < 2; ++_i) \
        __builtin_amdgcn_global_load_lds((const unsigned*)((const char*)(gbase) + (voff)[_i]), (PG8_LAS unsigned*)(lds + (bufoff) + ldsw + _i * 8192), 16, 0, 0); } while (0)
#define PG8_LDA(dst, b, h) do { _Pragma("unroll") for (int m = 0; m < 4; ++m) _Pragma("unroll") for (int k = 0; k < 2; ++k) dst[m][k] = *(const PG8_LAS bf16x8*)(lds + PG8_SA(b, h) + aoff + m * 2048 + k * 1024); } while (0)
#define PG8_LDB(dst, b, h) do { _Pragma("unroll") for (int n = 0; n < 2; ++n) _Pragma("unroll") for (int k = 0; k < 2; ++k) dst[n][k] = *(const PG8_LAS bf16x8*)(lds + PG8_SB(b, h) + boff + n * 2048 + k * 1024); } while (0)
#ifndef PG8_MMA_ORDER
#define PG8_MMA_ORDER 0
#endif
#if PG8_MMA_ORDER == 0
#define PG8_MMA(ai, bj, At, Bt) do { __builtin_amdgcn_s_setprio(1); _Pragma("unroll") for (int m = 0; m < 4; ++m) _Pragma("unroll") for (int n = 0; n < 2; ++n) _Pragma("unroll") for (int k = 0; k < 2; ++k) \
        acc[ai][bj][m][n] = __builtin_amdgcn_mfma_f32_16x16x32_bf16(Bt[n][k], At[m][k], acc[ai][bj][m][n], 0, 0, 0); __builtin_amdgcn_s_setprio(0); } while (0)
#elif PG8_MMA_ORDER == 1
#define PG8_MMA(ai, bj, At, Bt) do { __builtin_amdgcn_s_setprio(1); _Pragma("unroll") for (int k = 0; k < 2; ++k) _Pragma("unroll") for (int n = 0; n < 2; ++n) _Pragma("unroll") for (int m = 0; m < 4; ++m) \
        acc[ai][bj][m][n] = __builtin_amdgcn_mfma_f32_16x16x32_bf16(Bt[n][k], At[m][k], acc[ai][bj][m][n], 0, 0, 0); __builtin_amdgcn_s_setprio(0); } while (0)
#elif PG8_MMA_ORDER == 3
#define PG8_MMA(ai, bj, At, Bt) do { __builtin_amdgcn_s_setprio(1); _Pragma("unroll") for (int n = 0; n < 2; ++n) _Pragma("unroll") for (int m = 0; m < 4; ++m) _Pragma("unroll") for (int k = 0; k < 2; ++k) \
        acc[ai][bj][m][n] = __builtin_amdgcn_mfma_f32_16x16x32_bf16(Bt[n][k], At[m][k], acc[ai][bj][m][n], 0, 0, 0); __builtin_amdgcn_s_setprio(0); } while (0)
#elif PG8_MMA_ORDER == 4
#define PG8_MMA(ai, bj, At, Bt) do { _Pragma("unroll") for (int m = 0; m < 4; ++m) _Pragma("unroll") for (int n = 0; n < 2; ++n) _Pragma("unroll") for (int k = 0; k < 2; ++k) \
        acc[ai][bj][m][n] = __builtin_amdgcn_mfma_f32_16x16x32_bf16(Bt[n][k], At[m][k], acc[ai][bj][m][n], 0, 0, 0); } while (0)
#else
#define PG8_MMA(ai, bj, At, Bt) do { __builtin_amdgcn_s_setprio(1); _Pragma("unroll") for (int k = 0; k < 2; ++k) _Pragma("unroll") for (int m = 0; m < 4; ++m) _Pragma("unroll") for (int n = 0; n < 2; ++n) \
        acc[ai][bj][m][n] = __builtin_amdgcn_mfma_f32_16x16x32_bf16(Bt[n][k], At[m][k], acc[ai][bj][m][n], 0, 0, 0); __builtin_amdgcn_s_setprio(0); } while (0)
#endif
#define PG8_WAIT_V(n) asm volatile("s_waitcnt vmcnt(" #n ")" ::: "memory")
#define PG8_WAIT_L(n) asm volatile("s_waitcnt lgkmcnt(" #n ")" ::: "memory")
#define PG8_BAR __builtin_amdgcn_s_barrier()
#define PG8_SCHED __builtin_amdgcn_sched_barrier(0)
    Unit cur, nxt; int ui = 0;
    if (!S.next(0, cur)) return;
    f32x4 acc[2][2][4][2];
#pragma unroll
    for (int a = 0; a < 2; ++a)
#pragma unroll
        for (int b = 0; b < 2; ++b)
#pragma unroll
            for (int m = 0; m < 4; ++m)
#pragma unroll
                for (int n = 0; n < 2; ++n) acc[a][b][m][n] = (f32x4){0.f, 0.f, 0.f, 0.f};
    bf16x8 At[4][2], B0[2][2], B1[2][2];
    const char* cA = (const char*)g.A + (size_t)cur.pm * tstep; const char* cB = (const char*)g.Bt + (size_t)cur.pn * tstep;
    S.a_ready(cur);
    if constexpr (SP2) {
        PG8_STAGE(PG8_SB(0, 0), cB, voffB); PG8_STAGE(PG8_SB(0, 1), cB + hstep, voffB); PG8_STAGE(PG8_SA(0, 0), cA, voffA); PG8_STAGE(PG8_SA(0, 1), cA + hstep, voffA);
        if (wr == 1) PG8_BAR;
        PG8_WAIT_V(2); PG8_BAR;
        PG8_STAGE(PG8_SB(1, 0), cB + kstep, voffB); PG8_STAGE(PG8_SA(1, 0), cA + kstep, voffA); PG8_STAGE(PG8_SB(1, 1), cB + hstep + kstep, voffB);
        PG8_WAIT_V(6); PG8_BAR;
    } else {
        PG8_STAGE(PG8_SB(0, 0), cB, voffB); PG8_STAGE(PG8_SA(0, 0), cA, voffA); PG8_STAGE(PG8_SB(0, 1), cB + hstep, voffB); PG8_STAGE(PG8_SA(0, 1), cA + hstep, voffA);
        if (wr == 1) PG8_BAR;
        PG8_WAIT_V(4); PG8_BAR;
        PG8_STAGE(PG8_SB(1, 0), cB + kstep, voffB); PG8_STAGE(PG8_SA(1, 0), cA + kstep, voffA); PG8_STAGE(PG8_SB(1, 1), cB + hstep + kstep, voffB);
        PG8_WAIT_V(6); PG8_BAR;
    }
    for (;;) {
        const bool has_next = S.next(ui + 1, nxt);
        const char* nA = has_next ? (const char*)g.A + (size_t)nxt.pm * tstep : cA; const char* nB = has_next ? (const char*)g.Bt + (size_t)nxt.pn * tstep : cB;
        for (int t = 0; t < nt; t += 2) {
            const bool last = (t == nt - 2);
            const char* a1 = cA + (size_t)(t + 1) * kstep;
            const char* a2 = last ? nA : cA + (size_t)(t + 2) * kstep; const char* b2 = last ? nB : cB + (size_t)(t + 2) * kstep;
            const char* a3 = a2 + kstep; const char* b3 = b2 + kstep;
            if (last && has_next) S.a_ready(nxt);
            if constexpr (SP2) {
            PG8_LDB(B0, 0, 0); PG8_LDB(B1, 0, 1); PG8_SCHED; PG8_LDA(At, 0, 0); PG8_STAGE(PG8_SA(1, 1), a1 + hstep, voffA);
            PG8_WAIT_V(8); PG8_WAIT_L(0); PG8_BAR; PG8_MMA(0, 0, At, B0); PG8_MMA(0, 1, At, B1); PG8_BAR; PG8_SCHED;
            PG8_LDA(At, 0, 1); PG8_STAGE(PG8_SB(0, 0), b2, voffB); PG8_STAGE(PG8_SB(0, 1), b2 + hstep, voffB); PG8_STAGE(PG8_SA(0, 0), a2, voffA);
            PG8_WAIT_V(8); PG8_WAIT_L(0); PG8_BAR; PG8_MMA(1, 0, At, B0); PG8_MMA(1, 1, At, B1); PG8_BAR; PG8_SCHED;
            PG8_LDB(B0, 1, 0); PG8_LDB(B1, 1, 1); PG8_SCHED; PG8_LDA(At, 1, 0); PG8_STAGE(PG8_SA(0, 1), a2 + hstep, voffA);
            PG8_WAIT_V(8); PG8_WAIT_L(0); PG8_BAR; PG8_MMA(0, 0, At, B0); PG8_MMA(0, 1, At, B1); PG8_BAR; PG8_SCHED;
            PG8_LDA(At, 1, 1); PG8_STAGE(PG8_SB(1, 0), b3, voffB); PG8_STAGE(PG8_SB(1, 1), b3 + hstep, voffB); PG8_STAGE(PG8_SA(1, 0), a3, voffA);
            PG8_WAIT_V(8); PG8_WAIT_L(0); PG8_BAR; PG8_MMA(1, 0, At, B0); PG8_MMA(1, 1, At, B1); PG8_BAR; PG8_SCHED;
            } else {
            PG8_LDB(B0, 0, 0); PG8_SCHED; PG8_LDA(At, 0, 0); PG8_STAGE(PG8_SA(1, 1), a1 + hstep, voffA);
            PG8_WAIT_L(8); PG8_BAR; PG8_WAIT_L(0); PG8_MMA(0, 0, At, B0); PG8_BAR; PG8_SCHED;
            PG8_LDB(B1, 0, 1); PG8_STAGE(PG8_SB(0, 0), b2, voffB);
            PG8_BAR; PG8_WAIT_L(0); PG8_MMA(0, 1, At, B1); PG8_BAR;
            PG8_LDA(At, 0, 1); PG8_STAGE(PG8_SA(0, 0), a2, voffA);
            PG8_BAR; PG8_WAIT_L(0); PG8_MMA(1, 0, At, B0); PG8_BAR; PG8_SCHED;
            PG8_STAGE(PG8_SB(0, 1), b2 + hstep, voffB);
            PG8_WAIT_V(6); PG8_BAR; PG8_MMA(1, 1, At, B1); PG8_BAR;
            PG8_LDB(B0, 1, 0); PG8_SCHED; PG8_LDA(At, 1, 0); PG8_STAGE(PG8_SA(0, 1), a2 + hstep, voffA);
            PG8_WAIT_L(8); PG8_BAR; PG8_WAIT_L(0); PG8_MMA(0, 0, At, B0); PG8_BAR; PG8_SCHED;
            PG8_LDB(B1, 1, 1); PG8_STAGE(PG8_SB(1, 0), b3, voffB);
            PG8_BAR; PG8_WAIT_L(0); PG8_MMA(0, 1, At, B1); PG8_BAR;
            PG8_LDA(At, 1, 1); PG8_STAGE(PG8_SA(1, 0), a3, voffA);
            PG8_BAR; PG8_WAIT_L(0); PG8_MMA(1, 0, At, B0); PG8_BAR; PG8_SCHED;
            PG8_STAGE(PG8_SB(1, 1), b3 + hstep, voffB);
            PG8_WAIT_V(6); PG8_BAR; PG8_MMA(1, 1, At, B1); PG8_BAR;
            }
        }
        if constexpr (ALIGN_EPI) { if (wr == 0) PG8_BAR; }
        if constexpr (!Epi::AFTER_DRAIN) { E(acc, cur, wr, wc, fr, fq); S.done(cur); }
        if (!has_next) break;
#pragma unroll
        for (int a = 0; a < 2; ++a)
#pragma unroll
            for (int b = 0; b < 2; ++b)
#pragma unroll
                for (int m = 0; m < 4; ++m)
#pragma unroll
                    for (int n = 0; n < 2; ++n) acc[a][b][m][n] = (f32x4){0.f, 0.f, 0.f, 0.f};
        cur = nxt; cA = nA; cB = nB; ++ui;
        if constexpr (ALIGN_EPI) { if (wr == 1) PG8_BAR; }
    }
    PG8_WAIT_V(0);
    if constexpr (!ALIGN_EPI) { if (wr == 0) PG8_BAR; }
    PG8_BAR;
    if constexpr (Epi::AFTER_DRAIN) { E.fused(acc, cur, wr, wc, fr, fq, lds, wid, lane); S.done(cur); }
#undef PG8_SA
#undef PG8_SB
#undef PG8_STAGE
#undef PG8_LDA
#undef PG8_LDB
#undef PG8_MMA
#undef PG8_WAIT_V
#undef PG8_WAIT_L
#undef PG8_BAR
#undef PG8_SCHED
}
}
#ifndef PG8_SP2
#define PG8_SP2 true
#endif
#ifndef PG8_ALIGN
#define PG8_ALIGN true
#endif

constexpr int NWAVES = 8;
#ifndef MK_N_LAUNCHES
#define MK_N_LAUNCHES 1
#endif
constexpr int N_PHASES = 7;
constexpr int N_LAUNCHES = MK_N_LAUNCHES;

constexpr int D = 4096, MP = 16384, MS = 2048, M = MP + MS;
constexpr int TP = 4096, TS = 64, PAST = 2048, TKS = PAST + TS;
constexpr int NIN = 8192, DFF = 16384, LW = 2048;
constexpr float EPS = 1e-6f;
constexpr float QSCALE = 0.08838834764831845f * 1.4426950408889634f;
constexpr float LAM_INIT = 0.2f;
constexpr size_t O_Y = 0, O_KP = 75497472, O_VP = 92274688, O_CP = 109051904, O_LP = 109076480, O_KS = 109084672, O_VS = 111181824, O_CS = 113278976, O_LS = 113475584, O_END = 113541120;

constexpr size_t MiB = 1u << 20;
constexpr size_t WS_CTL = 0, CTL_ZERO_BYTES = 1 * MiB;
constexpr size_t WS_TAB = 1 * MiB;
constexpr size_t WS_GWT = 2 * MiB;
constexpr size_t WS_WIN = 4 * MiB, WS_WOUT = 68 * MiB, WS_WUP = 100 * MiB, WS_WDN = 228 * MiB;
constexpr size_t WS_HN = 356 * MiB;
constexpr size_t WS_Z = 500 * MiB;
constexpr size_t WS_XN = 500 * MiB;
constexpr size_t WS_QB = 644 * MiB;
constexpr size_t WS_KP = 716 * MiB;
constexpr size_t WS_KS = 748 * MiB;
constexpr size_t WS_VTP = 880 * MiB;
constexpr size_t WS_VTS = 912 * MiB;
constexpr size_t WS_XR = 1044 * MiB;
constexpr size_t WS_GG = 1116 * MiB;
constexpr size_t WS_SP = 1080 * MiB;
constexpr size_t WS_END = 1188 * MiB;
constexpr int CW_TMO = 0, CW_CODE = 1, CW_QCTR = 64  , CW_BAR = 4096, CW_P6 = 8192  , CW_RSS1 = 16384  ;

constexpr int RING_BYTES = 131072, LDSCTL_OFF = RING_BYTES, MISC_OFF = LDSCTL_OFF + 320, LDSCTL_BYTES = 1024, QX_OFF = LDSCTL_OFF + LDSCTL_BYTES  , SUBG_OFF = QX_OFF + 16384  , LDS_BYTES = 151552;

#ifndef XHALF_PERMLANE
#define XHALF_PERMLANE 1
#endif
#define GAS __attribute__((address_space(1)))
#define LAS __attribute__((address_space(3)))
typedef unsigned short bf16;
typedef unsigned v4u __attribute__((ext_vector_type(4)));
typedef unsigned v2u __attribute__((ext_vector_type(2)));
typedef float f32x4 __attribute__((ext_vector_type(4)));
typedef float f32x16 __attribute__((ext_vector_type(16)));
typedef short bf16x8 __attribute__((ext_vector_type(8)));
typedef GAS unsigned gu32;
#define RLX_AGENT __ATOMIC_RELAXED, __HIP_MEMORY_SCOPE_AGENT
#define LDS_WAIT() asm volatile("s_waitcnt lgkmcnt(0)" ::: "memory")
#define VM_WAIT() asm volatile("s_waitcnt vmcnt(0)" ::: "memory")
#define RAW_BAR() __builtin_amdgcn_s_barrier()
__device__ __forceinline__ unsigned f2bf(float f) { unsigned u = __builtin_bit_cast(unsigned, f); return (u + 0x7fffu + ((u >> 16) & 1u)) >> 16; }
__device__ __forceinline__ unsigned pk2(float lo, float hi) { return f2bf(lo) | (f2bf(hi) << 16); }
typedef __bf16 hwbf16x2 __attribute__((ext_vector_type(2)));
typedef float f32x2v __attribute__((ext_vector_type(2)));
__device__ __forceinline__ unsigned cvt2bf(float lo, float hi) { const f32x2v v = {lo, hi}; return __builtin_bit_cast(unsigned, __builtin_convertvector(v, hwbf16x2)); }
__device__ __forceinline__ float xhalf_max(float v) {
#if XHALF_PERMLANE
    const unsigned u = __builtin_bit_cast(unsigned, v); const auto r = __builtin_amdgcn_permlane32_swap(u, u, false, false);
    return fmaxf(__builtin_bit_cast(float, r[0]), __builtin_bit_cast(float, r[1]));
#else
    return fmaxf(v, __shfl_xor(v, 32));
#endif
}
__device__ __forceinline__ float bf2f(unsigned short b) { return __builtin_bit_cast(float, (unsigned)b << 16); }
__device__ __forceinline__ float wave_sum(float v) {
#pragma unroll
    for (int o = 1; o < 64; o <<= 1) v += __shfl_xor(v, o);
    return v;
}

#define XB_TMO      128
#define XB_XCNT(j)  (256  + 64 * (j))
#define XB_XSUB(j)  (1280 + 64 * (j))
#define XB_XGEN(j)  (2304 + 64 * (j))
#define XB_TOP      3328
#define XB_TOPGEN   3392
#define XCD_BAR_WORDS 3456
#define XB_SPIN_CAP (1u << 18)

__device__ __forceinline__ unsigned xb_ld(unsigned* p)              { return __hip_atomic_load(p, __ATOMIC_RELAXED, __HIP_MEMORY_SCOPE_AGENT); }
__device__ __forceinline__ unsigned xb_add(unsigned* p, unsigned v) { return __hip_atomic_fetch_add(p, v, __ATOMIC_RELAXED, __HIP_MEMORY_SCOPE_AGENT); }
__device__ __forceinline__ unsigned xb_xcc_id() { return (unsigned)__builtin_amdgcn_s_getreg((3 << 11) | 20) & 0xFu; }
#define XB_SPIN(cond, bar) do { unsigned _sp = 0; while (cond) { __builtin_amdgcn_s_sleep(1); \
    if ((++_sp & 255u) == 0u) { if (xb_ld(&(bar)[XB_TMO])) break; if (_sp > XB_SPIN_CAP) { atomicAdd(&(bar)[XB_TMO], 1u); break; } } } } while (0)

struct XcdBarrier {
    unsigned* bar; unsigned x;
    volatile LAS unsigned* st;
};

__device__ __forceinline__ XcdBarrier xcd_barrier_post(unsigned* bar, volatile LAS unsigned* st) {
    XcdBarrier b; b.bar = bar; b.x = xb_xcc_id(); b.st = st;
    if (threadIdx.x == 0) (void)xb_add(&bar[XB_XCNT(b.x)], 1u);
    return b;
}
__device__ __forceinline__ void xcd_barrier_complete(unsigned* bar, unsigned x, unsigned& nloc, unsigned& nx) {
    const unsigned G = gridDim.x * gridDim.y * gridDim.z;
    unsigned sum, cnt, mine, sp = 0u;
    for (;;) {
        sum = 0u; cnt = 0u; mine = 0u;
#pragma unroll
        for (unsigned j = 0; j < 16; ++j) { const unsigned c = xb_ld(&bar[XB_XCNT(j)]); sum += c; cnt += (c > 0u) ? 1u : 0u; mine = (j == x) ? c : mine; }
        if (sum == G) break;
        __builtin_amdgcn_s_sleep(1);
        if ((++sp & 255u) == 0u) { if (xb_ld(&bar[XB_TMO])) break; if (sp > XB_SPIN_CAP) { atomicAdd(&bar[XB_TMO], 1u); break; } }
    }
    nloc = mine > 0u ? mine : 1u; nx = cnt > 0u ? cnt : 1u;
}

__device__ __forceinline__ void xcd_barrier(const XcdBarrier& b) {
    asm volatile("s_waitcnt vmcnt(0)" ::: "memory");
    __syncthreads();
    if (threadIdx.x == 0) {
        unsigned* bar = b.bar;
        __builtin_amdgcn_s_waitcnt(0);
        unsigned nloc = b.st[0], nx = b.st[1];
        if (nloc == 0u) { xcd_barrier_complete(bar, b.x, nloc, nx); b.st[0] = nloc; b.st[1] = nx; }
        const unsigned old = xb_add(&bar[XB_XSUB(b.x)], 1u);
        const unsigned gen = old / nloc;
        if (old + 1u == (gen + 1u) * nloc) {
            __builtin_amdgcn_fence(__ATOMIC_RELEASE, "agent");
            asm volatile("s_waitcnt vmcnt(0)" ::: "memory");
            const unsigned og = xb_add(&bar[XB_TOP], 1u);
            const unsigned tg = og / nx;
            if (og + 1u == (tg + 1u) * nx) xb_add(&bar[XB_TOPGEN], 1u);
            else XB_SPIN(xb_ld(&bar[XB_TOPGEN]) == tg, bar);
            __builtin_amdgcn_fence(__ATOMIC_ACQUIRE, "agent");
            xb_add(&bar[XB_XGEN(b.x)], 1u);
            asm volatile("s_waitcnt vmcnt(0)" ::: "memory");
        } else {
            XB_SPIN(xb_ld(&bar[XB_XGEN(b.x)]) == gen, bar);
            __builtin_amdgcn_fence(__ATOMIC_ACQUIRE, "agent");
            asm volatile("s_waitcnt vmcnt(0)" ::: "memory");
        }
    }
    __syncthreads();
}

struct Args { const float* in[25]; float* out; unsigned char* ws; int ph_lo, ph_hi, qslot, variant; };

namespace pg8 {
struct EpiProj {
    static constexpr bool PERM = true, AFTER_DRAIN = false;
    bf16_t *QB, *KP, *KS, *VTP, *VTS, *XR, *GG; float* out; const float* tab;
    __device__ __forceinline__ void operator()(const f32x4 (&acc)[2][2][4][2], const Unit& u, int wr, int wc, int fr, int fq) const {
        const int pn = u.pn; const bool prompt = u.pm < 64;
        const int rbase = u.pm * BM + wr * 64 + fr, cbase = wc * 32 + 8 * fq;
#pragma unroll
        for (int ai = 0; ai < 2; ++ai)
#pragma unroll
            for (int m = 0; m < 4; ++m) {
                const int r = rbase + ai * HALF + m * 16;
                f32x4 v[2][2];
#pragma unroll
                for (int bj = 0; bj < 2; ++bj)
#pragma unroll
                    for (int n = 0; n < 2; ++n) v[bj][n] = acc[ai][bj][m][n];
                if (pn < 12) {
                    if (wc == 0) {
                        const int pos = prompt ? (r & 4095) : (PAST + (r & 63));
                        const float* tc = tab + pos * 16 + 8 * (fq & 1);
#pragma unroll
                        for (int n = 0; n < 2; ++n) {
                            const f32x4 cs = *(const f32x4*)(tc + 4 * n), sn = *(const f32x4*)(tc + 65536 + 4 * n);
#pragma unroll
                            for (int bj = 0; bj < 2; ++bj) {
                                const f32x4 x = v[bj][n]; f32x4 p;
#pragma unroll
                                for (int i = 0; i < 4; ++i) p[i] = __shfl_xor(x[i], 32);
                                v[bj][n] = (fq < 2) ? (x * cs - p * sn) : (x * cs + p * sn);
                            }
                        }
                    }
                    if (pn < 8) {
                        bf16_t* dst = QB + (size_t)r * 2048 + pn * 256 + cbase;
#pragma unroll
                        for (int bj = 0; bj < 2; ++bj) { const f32x4 a = v[bj][0] * QSCALE, b = v[bj][1] * QSCALE; u32x4 w; w.x = cvt_pk_bf16(a[0], a[1]); w.y = cvt_pk_bf16(a[2], a[3]); w.z = cvt_pk_bf16(b[0], b[1]); w.w = cvt_pk_bf16(b[2], b[3]);
                            *(u32x4*)(dst + bj * HALF) = w; }
                    } else {
                        const int kvh = pn - 8;
                        float* fo = out + (prompt ? (O_KP + (size_t)r * 1024) : (O_KS + (size_t)(r - MP) * 1024)) + kvh * 256 + cbase;
                        bf16_t* dst = (prompt ? (KP + (size_t)r * 1024) : (KS + ((size_t)((r - MP) >> 6) * TKS + PAST + (r & 63)) * 1024)) + kvh * 256 + cbase;
#pragma unroll
                        for (int bj = 0; bj < 2; ++bj) { const f32x4 a = v[bj][0], b = v[bj][1]; *(f32x4*)(fo + bj * HALF) = a; *(f32x4*)(fo + bj * HALF + 4) = b;
                            u32x4 w; w.x = cvt_pk_bf16(a[0], a[1]); w.y = cvt_pk_bf16(a[2], a[3]); w.z = cvt_pk_bf16(b[0], b[1]); w.w = cvt_pk_bf16(b[2], b[3]); *(u32x4*)(dst + bj * HALF) = w; }
                    }
                } else if (pn < 16) {
                    const int kvh = pn - 12;
                    float* fo = out + (prompt ? (O_VP + (size_t)r * 1024) : (O_VS + (size_t)(r - MP) * 1024)) + kvh * 256 + cbase;
                    bf16_t* vt; size_t ldv;
                    if (prompt) { vt = VTP + ((size_t)((r >> 12) * 4 + kvh) * 256) * TP + (r & 4095); ldv = TP; }
                    else { vt = VTS + ((size_t)(((r - MP) >> 6) * 4 + kvh) * 256) * TKS + PAST + (r & 63); ldv = TKS; }
#pragma unroll
                    for (int bj = 0; bj < 2; ++bj) { const f32x4 a = v[bj][0], b = v[bj][1]; *(f32x4*)(fo + bj * HALF) = a; *(f32x4*)(fo + bj * HALF + 4) = b;
                        bf16_t* vp = vt + (size_t)(bj * HALF + cbase) * ldv;
#pragma unroll
                        for (int i = 0; i < 4; ++i) { vp[(size_t)i * ldv] = (bf16_t)f2bf(a[i]); vp[(size_t)(4 + i) * ldv] = (bf16_t)f2bf(b[i]); } }
                } else if (pn < 24) {
                    bf16_t* dst = XR + (size_t)r * 2048 + (pn - 16) * 256 + cbase;
#pragma unroll
                    for (int bj = 0; bj < 2; ++bj) { const f32x4 a = v[bj][0], b = v[bj][1]; u32x4 w; w.x = cvt_pk_bf16(a[0], a[1]); w.y = cvt_pk_bf16(a[2], a[3]); w.z = cvt_pk_bf16(b[0], b[1]); w.w = cvt_pk_bf16(b[2], b[3]);
                        *(u32x4*)(dst + bj * HALF) = w; }
                } else {
                    bf16_t* dst = GG + (size_t)r * 2048 + (pn - 24) * 256 + cbase;
#pragma unroll
                    for (int bj = 0; bj < 2; ++bj) { f32x4 a = v[bj][0], b = v[bj][1];
#pragma unroll
                        for (int i = 0; i < 4; ++i) { { const float x = a[i], y = 1.5957691216f * (x + 0.044715f * x * x * x); a[i] = x / (1.0f + __expf(-y)); }
                                                      { const float x = b[i], y = 1.5957691216f * (x + 0.044715f * x * x * x); b[i] = x / (1.0f + __expf(-y)); } }
                        u32x4 w; w.x = cvt_pk_bf16(a[0], a[1]); w.y = cvt_pk_bf16(a[2], a[3]); w.z = cvt_pk_bf16(b[0], b[1]); w.w = cvt_pk_bf16(b[2], b[3]); *(u32x4*)(dst + bj * HALF) = w; }
                }
            }
    }
};
struct EpiRes1 {
    static constexpr bool PERM = true, AFTER_DRAIN = false;
    const float *xp, *xs; bf16_t* HN; float* rss;
    __device__ __forceinline__ void operator()(const f32x4 (&acc)[2][2][4][2], const Unit& u, int wr, int wc, int fr, int fq) const {
        const int rbase = u.pm * BM + wr * 64 + fr, col0 = u.pn * BM + wc * 32 + 8 * fq; const bool prompt = u.pm < 64;
#pragma unroll
        for (int ai = 0; ai < 2; ++ai)
#pragma unroll
            for (int m = 0; m < 4; ++m) {
                const int r = rbase + ai * HALF + m * 16;
                const float* xr = (prompt ? xp + (size_t)r * D : xs + (size_t)(r - MP) * D) + col0;
                bf16_t* hb = HN + (size_t)r * D + col0; float ss = 0.f;
#pragma unroll
                for (int bj = 0; bj < 2; ++bj) { const f32x4 a = acc[ai][bj][m][0] + *(const f32x4*)(xr + bj * HALF), b = acc[ai][bj][m][1] + *(const f32x4*)(xr + bj * HALF + 4);
                    ss += (a[0] * a[0] + a[1] * a[1]) + (a[2] * a[2] + a[3] * a[3]) + (b[0] * b[0] + b[1] * b[1]) + (b[2] * b[2] + b[3] * b[3]);
                    u32x4 w; w.x = cvt_pk_bf16(a[0], a[1]); w.y = cvt_pk_bf16(a[2], a[3]); w.z = cvt_pk_bf16(b[0], b[1]); w.w = cvt_pk_bf16(b[2], b[3]); *(u32x4*)(hb + bj * HALF) = w; }
                ss += __shfl_xor(ss, 16); ss += __shfl_xor(ss, 32);
                if (fq == 0) atomicAdd(rss + r, ss);
            }
    }
};
struct EpiUp {
    static constexpr bool PERM = true, AFTER_DRAIN = false;
    bf16_t* Z;
    __device__ __forceinline__ void operator()(const f32x4 (&acc)[2][2][4][2], const Unit& u, int wr, int wc, int fr, int fq) const {
        const int rbase = u.pm * BM + wr * 64 + fr, col0 = u.pn * BM + wc * 32 + 8 * fq;
#pragma unroll
        for (int ai = 0; ai < 2; ++ai)
#pragma unroll
            for (int m = 0; m < 4; ++m) {
                bf16_t* dst = Z + (size_t)(rbase + ai * HALF + m * 16) * DFF + col0;
#pragma unroll
                for (int bj = 0; bj < 2; ++bj) { f32x4 a = acc[ai][bj][m][0], b = acc[ai][bj][m][1];
#pragma unroll
                    for (int i = 0; i < 4; ++i) { const float x = fmaxf(a[i], 0.f), y = fmaxf(b[i], 0.f); a[i] = x * x; b[i] = y * y; }
                    u32x4 w; w.x = cvt_pk_bf16(a[0], a[1]); w.y = cvt_pk_bf16(a[2], a[3]); w.z = cvt_pk_bf16(b[0], b[1]); w.w = cvt_pk_bf16(b[2], b[3]); *(u32x4*)(dst + bj * HALF) = w; }
            }
    }
};
struct EpiDown {
    static constexpr bool PERM = true, AFTER_DRAIN = false;
    bf16_t* h; const float* rss;
    __device__ __forceinline__ void operator()(const f32x4 (&acc)[2][2][4][2], const Unit& u, int wr, int wc, int fr, int fq) const {
        const int rbase = u.pm * BM + wr * 64 + fr, col0 = u.pn * BM + wc * 32 + 8 * fq;
#pragma unroll
        for (int ai = 0; ai < 2; ++ai)
#pragma unroll
            for (int m = 0; m < 4; ++m) {
                const int r = rbase + ai * HALF + m * 16;
                bf16_t* ho = h + (size_t)r * D + col0; const float sc = 1.0f / (rss[r] * (1.0f / D) + EPS);
#pragma unroll
                for (int bj = 0; bj < 2; ++bj) { const u32x4 hv = *(const u32x4*)(ho + bj * HALF);
                    f32x4 a = acc[ai][bj][m][0] * sc, b = acc[ai][bj][m][1] * sc;
                    a[0] += __builtin_bit_cast(float, hv.x << 16); a[1] += __builtin_bit_cast(float, hv.x & 0xffff0000u); a[2] += __builtin_bit_cast(float, hv.y << 16); a[3] += __builtin_bit_cast(float, hv.y & 0xffff0000u);
                    b[0] += __builtin_bit_cast(float, hv.z << 16); b[1] += __builtin_bit_cast(float, hv.z & 0xffff0000u); b[2] += __builtin_bit_cast(float, hv.w << 16); b[3] += __builtin_bit_cast(float, hv.w & 0xffff0000u);
                    u32x4 w; w.x = cvt_pk_bf16(a[0], a[1]); w.y = cvt_pk_bf16(a[2], a[3]); w.z = cvt_pk_bf16(b[0], b[1]); w.w = cvt_pk_bf16(b[2], b[3]); *(u32x4*)(ho + bj * HALF) = w; }
            }
    }
};
struct EpiPart {
    static constexpr bool PERM = true, AFTER_DRAIN = false;
    float* S; const float* rss;
    __device__ __forceinline__ void operator()(const f32x4 (&acc)[2][2][4][2], const Unit& u, int wr, int wc, int fr, int fq) const {
        const int rbase = u.pm * BM + wr * 64 + fr, col0 = u.pn * BM + wc * 32 + 8 * fq;
#pragma unroll
        for (int ai = 0; ai < 2; ++ai)
#pragma unroll
            for (int m = 0; m < 4; ++m) {
                const int r = rbase + ai * HALF + m * 16;
                float* so = S + (size_t)r * D + col0; const float sc = 1.0f / (rss[r] * (1.0f / D) + EPS);
#pragma unroll
                for (int bj = 0; bj < 2; ++bj) { *(f32x4*)(so + bj * HALF) = acc[ai][bj][m][0] * sc; *(f32x4*)(so + bj * HALF + 4) = acc[ai][bj][m][1] * sc; }
            }
    }
};
struct OneUnit {
    Unit u; bool valid;
    __device__ __forceinline__ bool next(int i, Unit& o) const { if (i > 0 || !valid) return false; o = u; return true; }
    __device__ __forceinline__ void a_ready(const Unit&) const {}
    __device__ __forceinline__ void done(const Unit&) const {}
};
}

__device__ __forceinline__ void tr_item(const float* W, int ldw, bf16* WT, size_t ldt, LAS float* scr, int k0, int n0, int lane, const float* kscale) {
#pragma unroll
    for (int i = 0; i < 8; ++i) { const int kk = 8 * i + (lane >> 3), c4 = 4 * (lane & 7); f32x4 v = *(const GAS f32x4*)(W + (size_t)(k0 + kk) * ldw + n0 + c4); if (kscale) v = v * kscale[k0 + kk];
        LAS float* d = scr + kk * 33 + c4; d[0] = v[0]; d[1] = v[1]; d[2] = v[2]; d[3] = v[3]; }
    LDS_WAIT(); asm volatile("" ::: "memory");
    const int c = lane & 7;
#pragma unroll
    for (int j = 0; j < 4; ++j) { const int n = (lane >> 3) + 8 * j; const LAS float* s = scr + (8 * c) * 33 + n;
        v4u o; o.x = pk2(s[0 * 33], s[1 * 33]); o.y = pk2(s[2 * 33], s[3 * 33]); o.z = pk2(s[4 * 33], s[5 * 33]); o.w = pk2(s[6 * 33], s[7 * 33]);
        *(GAS v4u*)(WT + (size_t)(n0 + n) * ldt + k0 + 8 * c) = o; }
    LDS_WAIT(); asm volatile("" ::: "memory");
}
__device__ __forceinline__ void tr_matrix_item(const float* W, int K, int N, int ldw, bf16* WT, size_t ldt, LAS float* scr, int item, int lane, const float* kscale) {
    const int nblk = N / 32, kb = item / nblk, nb = item % nblk; (void)K;
    tr_item(W, ldw, WT, ldt, scr, 64 * kb, 32 * nb, lane, kscale);
}
__device__ __forceinline__ void rope_entry(int idx, float* tab) {
    const float invt[16] = {1.0f, 0.44036659598350525f, 0.1939227432012558f, 0.08539710193872452f, 0.03760603070259094f, 0.016560440883040428f, 0.007292664609849453f, 0.0032114461064338684f,
                            0.0014142135623842478f, 0.0006227724370546639f, 0.00027424818836152554f, 0.00012076973507646471f, 5.3182957344688475e-05f, 2.34199997066753e-05f, 1.0313385246263351e-05f, 4.541670477919979e-06f};
    const int pos = idx >> 4, j = idx & 15;
    float inv = invt[0];
#pragma unroll
    for (int k = 1; k < 16; ++k) inv = (j == k) ? invt[k] : inv;
    const float angf = (float)pos * inv;
    const double x = (double)angf, q = __builtin_rint(x * 0.63661977236758134308), r = __builtin_fma(-q, 1.57079632679489661923, x) - q * 6.123233995736766e-17, r2 = r * r;
    double s = r2 * (1.0 / 6227020800.0) - 1.0 / 39916800.0; s = s * r2 + 1.0 / 362880.0; s = s * r2 - 1.0 / 5040.0; s = s * r2 + 1.0 / 120.0; s = s * r2 - 1.0 / 6.0; s = s * r2 * r + r;
    double c = r2 * (1.0 / 87178291200.0) - 1.0 / 479001600.0; c = c * r2 + 1.0 / 3628800.0; c = c * r2 - 1.0 / 40320.0; c = c * r2 + 1.0 / 720.0; c = c * r2 - 1.0 / 24.0; c = c * r2 + 0.5; c = 1.0 - c * r2;
    const int qi = ((int)q) & 3;
    const double sn = (qi == 0) ? s : (qi == 1) ? c : (qi == 2) ? -s : -c, cs = (qi == 0) ? c : (qi == 1) ? -s : (qi == 2) ? -c : s;
    tab[idx] = (float)cs; tab[65536 + idx] = (float)sn;
}

namespace att {
#ifndef ATT_QKD
#define ATT_QKD 2
#endif
#ifndef ATT_PVD
#define ATT_PVD 4
#endif
#ifndef ATT_SCHED_BETA
#define ATT_SCHED_BETA
#endif
constexpr int KT_BYTES = 32768, STAGE = 65536;
struct Unit { const bf16* Kb; const bf16* Vt; int ldv, ntiles, qrow0, kvh; };
__device__ __forceinline__ void attn_unit(LAS unsigned char* lds, const Unit& U, const bf16* QB, bf16* CAT, const float* subg, float lam) {
    int tid = threadIdx.x; asm volatile("" : "+v"(tid));
    const int lane = tid & 63, wid = __builtin_amdgcn_readfirstlane(tid >> 6);
    const int g = wid >> 2, c = (wid >> 1) & 1, qs = wid & 1, ql = lane & 31, h = lane >> 5;
    const int qrow = U.qrow0 + qs * 32 + ql;
    bf16x8 qf[6];
    LAS bf16x8* qx = (LAS bf16x8*)(lds + QX_OFF) + tid;
    { const bf16* qp = QB + (size_t)qrow * 2048 + (U.kvh * 2 + g) * 256 + c * 128 + 8 * h;
#pragma unroll
      for (int ks = 0; ks < 6; ++ks) qf[ks] = *(const GAS bf16x8*)(qp + 16 * ks);
      qx[0] = *(const GAS bf16x8*)(qp + 96); qx[512] = *(const GAS bf16x8*)(qp + 112); }
    const int kr = tid >> 5, kcc = (tid & 31) ^ (kr & 15);
    const unsigned koff = (unsigned)(kr * 1024 + kcc * 8) * 2u;
    const int ve = tid >> 3, vcc = (tid & 7) ^ ((ve >> 1) & 7);
    const unsigned voff = (unsigned)(ve * U.ldv + vcc * 8) * 2u;
    const char* kb0 = (const char*)U.Kb; const char* vb0 = (const char*)U.Vt;
    const size_t vstep = (size_t)128 * U.ldv;
#ifndef ATT_DMA_REP
#define ATT_DMA_REP 1
#endif
#define ATT_ISSUE_K(t, st) do { const char* kp_ = kb0 + (size_t)(t) * 131072; \
        _Pragma("unroll") for (int j2_ = 0; j2_ < 4 * ATT_DMA_REP; ++j2_) { const int j_ = j2_ & 3; __builtin_amdgcn_global_load_lds((const unsigned*)(kp_ + (size_t)j_ * 32768 + koff), (LAS unsigned*)(lds + (st) * STAGE + wid * 1024 + j_ * 8192), 16, 0, 0); } } while (0)
#define ATT_ISSUE_V(t, st) do { const char* vp_ = vb0 + (size_t)(t) * 128; \
        _Pragma("unroll") for (int j2_ = 0; j2_ < 4 * ATT_DMA_REP; ++j2_) { const int j_ = j2_ & 3; __builtin_amdgcn_global_load_lds((const unsigned*)(vp_ + j_ * vstep + voff), (LAS unsigned*)(lds + (st) * STAGE + KT_BYTES + wid * 1024 + j_ * 8192), 16, 0, 0); } } while (0)
    const int kap = (ql & 0x13) | ((ql & 4) << 1) | ((ql & 8) >> 1);
    const unsigned kaddr0 = (unsigned)(kap * 512 + c * 256 + 16 * ((kap & 15) ^ h));
    const unsigned vaddr0 = (unsigned)(KT_BYTES + ql * 128 + 16 * (((ql >> 1) & 7) ^ h));
    f32x16 O[8];
#pragma unroll
    for (int e = 0; e < 8; ++e)
#pragma unroll
        for (int i = 0; i < 16; ++i) O[e][i] = 0.f;
    float mrun = 0.f, lrun = 0.f;
    ATT_ISSUE_K(0, 0); ATT_ISSUE_V(0, 0);
    VM_WAIT(); RAW_BAR();
    if (g == 1) RAW_BAR();
    const int nt = U.ntiles;
    for (int t = 0; t < nt; ++t) {
        const int st = t & 1, tn = (t + 1 < nt) ? t + 1 : t;
        const unsigned ka = kaddr0 + (unsigned)st * STAGE, va = vaddr0 + (unsigned)st * STAGE;
        const unsigned ka5 = ka >> 5, kal = ka & 31u, va5 = va >> 5, val = va & 31u;
#define ATT_KF(beta, ks) (*(const LAS bf16x8*)(lds + ((((ka5 ^ (unsigned)(ks)) << 5) | kal) + 16384u * (beta))))
#define ATT_VF(e, s) (*(const LAS bf16x8*)(lds + ((((va5 ^ (unsigned)(s)) << 5) | val) + 4096u * (e))))
#pragma unroll
        for (int beta = 0; beta < 2; ++beta) {
            if (g == 1) __builtin_amdgcn_s_setprio(1);
            f32x16 S;
#pragma unroll
            for (int i = 0; i < 16; ++i) S[i] = -mrun;
            { bf16x8 kf[8];
#pragma unroll
              for (int ks = 0; ks < 8; ++ks) kf[ks] = ATT_KF(beta, ks);
#pragma unroll
              for (int ks = 0; ks < 8; ++ks) S = __builtin_amdgcn_mfma_f32_32x32x16_bf16(kf[ks], (ks < 6) ? qf[ks < 6 ? ks : 0] : qx[(ks - 6) * 512], S, 0, 0, 0);
              __builtin_amdgcn_sched_group_barrier(0x100, ATT_QKD + 2, 0);
#pragma unroll
              for (int ks = 0; ks < 8 - ATT_QKD; ++ks) { __builtin_amdgcn_sched_group_barrier(0x8, 1, 0); __builtin_amdgcn_sched_group_barrier(0x100, 1, 0); }
              __builtin_amdgcn_sched_group_barrier(0x8, ATT_QKD, 0); }
            float mx = fmaxf(fmaxf(S[0], S[1]), S[2]);
#pragma unroll
            for (int i = 3; i < 15; i += 2) mx = fmaxf(fmaxf(mx, S[i]), S[i + 1]);
            mx = fmaxf(mx, S[15]);
            mx = xhalf_max(mx);
            const bool first = (t == 0) && (beta == 0);
            if (first || __any(mx > 8.0f)) {
                const float d = first ? mx : fmaxf(mx, 0.f);
                if (!first) { const float al = __builtin_amdgcn_exp2f(-d); lrun *= al;
#pragma unroll
                    for (int e = 0; e < 8; ++e) O[e] = O[e] * al; }
                mrun += d;
#pragma unroll
                for (int i = 0; i < 16; ++i) S[i] -= d;
            }
            float ps = 0.f; bf16x8 pb[2];
#pragma unroll
            for (int j = 0; j < 2; ++j) { v4u w;
#pragma unroll
                for (int k = 0; k < 4; ++k) { const float p0 = __builtin_amdgcn_exp2f(S[8 * j + 2 * k]), p1 = __builtin_amdgcn_exp2f(S[8 * j + 2 * k + 1]); ps += p0 + p1; w[k] = cvt2bf(p0, p1); }
                pb[j] = __builtin_bit_cast(bf16x8, w); }
            lrun += ps;
            if (beta == 0) ATT_ISSUE_K(tn, st ^ 1);
            if (g == 1) __builtin_amdgcn_s_setprio(0);
            if (beta == 1) { if (ATT_DMA_REP == 1) asm volatile("s_waitcnt vmcnt(4)" ::: "memory"); else asm volatile("s_waitcnt vmcnt(8)" ::: "memory"); }
            LDS_WAIT(); RAW_BAR();
            { bf16x8 vf[8][2];
#pragma unroll
              for (int e = 0; e < 8; ++e)
#pragma unroll
                  for (int j = 0; j < 2; ++j) vf[e][j] = ATT_VF(e, 2 * beta + j);
#pragma unroll
              for (int e = 0; e < 8; ++e)
#pragma unroll
                  for (int j = 0; j < 2; ++j) O[e] = __builtin_amdgcn_mfma_f32_32x32x16_bf16(vf[e][j], pb[j], O[e], 0, 0, 0);
              __builtin_amdgcn_sched_group_barrier(0x100, ATT_PVD, 0);
#pragma unroll
              for (int e = 0; e < 16 - ATT_PVD; ++e) { __builtin_amdgcn_sched_group_barrier(0x8, 1, 0); __builtin_amdgcn_sched_group_barrier(0x100, 1, 0); }
              __builtin_amdgcn_sched_group_barrier(0x8, ATT_PVD, 0); }
            if (beta == 0) ATT_ISSUE_V(tn, st ^ 1);
            if (beta == 1) VM_WAIT();
            LDS_WAIT(); RAW_BAR();
        }
    }
    if (g == 0) RAW_BAR();
#undef ATT_KF
#undef ATT_VF
#undef ATT_ISSUE_K
#undef ATT_ISSUE_V
    lrun += __shfl_xor(lrun, 32);
    const float inv = 1.0f / lrun;
    LAS float* X = (LAS float*)(lds + (g * 2 + qs) * 32768);
    if (c == 1) {
#pragma unroll
        for (int e = 0; e < 8; ++e)
#pragma unroll
            for (int i = 0; i < 16; ++i) X[(e * 16 + i) * 64 + lane] = O[e][i] * inv;
    }
    LDS_WAIT(); RAW_BAR();
    if (c == 0) {
        float ss = 0.f;
#pragma unroll
        for (int e = 0; e < 8; ++e) {
#pragma unroll
            for (int i = 0; i < 16; ++i) { const float o = O[e][i] * inv - lam * X[(e * 16 + i) * 64 + lane]; O[e][i] = o; ss += o * o; }
            asm volatile("" : "+v"(ss) :: "memory"); }
        ss += __shfl_xor(ss, 32);
        const float rs = 1.0f / sqrtf(ss * (1.0f / 256.0f) + EPS);
        bf16* orow = CAT + (size_t)qrow * D + (U.kvh * 2 + g) * 256 + 4 * h;
#pragma unroll
        for (int e = 0; e < 8; ++e) {
#pragma unroll
            for (int i4 = 0; i4 < 4; ++i4) { const int e0 = 32 * e + 8 * i4; const f32x4 gv = *(const LAS f32x4*)(lds + SUBG_OFF + (e0 + 4 * h) * 4);
                v2u w; w.x = pk2(O[e][4 * i4] * rs * gv[0], O[e][4 * i4 + 1] * rs * gv[1]); w.y = pk2(O[e][4 * i4 + 2] * rs * gv[2], O[e][4 * i4 + 3] * rs * gv[3]);
                *(GAS v2u*)(orow + e0) = w; }
            asm volatile("" ::: "memory"); }
    }
    LDS_WAIT(); RAW_BAR();
}
}

namespace lru {
constexpr int XCB_PITCH = 272;
__device__ __forceinline__ float sigm(float x) { return __builtin_amdgcn_rcpf(1.0f + __expf(-x)); }
__device__ __forceinline__ float em1_small(float x) { float p = 1.0f / 5040.0f; p = p * x + 1.0f / 720.0f; p = p * x + 1.0f / 120.0f; p = p * x + 1.0f / 24.0f; p = p * x + 1.0f / 6.0f; p = p * x + 0.5f; p = p * x + 1.0f; return p * x; }
struct Job { int row0, n, nchunks; const float* cprev; const float* h0; float* conv_out; float* h_out; };
__device__ __forceinline__ void lru_chain(LAS unsigned char* lds, const Job& J, const bf16* XR, const bf16* GG, bf16* CAT, const bf16* GWT, const float* conv_w, const float* conv_b,
                                          const float* ga_b, const float* gx_b, const float* lam) {
    const int tid = threadIdx.x, lane = tid & 63, wid = __builtin_amdgcn_readfirstlane(tid >> 6);
    const int nl = lane & 15, g4 = lane >> 4, ch = 16 * wid + nl, gch = J.n * 128 + ch;
    LAS unsigned char* XCB = lds;
    const float w0 = conv_w[gch], w1 = conv_w[2048 + gch], w2 = conv_w[4096 + gch], w3 = conv_w[6144 + gch], cb = conv_b[gch];
    const float ba = ga_b[gch], bxv = gx_b[gch], sp = log1pf(__expf(-lam[gch]));
    bf16x8 bfr[2][4];
#pragma unroll
    for (int gt = 0; gt < 2; ++gt)
#pragma unroll
        for (int ks = 0; ks < 4; ++ks) bfr[gt][ks] = *(const GAS bf16x8*)(GWT + ((size_t)(J.n * 256 + gt * 128 + ch)) * 128 + 32 * ks + 8 * g4);
    float hin = J.h0 ? J.h0[gch] : 0.f;
    float x[19], ggv[16];
    { const bf16* xp = XR + (size_t)(J.row0 + 16 * g4 - 3) * 2048 + gch;
#pragma unroll
      for (int j = 0; j < 19; ++j) { if (j < 3) x[j] = (g4 == 0) ? (J.cprev ? J.cprev[j * 2048 + gch] : 0.f) : bf2f(xp[(size_t)j * 2048]); else x[j] = bf2f(xp[(size_t)j * 2048]); }
      const bf16* gp = GG + (size_t)(J.row0 + 16 * g4) * 2048 + gch;
#pragma unroll
      for (int i = 0; i < 16; ++i) ggv[i] = bf2f(gp[(size_t)i * 2048]); }
    for (int cs = 0; cs < J.nchunks; ++cs) {
        const int t0 = J.row0 + 64 * cs;
        float xc[16], gcur[16];
#pragma unroll
        for (int i = 0; i < 16; ++i) { float v = cb + x[i] * w0; v += x[i + 1] * w1; v += x[i + 2] * w2; v += x[i + 3] * w3; xc[i] = v; gcur[i] = ggv[i];
            *(LAS unsigned short*)(XCB + (16 * g4 + i) * XCB_PITCH + 2 * ch) = (unsigned short)pg8::cvt_pk_bf16(v, v); }
        if (cs == J.nchunks - 1 && g4 == 3) { J.conv_out[gch] = x[16]; J.conv_out[2048 + gch] = x[17]; J.conv_out[4096 + gch] = x[18]; }
        if (cs + 1 < J.nchunks) { const bf16* xp = XR + (size_t)(t0 + 64 + 16 * g4 - 3) * 2048 + gch;
#pragma unroll
            for (int j = 0; j < 19; ++j) x[j] = bf2f(xp[(size_t)j * 2048]);
            const bf16* gp = GG + (size_t)(t0 + 64 + 16 * g4) * 2048 + gch;
#pragma unroll
            for (int i = 0; i < 16; ++i) ggv[i] = bf2f(gp[(size_t)i * 2048]); }
        LDS_WAIT(); RAW_BAR();
        pg8::f32x4 acc[4][2];
        { const int trow = 16 * (nl >> 2) + (nl & 3);
#pragma unroll
          for (int rb = 0; rb < 4; ++rb) { acc[rb][0] = (pg8::f32x4){0.f, 0.f, 0.f, 0.f}; acc[rb][1] = (pg8::f32x4){0.f, 0.f, 0.f, 0.f};
#pragma unroll
              for (int ks = 0; ks < 4; ++ks) { const bf16x8 af = *(const LAS bf16x8*)(XCB + (trow + 4 * rb) * XCB_PITCH + (32 * ks + 8 * g4) * 2);
                  acc[rb][0] = __builtin_amdgcn_mfma_f32_16x16x32_bf16(af, bfr[0][ks], acc[rb][0], 0, 0, 0); acc[rb][1] = __builtin_amdgcn_mfma_f32_16x16x32_bf16(af, bfr[1][ks], acc[rb][1], 0, 0, 0); } } }
        LDS_WAIT(); RAW_BAR();
        float Hl[16], Pc[16]; float H = 0.f, P = 1.f;
#pragma unroll
        for (int rb = 0; rb < 4; ++rb)
#pragma unroll
            for (int i = 0; i < 4; ++i) { const int j = 4 * rb + i;
                const float r = sigm(acc[rb][0][i] + ba), ig = sigm(acc[rb][1][i] + bxv), la = -8.0f * r * sp, la2 = la + la;
                const float a = __expf(la), m2 = (la2 > -0.25f) ? -em1_small(la2) : 1.0f - a * a, u = __builtin_amdgcn_sqrtf(m2) * (ig * xc[j]);
                H = a * H + u; P *= a; Hl[j] = H; Pc[j] = P; }
        float Pt = 1.f, Ht = 0.f, Pp = 1.f, Hp = 0.f;
#pragma unroll
        for (int s = 0; s < 4; ++s) { const float ps = __shfl(P, nl + 16 * s), hs = __shfl(H, nl + 16 * s); if (s == g4) { Pp = Pt; Hp = Ht; } Ht = ps * Ht + hs; Pt *= ps; }
        { const float hs = Pp * hin + Hp;
          bf16* op = CAT + (size_t)(t0 + 16 * g4) * D + 2048 + gch;
#pragma unroll
          for (int j = 0; j < 16; ++j) { const float yv = (Hl[j] + Pc[j] * hs) * gcur[j]; op[(size_t)j * D] = (bf16)pg8::cvt_pk_bf16(yv, yv); } }
        hin = Pt * hin + Ht;
    }
    if (g4 == 0) J.h_out[gch] = hin;
}
}

__global__ void __launch_bounds__(NWAVES * 64, 2) mega_fwd(Args args) {
    extern __shared__ __attribute__((aligned(16))) unsigned char lds_raw[];
    LAS unsigned char* lds = (LAS unsigned char*)lds_raw;
    volatile LAS unsigned* MISC = (volatile LAS unsigned*)(lds + MISC_OFF);
    const int tid = threadIdx.x, lane = tid & 63, wave = __builtin_amdgcn_readfirstlane(tid >> 6);
    const int G = gridDim.x, bx = blockIdx.x;
    const int vcu = (G % 8 == 0) ? (bx % 8) * (G / 8) + bx / 8 : bx;
    unsigned char* ws = args.ws;
    gu32* ctl = (gu32*)(ws + WS_CTL);
    float* out = args.out;
    const float* x_prompt = args.in[0]; const float* x_sample = args.in[1]; const float* cache_k = args.in[2]; const float* cache_v = args.in[3];
    const float* state_conv = args.in[4]; const float* state_lru = args.in[5]; const float* norm_mix = args.in[6]; const float* w_in = args.in[7];
    const float* conv_w = args.in[8]; const float* conv_b = args.in[9]; const float* gate_a_w = args.in[10]; const float* gate_a_b = args.in[11];
    const float* gate_x_w = args.in[12]; const float* gate_x_b = args.in[13]; const float* lru_lambda = args.in[14];
    const float* lq1 = args.in[15]; const float* lk1 = args.in[16]; const float* lq2 = args.in[17]; const float* lk2 = args.in[18]; const float* subln_g = args.in[19];
    const float* w_out = args.in[20]; const float* norm_mlp = args.in[21]; const float* w_up = args.in[22]; const float* w_down = args.in[23]; const float* norm_final = args.in[24];
    bf16* WIN = (bf16*)(ws + WS_WIN); bf16* WOUT = (bf16*)(ws + WS_WOUT); bf16* WUP = (bf16*)(ws + WS_WUP); bf16* WDN = (bf16*)(ws + WS_WDN);
    bf16* HN = (bf16*)(ws + WS_HN); bf16* Z = (bf16*)(ws + WS_Z); bf16* XN = (bf16*)(ws + WS_XN); bf16* CAT = XN; bf16* QB = (bf16*)(ws + WS_QB);
    bf16* KP = (bf16*)(ws + WS_KP); bf16* KS = (bf16*)(ws + WS_KS); bf16* VTP = (bf16*)(ws + WS_VTP); bf16* VTS = (bf16*)(ws + WS_VTS);
    bf16* XR = (bf16*)(ws + WS_XR); bf16* GG = (bf16*)(ws + WS_GG); bf16* GWT = (bf16*)(ws + WS_GWT); float* TAB = (float*)(ws + WS_TAB);
    float* RSS1 = (float*)(ws + WS_CTL) + CW_RSS1;

    for (int u = tid; u < LDSCTL_BYTES / 4; u += NWAVES * 64) ((LAS unsigned*)(lds + LDSCTL_OFF))[u] = 0u;
    __syncthreads();
    XcdBarrier bar; bar.bar = (unsigned*)(ctl + CW_BAR); bar.x = 0; bar.st = nullptr;
    if (N_LAUNCHES == 1) bar = xcd_barrier_post((unsigned*)(ctl + CW_BAR), MISC + 8);
#define GRID_BAR() do { if (N_LAUNCHES == 1) xcd_barrier(bar); } while (0)
    const int lo = args.ph_lo, hi = args.ph_hi;
#ifndef PH_MASK
#define PH_MASK 0x7f
#endif
#define IN(k) (((PH_MASK >> (k)) & 1) && lo <= (k) && (k) < hi)
#define BOTH(k) (IN(k) && IN((k) + 1))

#ifndef P0_REPS
#define P0_REPS 1
#endif
#ifndef P2_REPS
#define P2_REPS 1
#endif
#ifndef P4_REPS
#define P4_REPS 1
#endif
    if (IN(0)) {
      for (int rep0 = 0; rep0 < P0_REPS; ++rep0) {
        LAS float* scr = (LAS float*)(lds + wave * 16384);
        const int gw = vcu * NWAVES + wave, NGW = G * NWAVES;
        constexpr int I_IN = 64 * 256, I_OUT = 64 * 128, I_UP = 64 * 512, I_CV = 128 * 256, I_GW = 32 * 8;
        constexpr int NITEMS = I_IN + I_OUT + I_UP + I_CV + I_GW;
        for (int it = gw; it < NITEMS; it += NGW) {
            int r = it;
            if (r < I_IN) { tr_matrix_item(w_in, D, NIN, NIN, WIN, D, scr, r, lane, nullptr); continue; } r -= I_IN;
            if (r < I_OUT) { tr_matrix_item(w_out, D, D, D, WOUT, D, scr, r, lane, nullptr); continue; } r -= I_OUT;
            if (r < I_UP) { tr_matrix_item(w_up, D, DFF, DFF, WUP, D, scr, r, lane, norm_mlp); continue; } r -= I_UP;
            if (r < I_CV) { const int sl = r >> 8, sb = sl >> 2, kvh = sl & 3;
                tr_matrix_item(cache_v + (size_t)sb * PAST * 1024 + kvh * 256, PAST, 256, 1024, VTS + (size_t)sl * 256 * TKS, TKS, scr, r & 255, lane, nullptr); continue; } r -= I_CV;
            { const int gi = r >> 3, gt = gi >> 4, nb = gi & 15;
              tr_matrix_item((gt ? gate_x_w : gate_a_w) + (size_t)nb * 16384, 128, 128, 128, GWT + (size_t)(nb * 256 + gt * 128) * 128, 128, scr, r & 7, lane, nullptr); }
        }
        for (int m = gw; m < M; m += NGW) {
            const GAS f32x4* xr = (const GAS f32x4*)(m < MP ? x_prompt + (size_t)m * D : x_sample + (size_t)(m - MP) * D) + lane;
            f32x4 v[16]; float s = 0.f;
#pragma unroll
            for (int j = 0; j < 16; ++j) { v[j] = xr[64 * j]; s += (v[j][0] * v[j][0] + v[j][1] * v[j][1]) + (v[j][2] * v[j][2] + v[j][3] * v[j][3]); }
            const float rstd = 1.0f / sqrtf(wave_sum(s) * (1.0f / D) + EPS);
            GAS v2u* o8 = (GAS v2u*)(XN + (size_t)m * D) + lane;
#pragma unroll
            for (int j = 0; j < 16; ++j) { const f32x4 gv = ((const GAS f32x4*)norm_mix)[lane + 64 * j]; v2u w; w.x = pk2(v[j][0] * rstd * gv[0], v[j][1] * rstd * gv[1]); w.y = pk2(v[j][2] * rstd * gv[2], v[j][3] * rstd * gv[3]); o8[64 * j] = w; }
        }
        for (int rr = gw; rr < 32 * PAST; rr += NGW) {
            const int sb = rr >> 11, t = rr & 2047;
            const GAS f32x4* src = (const GAS f32x4*)(cache_k + (size_t)rr * 1024); GAS v4u* dst = (GAS v4u*)(KS + ((size_t)sb * TKS + t) * 1024);
#pragma unroll
            for (int j = 0; j < 2; ++j) { const f32x4 a = src[j * 128 + lane * 2], b = src[j * 128 + lane * 2 + 1]; v4u w; w.x = pk2(a[0], a[1]); w.y = pk2(a[2], a[3]); w.z = pk2(b[0], b[1]); w.w = pk2(b[2], b[3]); dst[j * 64 + lane] = w; }
        }
        for (int jb = gw; jb < 1024; jb += NGW) rope_entry(jb * 64 + lane, TAB);
      }
        if (BOTH(0)) GRID_BAR();
    }

    if (IN(1)) {
        pg8::Gemm g{XN, WIN, M, NIN, D, D}; pg8::StaticOrder S; S.init(M, NIN, G, bx);
        pg8::EpiProj E{QB, KP, KS, VTP, VTS, XR, GG, out, TAB};
#ifndef P1_REPS
#define P1_REPS 1
#endif
        for (int rep1 = 0; rep1 < P1_REPS; ++rep1)
        pg8::gemm_phase<pg8::EpiProj, pg8::StaticOrder, PG8_ALIGN, PG8_SP2>(lds, g, S, E);
        if (BOTH(1)) GRID_BAR();
    }

    if (IN(2)) {
      for (int rep2 = 0; rep2 < P2_REPS; ++rep2) {
#ifndef P2_NO_LRU
        if (args.variant != 1) {
            lru::Job J;
            if (bx < 64) { const int b = bx >> 4;
                J.row0 = b * TP; J.n = bx & 15; J.nchunks = TP / 64; J.cprev = nullptr; J.h0 = nullptr; J.conv_out = out + O_CP + (size_t)b * 3 * LW; J.h_out = out + O_LP + (size_t)b * LW;
                lru::lru_chain(lds, J, XR, GG, CAT, GWT, conv_w, conv_b, gate_a_b, gate_x_b, lru_lambda);
            } else for (int v = bx - 64; v < 512; v += G - 64) { const int sb = v >> 4;
                J.row0 = MP + sb * TS; J.n = v & 15; J.nchunks = 1; J.cprev = state_conv + (size_t)sb * 3 * LW; J.h0 = state_lru + (size_t)sb * LW;
                J.conv_out = out + O_CS + (size_t)sb * 3 * LW; J.h_out = out + O_LS + (size_t)sb * LW;
                lru::lru_chain(lds, J, XR, GG, CAT, GWT, conv_w, conv_b, gate_a_b, gate_x_b, lru_lambda); }
        }
#endif
#ifndef P2_NO_ATT
        float lam;
        { const float d1 = wave_sum(lq1[lane] * lk1[lane] + lq1[lane + 64] * lk1[lane + 64]), d2 = wave_sum(lq2[lane] * lk2[lane] + lq2[lane + 64] * lk2[lane + 64]); lam = expf(d1) - expf(d2) + LAM_INIT; }
        if (tid < 256) ((LAS float*)(lds + SUBG_OFF))[tid] = subln_g[tid] * (1.0f - LAM_INIT);
        const unsigned myq = xb_xcc_id() & 7u; unsigned qdone = 0u;
        if (args.variant != 2)
        for (;;) {
            if (tid == 0) { unsigned res = 0xffffffffu;
                for (unsigned k = 0; k < 8u; ++k) { const unsigned q = (myq + k) & 7u; if ((qdone >> q) & 1u) continue;
                    const unsigned p = __hip_atomic_fetch_add((unsigned*)(ctl + CW_QCTR + 64 * (q + 8 * (rep2 + args.qslot))), 1u, RLX_AGENT);
                    if (p < 144u) { res = q * 256u + p; break; } qdone |= 1u << q; }
                MISC[16] = res; }
            LDS_WAIT(); RAW_BAR();
            const unsigned res = (unsigned)__builtin_amdgcn_readfirstlane((int)MISC[16]);
            LDS_WAIT(); RAW_BAR();
            if (res == 0xffffffffu) break;
            const int q = (int)(res >> 8), p = (int)(res & 255u);
            att::Unit U;
            int qc = -1, pair = 0, su = -1;
            if (p < 62) { qc = 63 - (p >> 1); pair = 2 * q + (p & 1); } else if (p < 78) su = 16 * q + (p - 62); else { const int r = p - 78; qc = 32 - (r >> 1); pair = 2 * q + (r & 1); }
            if (su >= 0) { const int sb = su >> 2, kvh = su & 3; U.Kb = KS + (size_t)sb * TKS * 1024 + kvh * 256; U.Vt = VTS + (size_t)(sb * 4 + kvh) * 256 * TKS; U.ldv = TKS; U.ntiles = TKS / 64; U.qrow0 = MP + sb * TS; U.kvh = kvh; }
            else { const int b = pair >> 2, kvh = pair & 3; U.Kb = KP + (size_t)b * TP * 1024 + kvh * 256; U.Vt = VTP + (size_t)(b * 4 + kvh) * 256 * TP; U.ldv = TP; U.ntiles = qc + 1; U.qrow0 = b * TP + qc * 64; U.kvh = kvh; }
            att::attn_unit(lds, U, QB, CAT, subln_g, lam);
        }
#endif
      }
        if (BOTH(2)) GRID_BAR();
    }

    if (IN(3)) {
        pg8::Gemm g{CAT, WOUT, M, D, D, D}; pg8::StaticOrder S; S.init(M, D, G, bx);
        pg8::EpiRes1 E{x_prompt, x_sample, HN, RSS1};
        pg8::gemm_phase<pg8::EpiRes1, pg8::StaticOrder, PG8_ALIGN, PG8_SP2>(lds, g, S, E);
        {
            const int nfull = (72 * 16) % G, nidle = G - nfull;
            if (nfull > 0 && bx >= nfull) { LAS float* scr = (LAS float*)(lds + wave * 16384);
                for (int it = (bx - nfull) * NWAVES + wave; it < 256 * 128; it += nidle * NWAVES) tr_matrix_item(w_down, DFF, D, D, WDN, DFF, scr, it, lane, nullptr); }
            else if (nfull == 0) { LAS float* scr = (LAS float*)(lds + wave * 16384);
                for (int it = bx * NWAVES + wave; it < 256 * 128; it += G * NWAVES) tr_matrix_item(w_down, DFF, D, D, WDN, DFF, scr, it, lane, nullptr); } }
        if (BOTH(3)) GRID_BAR();
    }

    if (IN(4)) {
        pg8::Gemm g{HN, WUP, M, DFF, D, D}; pg8::StaticOrder S; S.init(M, DFF, G, bx);
        pg8::EpiUp E{Z};
        for (int rep4 = 0; rep4 < P4_REPS; ++rep4)
        pg8::gemm_phase<pg8::EpiUp, pg8::StaticOrder, PG8_ALIGN, PG8_SP2>(lds, g, S, E);
        if (BOTH(4)) GRID_BAR();
    }

    if (IN(5)) {
#define P5_SIGNAL(p) do { asm volatile("s_waitcnt vmcnt(0)" ::: "memory"); __syncthreads(); \
        if (tid == 0) { __builtin_amdgcn_fence(__ATOMIC_RELEASE, "agent"); asm volatile("s_waitcnt vmcnt(0)" ::: "memory"); (void)xb_add((unsigned*)(ctl + CW_P6) + (p), 1u); } } while (0)
        { const int hu = vcu, tile = hu >> 1, kh = hu & 1;
          pg8::Gemm g{Z + (size_t)MP * DFF + (size_t)kh * (DFF / 2), WDN + (size_t)kh * (DFF / 2), MS, D, DFF / 2, DFF};
          pg8::OneUnit S; S.u.pm = tile & 7; S.u.pn = tile >> 3; S.valid = (G == 256);
          pg8::EpiPart E{(float*)(ws + WS_SP) + (size_t)kh * MS * D, RSS1 + MP};
          pg8::gemm_phase<pg8::EpiPart, pg8::OneUnit, false, PG8_SP2>(lds, g, S, E); }
        P5_SIGNAL(64 * 8);
        { pg8::Gemm g{Z, WDN, MP, D, DFF, DFF}; pg8::StaticOrder S; S.init(MP, D, G, bx);
          pg8::EpiDown E{HN, RSS1};
          pg8::gemm_phase<pg8::EpiDown, pg8::StaticOrder, PG8_ALIGN, PG8_SP2>(lds, g, S, E); }
        P5_SIGNAL(64 * (bx & 7));
#undef P5_SIGNAL
        if (BOTH(5) && G != 256) GRID_BAR();
    }

    if (IN(6)) {
        const float* SP = (const float*)(ws + WS_SP);
#define P6_ROW(m_) do { const int m = (m_); \
            GAS f32x4* yr = (GAS f32x4*)(out + O_Y + (size_t)m * D) + lane; \
            const GAS v2u* hr = (const GAS v2u*)(HN + (size_t)m * D) + lane; \
            f32x4 v[16]; float s = 0.f; \
            _Pragma("unroll") for (int j = 0; j < 16; ++j) { const v2u hv = hr[64 * j]; v[j][0] = __builtin_bit_cast(float, hv.x << 16); v[j][1] = __builtin_bit_cast(float, hv.x & 0xffff0000u); v[j][2] = __builtin_bit_cast(float, hv.y << 16); v[j][3] = __builtin_bit_cast(float, hv.y & 0xffff0000u); } \
            if (m >= MP) { const GAS f32x4* p0 = (const GAS f32x4*)(SP + (size_t)(m - MP) * D) + lane; const GAS f32x4* p1 = (const GAS f32x4*)(SP + (size_t)(MS + m - MP) * D) + lane; \
                _Pragma("unroll") for (int j = 0; j < 16; ++j) v[j] = v[j] + p0[64 * j] + p1[64 * j]; } \
            _Pragma("unroll") for (int j = 0; j < 16; ++j) s += (v[j][0] * v[j][0] + v[j][1] * v[j][1]) + (v[j][2] * v[j][2] + v[j][3] * v[j][3]); \
            const float rstd = 1.0f / sqrtf(wave_sum(s) * (1.0f / D) + EPS); \
            _Pragma("unroll") for (int j = 0; j < 16; ++j) { const f32x4 gv = ((const GAS f32x4*)norm_final)[lane + 64 * j]; yr[64 * j] = v[j] * rstd * gv; } } while (0)
        if (G == 256) {
            unsigned* pc = (unsigned*)(ctl + CW_P6); unsigned* bw = (unsigned*)(ctl + CW_BAR);
            const unsigned myg = (unsigned)bx & 7u; unsigned pend = 0x1ffu;
            for (;;) {
                if (tid == 0) { unsigned res = 0xffffffffu, sp = 0u;
                    while (pend) {
                        for (unsigned k = 0; k < 9u; ++k) { const unsigned sx = (k == 0u) ? myg : (k == 1u) ? 8u : ((myg + k - 1u) & 7u);
                            if (!((pend >> sx) & 1u)) continue;
                            if (xb_ld(pc + 64 * sx) < (sx == 8u ? 256u : 32u)) continue;
                            const unsigned p = xb_add(pc + 1024 + 64 * sx, 1u);
                            if (p < 128u) { res = sx * 256u + p; break; } pend &= ~(1u << sx); }
                        if (res != 0xffffffffu || !pend) break;
                        __builtin_amdgcn_s_sleep(2);
                        if ((++sp & 255u) == 0u) { if (xb_ld(&bw[XB_TMO])) break; if (sp > XB_SPIN_CAP) { atomicAdd(&bw[XB_TMO], 1u); break; } } }
                    __builtin_amdgcn_fence(__ATOMIC_ACQUIRE, "agent"); asm volatile("s_waitcnt vmcnt(0)" ::: "memory");
                    MISC[16] = res; }
                LDS_WAIT(); RAW_BAR();
                const unsigned res = (unsigned)__builtin_amdgcn_readfirstlane((int)MISC[16]);
                LDS_WAIT(); RAW_BAR();
                if (res == 0xffffffffu) break;
                const int sx = (int)(res >> 8), r0 = (sx == 8 ? MP : sx * 2048) + 16 * (int)(res & 255u) + wave;
                P6_ROW(r0); P6_ROW(r0 + 8);
            }
        } else {
            const int gw = vcu * NWAVES + wave, NGW = G * NWAVES;
            for (int m2 = gw; m2 < M; m2 += NGW) P6_ROW(m2);
        }
#undef P6_ROW
    }
#undef IN
#undef BOTH
#undef GRID_BAR
}

extern "C" void kernel_launch(void* const* d_in, const int* in_sizes, int n_in, void* d_out, int out_size, void* d_ws, size_t ws_size, hipStream_t stream) {
    static int grid = 0;
    if (grid == 0) {
        if (n_in != 25 || in_sizes[0] != MP * D || (size_t)out_size != O_END || ws_size < WS_END) { fprintf(stderr, "kernel_launch: unexpected shapes (n_in %d, in0 %d, out %d, ws %zu); nothing launched\n", n_in, n_in > 0 ? in_sizes[0] : -1, out_size, ws_size); grid = -1; return; }
        int dev = 0, cus = 0, per_cu = 0;
        if (hipGetDevice(&dev) != hipSuccess || hipDeviceGetAttribute(&cus, hipDeviceAttributeMultiprocessorCount, dev) != hipSuccess) { grid = -1; return; }
        if (hipFuncSetAttribute((const void*)mega_fwd, hipFuncAttributeMaxDynamicSharedMemorySize, LDS_BYTES) != hipSuccess) { fprintf(stderr, "kernel_launch: hipFuncSetAttribute failed\n"); grid = -1; return; }
        if (hipOccupancyMaxActiveBlocksPerMultiprocessor(&per_cu, (const void*)mega_fwd, NWAVES * 64, LDS_BYTES) != hipSuccess || per_cu < 1) { fprintf(stderr, "kernel_launch: occupancy query reports %d workgroups per CU\n", per_cu); }
        (void)hipGetLastError();
        grid = cus;
        if (grid != 256) { fprintf(stderr, "kernel_launch: built for a 256-CU device (got %d); nothing launched\n", cus); grid = -1; return; }
    }
    if (grid < 0) return;
    if (hipMemsetAsync((char*)d_ws + WS_CTL, 0, CTL_ZERO_BYTES, stream) != hipSuccess) return;
    Args a{};
    for (int i = 0; i < 25; ++i) a.in[i] = (const float*)d_in[i];
    a.out = (float*)d_out; a.ws = (unsigned char*)d_ws;
#ifdef PROBE_SEQ
    const int seq[] = PROBE_SEQ; int nq = 0;
    for (int li = 0; li < (int)(sizeof(seq) / sizeof(seq[0])); ++li) {
        a.ph_lo = seq[li] % 10; a.ph_hi = seq[li] % 10 + 1; a.variant = seq[li] / 10; a.qslot = (seq[li] % 10 == 2) ? nq++ : 0;
#else
    for (int li = 0; li < N_LAUNCHES; ++li) {
        a.ph_lo = (N_LAUNCHES == 1) ? 0 : li; a.ph_hi = (N_LAUNCHES == 1) ? N_PHASES : li + 1;
#endif
        hipLaunchKernelGGL(mega_fwd, dim3(grid), dim3(NWAVES * 64), LDS_BYTES, stream, a);
        const hipError_t le = hipPeekAtLastError();
        if (le != hipSuccess) { fprintf(stderr, "kernel_launch: launch %d failed: %s\n", li, hipGetErrorName(le)); break; }
    }
}
```

```cpp
#include <hip/hip_runtime.h>
#include <cstdio>
#include <cstdint>
#ifndef PG8_WGM_XCD
#define PG8_WGM_XCD 1
#endif
#ifndef PG8_SUB9
#define PG8_SUB9 9
#endif
#ifndef PG8_SUB8
#define PG8_SUB8 8
#endif
namespace pg8 {
#define PG8_LAS __attribute__((address_space(3)))
typedef unsigned short bf16_t;
typedef short bf16x8 __attribute__((ext_vector_type(8)));
typedef float f32x4 __attribute__((ext_vector_type(4)));
typedef unsigned u32x4 __attribute__((ext_vector_type(4)));
constexpr int BM = 256, BK = 64, HALF = 128, HTB = HALF * BK * 2  , STAGE_BYTES = 8 * HTB, NXCD = 8, WGM = 8;

__host__ __device__ __forceinline__ int lds_byte(int r, int c) { const int st = (r >> 4) * 2 + (c >> 5), rr = r & 15, cc = c & 31, ob = rr * 64 + cc * 2; return st * 1024 + (ob ^ (((ob >> 9) & 1) << 5)); }
__host__ __device__ __forceinline__ void stage_rc(int b, int& R, int& C) { const int st = b / 1024, sb = b % 1024, swz = sb ^ (((sb >> 9) & 1) << 5); R = (st >> 1) * 16 + swz / 64; C = (st & 1) * 32 + (swz % 64) / 2; }
__host__ __device__ __forceinline__ int perm32(int rho) { const int n = rho >> 4, i = rho & 15; return 8 * (i >> 2) + 4 * n + (i & 3); }

struct Unit { int pm, pn; };
struct Gemm { const bf16_t* A; const bf16_t* Bt; int M, N, K, ld; };

struct StaticOrder {
    int nM, nN, nwg, G, c, wgm;
    __host__ __device__ void init(int M, int N, int G_, int c_) { nM = M / BM; nN = N / BM; nwg = nM * nN; G = G_; c = c_; wgm = (PG8_WGM_XCD && nM % NXCD == 0) ? nM / NXCD : WGM; if (PG8_WGM_XCD && nM % NXCD == 0 && nM / NXCD == 9) wgm = PG8_SUB9; if (PG8_WGM_XCD && nM % NXCD == 0 && nM / NXCD == 8) wgm = PG8_SUB8; }
    __host__ __device__ bool next(int i, Unit& u) const {
        const long L = (long)i * G + c; if (L >= nwg) return false;
        int wgid = (int)L; { const int q = nwg / NXCD, r = nwg % NXCD, xcd = wgid % NXCD, off = wgid / NXCD; wgid = (xcd < r ? xcd * (q + 1) : r * (q + 1) + (xcd - r) * q) + off; }
        const int nig = wgm * nN, gid = wgid / nig, fm = gid * wgm, gsz = (nM - fm) < wgm ? (nM - fm) : wgm;
        u.pm = fm + ((wgid % nig) % gsz); u.pn = (wgid % nig) / gsz; return true;
    }
    __device__ __forceinline__ void a_ready(const Unit&) const {}
    __device__ __forceinline__ void done(const Unit&) const {}
};

__device__ __forceinline__ unsigned cvt_pk_bf16(float lo, float hi) { unsigned r; asm volatile("v_cvt_pk_bf16_f32 %0, %1, %2" : "=v"(r) : "v"(lo), "v"(hi)); return r; }
typedef float f32x2 __attribute__((ext_vector_type(2)));
template <class Epi, class Sched, bool ALIGN_EPI = false, bool SP2 = false>
__device__ __forceinline__ void gemm_phase(PG8_LAS unsigned char* lds, const Gemm g, const Sched& S, const Epi& E) {
    const int tid = threadIdx.x, wid = __builtin_amdgcn_readfirstlane(tid >> 6), lane = tid & 63, wr = wid >> 2, wc = wid & 3, fr = lane & 15, fq = lane >> 4;
    const int K = g.ld, nt = g.K / BK;
    unsigned voffA[2], voffB[2];
#pragma unroll
    for (int i = 0; i < 2; ++i) { int R, C; stage_rc(tid * 16 + i * 8192, R, C); const int Rb = Epi::PERM ? ((R & ~31) + perm32(R & 31)) : R;
        voffA[i] = (unsigned)(R * K + C) * 2u; voffB[i] = (unsigned)(Rb * K + C) * 2u; }
    const size_t kstep = (size_t)(BK * 2);
    const size_t hstep = (size_t)HALF * K * 2;
    const size_t tstep = 2 * hstep;
    const unsigned ldsw = (unsigned)wid * 1024u;
    const int aoff = lds_byte(wr * 64 + fr, fq * 8), boff = lds_byte(wc * 32 + fr, fq * 8);
#define PG8_SA(b, h) (((b) * 2 + (h)) * HTB)
#define PG8_SB(b, h) ((4 + (b) * 2 + (h)) * HTB)
#define PG8_STAGE(bufoff, gbase, voff) do { _Pragma("unroll") for (int _i = 0; _i < 2; ++_i) \
        __builtin_amdgcn_global_load_lds((const unsigned*)((const char*)(gbase) + (voff)[_i]), (PG8_LAS unsigned*)(lds + (bufoff) + ldsw + _i * 8192), 16, 0, 0); } while (0)
#define PG8_LDA(dst, b, h) do { _Pragma("unroll") for (int m = 0; m < 4; ++m) _Pragma("unroll") for (int k = 0; k < 2; ++k) dst[m][k] = *(const PG8_LAS bf16x8*)(lds + PG8_SA(b, h) + aoff + m * 2048 + k * 1024); } while (0)
#define PG8_LDB(dst, b, h) do { _Pragma("unroll") for (int n = 0; n < 2; ++n) _Pragma("unroll") for (int k = 0; k < 2; ++k) dst[n][k] = *(const PG8_LAS bf16x8*)(lds + PG8_SB(b, h) + boff + n * 2048 + k * 1024); } while (0)
#ifndef PG8_MMA_ORDER
#define PG8_MMA_ORDER 0
#endif
#if PG8_MMA_ORDER == 0
#define PG8_MMA(ai, bj, At, Bt) do { __builtin_amdgcn_s_setprio(1); _Pragma("unroll") for (int m = 0; m < 4; ++m) _Pragma("unroll") for (int n = 0; n < 2; ++n) _Pragma("unroll") for (int k = 0; k < 2; ++k) \
        acc[ai][bj][m][n] = __builtin_amdgcn_mfma_f32_16x16x32_bf16(Bt[n][k], At[m][k], acc[ai][bj][m][n], 0, 0, 0); __builtin_amdgcn_s_setprio(0); } while (0)
#elif PG8_MMA_ORDER == 1
#define PG8_MMA(ai, bj, At, Bt) do { __builtin_amdgcn_s_setprio(1); _Pragma("unroll") for (int k = 0; k < 2; ++k) _Pragma("unroll") for (int n = 0; n < 2; ++n) _Pragma("unroll") for (int m = 0; m < 4; ++m) \
        acc[ai][bj][m][n] = __builtin_amdgcn_mfma_f32_16x16x32_bf16(Bt[n][k], At[m][k], acc[ai][bj][m][n], 0, 0, 0); __builtin_amdgcn_s_setprio(0); } while (0)
#elif PG8_MMA_ORDER == 3
#define PG8_MMA(ai, bj, At, Bt) do { __builtin_amdgcn_s_setprio(1); _Pragma("unroll") for (int n = 0; n < 2; ++n) _Pragma("unroll") for (int m = 0; m < 4; ++m) _Pragma("unroll") for (int k = 0; k < 2; ++k) \
        acc[ai][bj][m][n] = __builtin_amdgcn_mfma_f32_16x16x32_bf16(Bt[n][k], At[m][k], acc[ai][bj][m][n], 0, 0, 0); __builtin_amdgcn_s_setprio(0); } while (0)
#elif PG8_MMA_ORDER == 4
#define PG8_MMA(ai, bj, At, Bt) do { _Pragma("unroll") for (int m = 0; m < 4; ++m) _Pragma("unroll") for (int n = 0; n < 2; ++n) _Pragma("unroll") for (int k = 0; k < 2; ++k) \
        acc[ai][bj][m][n] = __builtin_amdgcn_mfma_f32_16x16x32_bf16(Bt[n][k], At[m][k], acc[ai][bj][m][n], 0, 0, 0); } while (0)
#else
#define PG8_MMA(ai, bj, At, Bt) do { __builtin_amdgcn_s_setprio(1); _Pragma("unroll") for (int k = 0; k < 2; ++k) _Pragma("unroll") for (int m = 0; m < 4; ++m) _Pragma("unroll") for (int n = 0; n < 2; ++n) \
        acc[ai][bj][m][n] = __builtin_amdgcn_mfma_f32_16x16x32_bf16(Bt[n][k], At[m][k], acc[ai][bj][m][n], 0, 0, 0); __builtin_amdgcn_s_setprio(0); } while (0)
#endif
#define PG8_WAIT_V(n) asm volatile("s_waitcnt vmcnt(" #n ")" ::: "memory")
#define PG8_WAIT_L(n) asm volatile("s_waitcnt lgkmcnt(" #n ")" ::: "memory")
#define PG8_BAR __builtin_amdgcn_s_barrier()
#define PG8_SCHED __builtin_amdgcn_sched_barrier(0)
    Unit cur, nxt; int ui = 0;
    if (!S.next(0, cur)) return;
    f32x4 acc[2][2][4][2];
#pragma unroll
    for (int a = 0; a < 2; ++a)
#pragma unroll
        for (int b = 0; b < 2; ++b)
#pragma unroll
            for (int m = 0; m < 4; ++m)
#pragma unroll
                for (int n = 0; n < 2; ++n) acc[a][b][m][n] = (f32x4){0.f, 0.f, 0.f, 0.f};
    bf16x8 At[4][2], B0[2][2], B1[2][2];
    const char* cA = (const char*)g.A + (size_t)cur.pm * tstep; const char* cB = (const char*)g.Bt + (size_t)cur.pn * tstep;
    S.a_ready(cur);
    if constexpr (SP2) {
        PG8_STAGE(PG8_SB(0, 0), cB, voffB); PG8_STAGE(PG8_SB(0, 1), cB + hstep, voffB); PG8_STAGE(PG8_SA(0, 0), cA, voffA); PG8_STAGE(PG8_SA(0, 1), cA + hstep, voffA);
        if (wr == 1) PG8_BAR;
        PG8_WAIT_V(2); PG8_BAR;
        PG8_STAGE(PG8_SB(1, 0), cB + kstep, voffB); PG8_STAGE(PG8_SA(1, 0), cA + kstep, voffA); PG8_STAGE(PG8_SB(1, 1), cB + hstep + kstep, voffB);
        PG8_WAIT_V(6); PG8_BAR;
    } else {
        PG8_STAGE(PG8_SB(0, 0), cB, voffB); PG8_STAGE(PG8_SA(0, 0), cA, voffA); PG8_STAGE(PG8_SB(0, 1), cB + hstep, voffB); PG8_STAGE(PG8_SA(0, 1), cA + hstep, voffA);
        if (wr == 1) PG8_BAR;
        PG8_WAIT_V(4); PG8_BAR;
        PG8_STAGE(PG8_SB(1, 0), cB + kstep, voffB); PG8_STAGE(PG8_SA(1, 0), cA + kstep, voffA); PG8_STAGE(PG8_SB(1, 1), cB + hstep + kstep, voffB);
        PG8_WAIT_V(6); PG8_BAR;
    }
    for (;;) {
        const bool has_next = S.next(ui + 1, nxt);
        const char* nA = has_next ? (const char*)g.A + (size_t)nxt.pm * tstep : cA; const char* nB = has_next ? (const char*)g.Bt + (size_t)nxt.pn * tstep : cB;
        for (int t = 0; t < nt; t += 2) {
            const bool last = (t == nt - 2);
            const char* a1 = cA + (size_t)(t + 1) * kstep;
            const char* a2 = last ? nA : cA + (size_t)(t + 2) * kstep; const char* b2 = last ? nB : cB + (size_t)(t + 2) * kstep;
            const char* a3 = a2 + kstep; const char* b3 = b2 + kstep;
            if (last && has_next) S.a_ready(nxt);
            if constexpr (SP2) {
            PG8_LDB(B0, 0, 0); PG8_LDB(B1, 0, 1); PG8_SCHED; PG8_LDA(At, 0, 0); PG8_STAGE(PG8_SA(1, 1), a1 + hstep, voffA);
            PG8_WAIT_V(8); PG8_WAIT_L(0); PG8_BAR; PG8_MMA(0, 0, At, B0); PG8_MMA(0, 1, At, B1); PG8_BAR; PG8_SCHED;
            PG8_LDA(At, 0, 1); PG8_STAGE(PG8_SB(0, 0), b2, voffB); PG8_STAGE(PG8_SB(0, 1), b2 + hstep, voffB); PG8_STAGE(PG8_SA(0, 0), a2, voffA);
            PG8_WAIT_V(8); PG8_WAIT_L(0); PG8_BAR; PG8_MMA(1, 0, At, B0); PG8_MMA(1, 1, At, B1); PG8_BAR; PG8_SCHED;
            PG8_LDB(B0, 1, 0); PG8_LDB(B1, 1, 1); PG8_SCHED; PG8_LDA(At, 1, 0); PG8_STAGE(PG8_SA(0, 1), a2 + hstep, voffA);
            PG8_WAIT_V(8); PG8_WAIT_L(0); PG8_BAR; PG8_MMA(0, 0, At, B0); PG8_MMA(0, 1, At, B1); PG8_BAR; PG8_SCHED;
            PG8_LDA(At, 1, 1); PG8_STAGE(PG8_SB(1, 0), b3, voffB); PG8_STAGE(PG8_SB(1, 1), b3 + hstep, voffB); PG8_STAGE(PG8_SA(1, 0), a3, voffA);
            PG8_WAIT_V(8); PG8_WAIT_L(0); PG8_BAR; PG8_MMA(1, 0, At, B0); PG8_MMA(1, 1, At, B1); PG8_BAR; PG8_SCHED;
            } else {
            PG8_LDB(B0, 0, 0); PG8_SCHED; PG8_LDA(At, 0, 0); PG8_STAGE(PG8_SA(1, 1), a1 + hstep, voffA);
            PG8_WAIT_L(8); PG8_BAR; PG8_WAIT_L(0); PG8_MMA(0, 0, At, B0); PG8_BAR; PG8_SCHED;
            PG8_LDB(B1, 0, 1); PG8_STAGE(PG8_SB(0, 0), b2, voffB);
            PG8_BAR; PG8_WAIT_L(0); PG8_MMA(0, 1, At, B1); PG8_BAR;
            PG8_LDA(At, 0, 1); PG8_STAGE(PG8_SA(0, 0), a2, voffA);
            PG8_BAR; PG8_WAIT_L(0); PG8_MMA(1, 0, At, B0); PG8_BAR; PG8_SCHED;
            PG8_STAGE(PG8_SB(0, 1), b2 + hstep, voffB);
            PG8_WAIT_V(6); PG8_BAR; PG8_MMA(1, 1, At, B1); PG8_BAR;
            PG8_LDB(B0, 1, 0); PG8_SCHED; PG8_LDA(At, 1, 0); PG8_STAGE(PG8_SA(0, 1), a2 + hstep, voffA);
            PG8_WAIT_L(8); PG8_BAR; PG8_WAIT_L(0); PG8_MMA(0, 0, At, B0); PG8_BAR; PG8_SCHED;
            PG8_LDB(B1, 1, 1); PG8_STAGE(PG8_SB(1, 0), b3, voffB);
            PG8_BAR; PG8_WAIT_L(0); PG8_MMA(0, 1, At, B1); PG8_BAR;
            PG8_LDA(At, 1, 1); PG8_STAGE(PG8_SA(1, 0), a3, voffA);
            PG8_BAR; PG8_WAIT_L(0); PG8_MMA(1, 0, At, B0); PG8_BAR; PG8_SCHED;
            PG8_STAGE(PG8_SB(1, 1), b3 + hstep, voffB);
            PG8_WAIT_V(6); PG8_BAR; PG8_MMA(1, 1, At, B1); PG8_BAR;
            }
        }
        if constexpr (ALIGN_EPI) { if (wr == 0) PG8_BAR; }
        if constexpr (!Epi::AFTER_DRAIN) { E(acc, cur, wr, wc, fr, fq); S.done(cur); }
        if (!has_next) break;
#pragma unroll
        for (int a = 0; a < 2; ++a)
#pragma unroll
            for (int b = 0; b < 2; ++b)
#pragma unroll
                for (int m = 0; m < 4; ++m)
#pragma unroll
                    for (int n = 0; n < 2; ++n) acc[a][b][m][n] = (f32x4){0.f, 0.f, 0.f, 0.f};
        cur = nxt; cA = nA; cB = nB; ++ui;
        if constexpr (ALIGN_EPI) { if (wr == 1) PG8_BAR; }
    }
    PG8_WAIT_V(0);
    if constexpr (!ALIGN_EPI) { if (wr == 0) PG8_BAR; }
    PG8_BAR;
    if constexpr (Epi::AFTER_DRAIN) { E.fused(acc, cur, wr, wc, fr, fq, lds, wid, lane); S.done(cur); }
#undef PG8_SA
#undef PG8_SB
#undef PG8_STAGE
#undef PG8_LDA
#undef PG8_LDB
#undef PG8_MMA
#undef PG8_WAIT_V
#undef PG8_WAIT_L
#undef PG8_BAR
#undef PG8_SCHED
}
}
#ifndef PG8_SP2
#define PG8_SP2 true
#endif
#ifndef PG8_ALIGN
#define PG8_ALIGN true
#endif

constexpr int NWAVES = 8;
#ifndef MK_N_LAUNCHES
#define MK_N_LAUNCHES 1
#endif
constexpr int N_PHASES = 7;
constexpr int N_LAUNCHES = MK_N_LAUNCHES;

constexpr int D = 4096, MP = 16384, MS = 2048, M = MP + MS;
constexpr int TP = 4096, TS = 64, PAST = 2048, TKS = PAST + TS;
constexpr int NIN = 8192, DFF = 16384, LW = 2048;
constexpr float EPS = 1e-6f;
constexpr float QSCALE = 0.08838834764831845f * 1.4426950408889634f;
constexpr float LAM_INIT = 0.2f;
constexpr size_t O_Y = 0, O_KP = 75497472, O_VP = 92274688, O_CP = 109051904, O_LP = 109076480, O_KS = 109084672, O_VS = 111181824, O_CS = 113278976, O_LS = 113475584, O_END = 113541120;

constexpr size_t MiB = 1u << 20;
constexpr size_t WS_CTL = 0, CTL_ZERO_BYTES = 1 * MiB;
constexpr size_t WS_TAB = 1 * MiB;
constexpr size_t WS_GWT = 2 * MiB;
constexpr size_t WS_WIN = 4 * MiB, WS_WOUT = 68 * MiB, WS_WUP = 100 * MiB, WS_WDN = 228 * MiB;
constexpr size_t WS_HN = 356 * MiB;
constexpr size_t WS_Z = 500 * MiB;
constexpr size_t WS_XN = 500 * MiB;
constexpr size_t WS_QB = 644 * MiB;
constexpr size_t WS_KP = 716 * MiB;
constexpr size_t WS_KS = 748 * MiB;
constexpr size_t WS_VTP = 880 * MiB;
constexpr size_t WS_VTS = 912 * MiB;
constexpr size_t WS_XR = 1044 * MiB;
constexpr size_t WS_GG = 1116 * MiB;
constexpr size_t WS_SP = 1080 * MiB;
constexpr size_t WS_END = 1188 * MiB;
constexpr int CW_TMO = 0, CW_CODE = 1, CW_QCTR = 64  , CW_BAR = 4096, CW_P6 = 8192  , CW_RSS1 = 16384  ;

constexpr int RING_BYTES = 131072, LDSCTL_OFF = RING_BYTES, MISC_OFF = LDSCTL_OFF + 320, LDSCTL_BYTES = 1024, QX_OFF = LDSCTL_OFF + LDSCTL_BYTES  , SUBG_OFF = QX_OFF + 16384  , LDS_BYTES = 151552;

#ifndef XHALF_PERMLANE
#define XHALF_PERMLANE 1
#endif
#define GAS __attribute__((address_space(1)))
#define LAS __attribute__((address_space(3)))
typedef unsigned short bf16;
typedef unsigned v4u __attribute__((ext_vector_type(4)));
typedef unsigned v2u __attribute__((ext_vector_type(2)));
typedef float f32x4 __attribute__((ext_vector_type(4)));
typedef float f32x16 __attribute__((ext_vector_type(16)));
typedef short bf16x8 __attribute__((ext_vector_type(8)));
typedef GAS unsigned gu32;
#define RLX_AGENT __ATOMIC_RELAXED, __HIP_MEMORY_SCOPE_AGENT
#define LDS_WAIT() asm volatile("s_waitcnt lgkmcnt(0)" ::: "memory")
#define VM_WAIT() asm volatile("s_waitcnt vmcnt(0)" ::: "memory")
#define RAW_BAR() __builtin_amdgcn_s_barrier()
__device__ __forceinline__ unsigned f2bf(float f) { unsigned u = __builtin_bit_cast(unsigned, f); return (u + 0x7fffu + ((u >> 16) & 1u)) >> 16; }
__device__ __forceinline__ unsigned pk2(float lo, float hi) { return f2bf(lo) | (f2bf(hi) << 16); }
typedef __bf16 hwbf16x2 __attribute__((ext_vector_type(2)));
typedef float f32x2v __attribute__((ext_vector_type(2)));
__device__ __forceinline__ unsigned cvt2bf(float lo, float hi) { const f32x2v v = {lo, hi}; return __builtin_bit_cast(unsigned, __builtin_convertvector(v, hwbf16x2)); }
__device__ __forceinline__ float xhalf_max(float v) {
#if XHALF_PERMLANE
    const unsigned u = __builtin_bit_cast(unsigned, v); const auto r = __builtin_amdgcn_permlane32_swap(u, u, false, false);
    return fmaxf(__builtin_bit_cast(float, r[0]), __builtin_bit_cast(float, r[1]));
#else
    return fmaxf(v, __shfl_xor(v, 32));
#endif
}
__device__ __forceinline__ float bf2f(unsigned short b) { return __builtin_bit_cast(float, (unsigned)b << 16); }
__device__ __forceinline__ float wave_sum(float v) {
#pragma unroll
    for (int o = 1; o < 64; o <<= 1) v += __shfl_xor(v, o);
    return v;
}

#define XB_TMO      128
#define XB_XCNT(j)  (256  + 64 * (j))
#define XB_XSUB(j)  (1280 + 64 * (j))
#define XB_XGEN(j)  (2304 + 64 * (j))
#define XB_TOP      3328
#define XB_TOPGEN   3392
#define XCD_BAR_WORDS 3456
#define XB_SPIN_CAP (1u << 18)

__device__ __forceinline__ unsigned xb_ld(unsigned* p)              { return __hip_atomic_load(p, __ATOMIC_RELAXED, __HIP_MEMORY_SCOPE_AGENT); }
__device__ __forceinline__ unsigned xb_add(unsigned* p, unsigned v) { return __hip_atomic_fetch_add(p, v, __ATOMIC_RELAXED, __HIP_MEMORY_SCOPE_AGENT); }
__device__ __forceinline__ unsigned xb_xcc_id() { return (unsigned)__builtin_amdgcn_s_getreg((3 << 11) | 20) & 0xFu; }
#define XB_SPIN(cond, bar) do { unsigned _sp = 0; while (cond) { __builtin_amdgcn_s_sleep(1); \
    if ((++_sp & 255u) == 0u) { if (xb_ld(&(bar)[XB_TMO])) break; if (_sp > XB_SPIN_CAP) { atomicAdd(&(bar)[XB_TMO], 1u); break; } } } } while (0)

struct XcdBarrier {
    unsigned* bar; unsigned x;
    volatile LAS unsigned* st;
};

__device__ __forceinline__ XcdBarrier xcd_barrier_post(unsigned* bar, volatile LAS unsigned* st) {
    XcdBarrier b; b.bar = bar; b.x = xb_xcc_id(); b.st = st;
    if (threadIdx.x == 0) (void)xb_add(&bar[XB_XCNT(b.x)], 1u);
    return b;
}
__device__ __forceinline__ void xcd_barrier_complete(unsigned* bar, unsigned x, unsigned& nloc, unsigned& nx) {
    const unsigned G = gridDim.x * gridDim.y * gridDim.z;
    unsigned sum, cnt, mine, sp = 0u;
    for (;;) {
        sum = 0u; cnt = 0u; mine = 0u;
#pragma unroll
        for (unsigned j = 0; j < 16; ++j) { const unsigned c = xb_ld(&bar[XB_XCNT(j)]); sum += c; cnt += (c > 0u) ? 1u : 0u; mine = (j == x) ? c : mine; }
        if (sum == G) break;
        __builtin_amdgcn_s_sleep(1);
        if ((++sp & 255u) == 0u) { if (xb_ld(&bar[XB_TMO])) break; if (sp > XB_SPIN_CAP) { atomicAdd(&bar[XB_TMO], 1u); break; } }
    }
    nloc = mine > 0u ? mine : 1u; nx = cnt > 0u ? cnt : 1u;
}

__device__ __forceinline__ void xcd_barrier(const XcdBarrier& b) {
    asm volatile("s_waitcnt vmcnt(0)" ::: "memory");
    __syncthreads();
    if (threadIdx.x == 0) {
        unsigned* bar = b.bar;
        __builtin_amdgcn_s_waitcnt(0);
        unsigned nloc = b.st[0], nx = b.st[1];
        if (nloc == 0u) { xcd_barrier_complete(bar, b.x, nloc, nx); b.st[0] = nloc; b.st[1] = nx; }
        const unsigned old = xb_add(&bar[XB_XSUB(b.x)], 1u);
        const unsigned gen = old / nloc;
        if (old + 1u == (gen + 1u) * nloc) {
            __builtin_amdgcn_fence(__ATOMIC_RELEASE, "agent");
            asm volatile("s_waitcnt vmcnt(0)" ::: "memory");
            const unsigned og = xb_add(&bar[XB_TOP], 1u);
            const unsigned tg = og / nx;
            if (og + 1u == (tg + 1u) * nx) xb_add(&bar[XB_TOPGEN], 1u);
            else XB_SPIN(xb_ld(&bar[XB_TOPGEN]) == tg, bar);
            __builtin_amdgcn_fence(__ATOMIC_ACQUIRE, "agent");
            xb_add(&bar[XB_XGEN(b.x)], 1u);
            asm volatile("s_waitcnt vmcnt(0)" ::: "memory");
        } else {
            XB_SPIN(xb_ld(&bar[XB_XGEN(b.x)]) == gen, bar);
            __builtin_amdgcn_fence(__ATOMIC_ACQUIRE, "agent");
            asm volatile("s_waitcnt vmcnt(0)" ::: "memory");
        }
    }
    __syncthreads();
}

struct Args { const float* in[25]; float* out; unsigned char* ws; int ph_lo, ph_hi, qslot, variant; };

namespace pg8 {
struct EpiProj {
    static constexpr bool PERM = true, AFTER_DRAIN = false;
    bf16_t *QB, *KP, *KS, *VTP, *VTS, *XR, *GG; float* out; const float* tab;
    __device__ __forceinline__ void operator()(const f32x4 (&acc)[2][2][4][2], const Unit& u, int wr, int wc, int fr, int fq) const {
        const int pn = u.pn; const bool prompt = u.pm < 64;
        const int rbase = u.pm * BM + wr * 64 + fr, cbase = wc * 32 + 8 * fq;
#pragma unroll
        for (int ai = 0; ai < 2; ++ai)
#pragma unroll
            for (int m = 0; m < 4; ++m) {
                const int r = rbase + ai * HALF + m * 16;
                f32x4 v[2][2];
#pragma unroll
                for (int bj = 0; bj < 2; ++bj)
#pragma unroll
                    for (int n = 0; n < 2; ++n) v[bj][n] = acc[ai][bj][m][n];
                if (pn < 12) {
                    if (wc == 0) {
                        const int pos = prompt ? (r & 4095) : (PAST + (r & 63));
                        const float* tc = tab + pos * 16 + 8 * (fq & 1);
#pragma unroll
                        for (int n = 0; n < 2; ++n) {
                            const f32x4 cs = *(const f32x4*)(tc + 4 * n), sn = *(const f32x4*)(tc + 65536 + 4 * n);
#pragma unroll
                            for (int bj = 0; bj < 2; ++bj) {
                                const f32x4 x = v[bj][n]; f32x4 p;
#pragma unroll
                                for (int i = 0; i < 4; ++i) p[i] = __shfl_xor(x[i], 32);
                                v[bj][n] = (fq < 2) ? (x * cs - p * sn) : (x * cs + p * sn);
                            }
                        }
                    }
                    if (pn < 8) {
                        bf16_t* dst = QB + (size_t)r * 2048 + pn * 256 + cbase;
#pragma unroll
                        for (int bj = 0; bj < 2; ++bj) { const f32x4 a = v[bj][0] * QSCALE, b = v[bj][1] * QSCALE; u32x4 w; w.x = cvt_pk_bf16(a[0], a[1]); w.y = cvt_pk_bf16(a[2], a[3]); w.z = cvt_pk_bf16(b[0], b[1]); w.w = cvt_pk_bf16(b[2], b[3]);
                            *(u32x4*)(dst + bj * HALF) = w; }
                    } else {
                        const int kvh = pn - 8;
                        float* fo = out + (prompt ? (O_KP + (size_t)r * 1024) : (O_KS + (size_t)(r - MP) * 1024)) + kvh * 256 + cbase;
                        bf16_t* dst = (prompt ? (KP + (size_t)r * 1024) : (KS + ((size_t)((r - MP) >> 6) * TKS + PAST + (r & 63)) * 1024)) + kvh * 256 + cbase;
#pragma unroll
                        for (int bj = 0; bj < 2; ++bj) { const f32x4 a = v[bj][0], b = v[bj][1]; *(f32x4*)(fo + bj * HALF) = a; *(f32x4*)(fo + bj * HALF + 4) = b;
                            u32x4 w; w.x = cvt_pk_bf16(a[0], a[1]); w.y = cvt_pk_bf16(a[2], a[3]); w.z = cvt_pk_bf16(b[0], b[1]); w.w = cvt_pk_bf16(b[2], b[3]); *(u32x4*)(dst + bj * HALF) = w; }
                    }
                } else if (pn < 16) {
                    const int kvh = pn - 12;
                    float* fo = out + (prompt ? (O_VP + (size_t)r * 1024) : (O_VS + (size_t)(r - MP) * 1024)) + kvh * 256 + cbase;
                    bf16_t* vt; size_t ldv;
                    if (prompt) { vt = VTP + ((size_t)((r >> 12) * 4 + kvh) * 256) * TP + (r & 4095); ldv = TP; }
                    else { vt = VTS + ((size_t)(((r - MP) >> 6) * 4 + kvh) * 256) * TKS + PAST + (r & 63); ldv = TKS; }
#pragma unroll
                    for (int bj = 0; bj < 2; ++bj) { const f32x4 a = v[bj][0], b = v[bj][1]; *(f32x4*)(fo + bj * HALF) = a; *(f32x4*)(fo + bj * HALF + 4) = b;
                        bf16_t* vp = vt + (size_t)(bj * HALF + cbase) * ldv;
#pragma unroll
                        for (int i = 0; i < 4; ++i) { vp[(size_t)i * ldv] = (bf16_t)f2bf(a[i]); vp[(size_t)(4 + i) * ldv] = (bf16_t)f2bf(b[i]); } }
                } else if (pn < 24) {
                    bf16_t* dst = XR + (size_t)r * 2048 + (pn - 16) * 256 + cbase;
#pragma unroll
                    for (int bj = 0; bj < 2; ++bj) { const f32x4 a = v[bj][0], b = v[bj][1]; u32x4 w; w.x = cvt_pk_bf16(a[0], a[1]); w.y = cvt_pk_bf16(a[2], a[3]); w.z = cvt_pk_bf16(b[0], b[1]); w.w = cvt_pk_bf16(b[2], b[3]);
                        *(u32x4*)(dst + bj * HALF) = w; }
                } else {
                    bf16_t* dst = GG + (size_t)r * 2048 + (pn - 24) * 256 + cbase;
#pragma unroll
                    for (int bj = 0; bj < 2; ++bj) { f32x4 a = v[bj][0], b = v[bj][1];
#pragma unroll
                        for (int i = 0; i < 4; ++i) { { const float x = a[i], y = 1.5957691216f * (x + 0.044715f * x * x * x); a[i] = x / (1.0f + __expf(-y)); }
                                                      { const float x = b[i], y = 1.5957691216f * (x + 0.044715f * x * x * x); b[i] = x / (1.0f + __expf(-y)); } }
                        u32x4 w; w.x = cvt_pk_bf16(a[0], a[1]); w.y = cvt_pk_bf16(a[2], a[3]); w.z = cvt_pk_bf16(b[0], b[1]); w.w = cvt_pk_bf16(b[2], b[3]); *(u32x4*)(dst + bj * HALF) = w; }
                }
            }
    }
};
struct EpiRes1 {
    static constexpr bool PERM = true, AFTER_DRAIN = false;
    const float *xp, *xs; bf16_t* HN; float* rss;
    __device__ __forceinline__ void operator()(const f32x4 (&acc)[2][2][4][2], const Unit& u, int wr, int wc, int fr, int fq) const {
        const int rbase = u.pm * BM + wr * 64 + fr, col0 = u.pn * BM + wc * 32 + 8 * fq; const bool prompt = u.pm < 64;
#pragma unroll
        for (int ai = 0; ai < 2; ++ai)
#pragma unroll
            for (int m = 0; m < 4; ++m) {
                const int r = rbase + ai * HALF + m * 16;
                const float* xr = (prompt ? xp + (size_t)r * D : xs + (size_t)(r - MP) * D) + col0;
                bf16_t* hb = HN + (size_t)r * D + col0; float ss = 0.f;
#pragma unroll
                for (int bj = 0; bj < 2; ++bj) { const f32x4 a = acc[ai][bj][m][0] + *(const f32x4*)(xr + bj * HALF), b = acc[ai][bj][m][1] + *(const f32x4*)(xr + bj * HALF + 4);
                    ss += (a[0] * a[0] + a[1] * a[1]) + (a[2] * a[2] + a[3] * a[3]) + (b[0] * b[0] + b[1] * b[1]) + (b[2] * b[2] + b[3] * b[3]);
                    u32x4 w; w.x = cvt_pk_bf16(a[0], a[1]); w.y = cvt_pk_bf16(a[2], a[3]); w.z = cvt_pk_bf16(b[0], b[1]); w.w = cvt_pk_bf16(b[2], b[3]); *(u32x4*)(hb + bj * HALF) = w; }
                ss += __shfl_xor(ss, 16); ss += __shfl_xor(ss, 32);
                if (fq == 0) atomicAdd(rss + r, ss);
            }
    }
};
struct EpiUp {
    static constexpr bool PERM = true, AFTER_DRAIN = false;
    bf16_t* Z;
    __device__ __forceinline__ void operator()(const f32x4 (&acc)[2][2][4][2], const Unit& u, int wr, int wc, int fr, int fq) const {
        const int rbase = u.pm * BM + wr * 64 + fr, col0 = u.pn * BM + wc * 32 + 8 * fq;
#pragma unroll
        for (int ai = 0; ai < 2; ++ai)
#pragma unroll
            for (int m = 0; m < 4; ++m) {
                bf16_t* dst = Z + (size_t)(rbase + ai * HALF + m * 16) * DFF + col0;
#pragma unroll
                for (int bj = 0; bj < 2; ++bj) { f32x4 a = acc[ai][bj][m][0], b = acc[ai][bj][m][1];
#pragma unroll
                    for (int i = 0; i < 4; ++i) { const float x = fmaxf(a[i], 0.f), y = fmaxf(b[i], 0.f); a[i] = x * x; b[i] = y * y; }
                    u32x4 w; w.x = cvt_pk_bf16(a[0], a[1]); w.y = cvt_pk_bf16(a[2], a[3]); w.z = cvt_pk_bf16(b[0], b[1]); w.w = cvt_pk_bf16(b[2], b[3]); *(u32x4*)(dst + bj * HALF) = w; }
            }
    }
};
struct EpiDown {
    static constexpr bool PERM = true, AFTER_DRAIN = false;
    bf16_t* h; const float* rss;
    __device__ __forceinline__ void operator()(const f32x4 (&acc)[2][2][4][2], const Unit& u, int wr, int wc, int fr, int fq) const {
        const int rbase = u.pm * BM + wr * 64 + fr, col0 = u.pn * BM + wc * 32 + 8 * fq;
#pragma unroll
        for (int ai = 0; ai < 2; ++ai)
#pragma unroll
            for (int m = 0; m < 4; ++m) {
                const int r = rbase + ai * HALF + m * 16;
                bf16_t* ho = h + (size_t)r * D + col0; const float sc = 1.0f / (rss[r] * (1.0f / D) + EPS);
#pragma unroll
                for (int bj = 0; bj < 2; ++bj) { const u32x4 hv = *(const u32x4*)(ho + bj * HALF);
                    f32x4 a = acc[ai][bj][m][0] * sc, b = acc[ai][bj][m][1] * sc;
                    a[0] += __builtin_bit_cast(float, hv.x << 16); a[1] += __builtin_bit_cast(float, hv.x & 0xffff0000u); a[2] += __builtin_bit_cast(float, hv.y << 16); a[3] += __builtin_bit_cast(float, hv.y & 0xffff0000u);
                    b[0] += __builtin_bit_cast(float, hv.z << 16); b[1] += __builtin_bit_cast(float, hv.z & 0xffff0000u); b[2] += __builtin_bit_cast(float, hv.w << 16); b[3] += __builtin_bit_cast(float, hv.w & 0xffff0000u);
                    u32x4 w; w.x = cvt_pk_bf16(a[0], a[1]); w.y = cvt_pk_bf16(a[2], a[3]); w.z = cvt_pk_bf16(b[0], b[1]); w.w = cvt_pk_bf16(b[2], b[3]); *(u32x4*)(ho + bj * HALF) = w; }
            }
    }
};
struct EpiPart {
    static constexpr bool PERM = true, AFTER_DRAIN = false;
    float* S; const float* rss;
    __device__ __forceinline__ void operator()(const f32x4 (&acc)[2][2][4][2], const Unit& u, int wr, int wc, int fr, int fq) const {
        const int rbase = u.pm * BM + wr * 64 + fr, col0 = u.pn * BM + wc * 32 + 8 * fq;
#pragma unroll
        for (int ai = 0; ai < 2; ++ai)
#pragma unroll
            for (int m = 0; m < 4; ++m) {
                const int r = rbase + ai * HALF + m * 16;
                float* so = S + (size_t)r * D + col0; const float sc = 1.0f / (rss[r] * (1.0f / D) + EPS);
#pragma unroll
                for (int bj = 0; bj < 2; ++bj) { *(f32x4*)(so + bj * HALF) = acc[ai][bj][m][0] * sc; *(f32x4*)(so + bj * HALF + 4) = acc[ai][bj][m][1] * sc; }
            }
    }
};
struct OneUnit {
    Unit u; bool valid;
    __device__ __forceinline__ bool next(int i, Unit& o) const { if (i > 0 || !valid) return false; o = u; return true; }
    __device__ __forceinline__ void a_ready(const Unit&) const {}
    __device__ __forceinline__ void done(const Unit&) const {}
};
}

__device__ __forceinline__ void tr_item(const float* W, int ldw, bf16* WT, size_t ldt, LAS float* scr, int k0, int n0, int lane, const float* kscale) {
#pragma unroll
    for (int i = 0; i < 8; ++i) { const int kk = 8 * i + (lane >> 3), c4 = 4 * (lane & 7); f32x4 v = *(const GAS f32x4*)(W + (size_t)(k0 + kk) * ldw + n0 + c4); if (kscale) v = v * kscale[k0 + kk];
        LAS float* d = scr + kk * 33 + c4; d[0] = v[0]; d[1] = v[1]; d[2] = v[2]; d[3] = v[3]; }
    LDS_WAIT(); asm volatile("" ::: "memory");
    const int c = lane & 7;
#pragma unroll
    for (int j = 0; j < 4; ++j) { const int n = (lane >> 3) + 8 * j; const LAS float* s = scr + (8 * c) * 33 + n;
        v4u o; o.x = pk2(s[0 * 33], s[1 * 33]); o.y = pk2(s[2 * 33], s[3 * 33]); o.z = pk2(s[4 * 33], s[5 * 33]); o.w = pk2(s[6 * 33], s[7 * 33]);
        *(GAS v4u*)(WT + (size_t)(n0 + n) * ldt + k0 + 8 * c) = o; }
    LDS_WAIT(); asm volatile("" ::: "memory");
}
__device__ __forceinline__ void tr_matrix_item(const float* W, int K, int N, int ldw, bf16* WT, size_t ldt, LAS float* scr, int item, int lane, const float* kscale) {
    const int nblk = N / 32, kb = item / nblk, nb = item % nblk; (void)K;
    tr_item(W, ldw, WT, ldt, scr, 64 * kb, 32 * nb, lane, kscale);
}
__device__ __forceinline__ void rope_entry(int idx, float* tab) {
    const float invt[16] = {1.0f, 0.44036659598350525f, 0.1939227432012558f, 0.08539710193872452f, 0.03760603070259094f, 0.016560440883040428f, 0.007292664609849453f, 0.0032114461064338684f,
                            0.0014142135623842478f, 0.0006227724370546639f, 0.00027424818836152554f, 0.00012076973507646471f, 5.3182957344688475e-05f, 2.34199997066753e-05f, 1.0313385246263351e-05f, 4.541670477919979e-06f};
    const int pos = idx >> 4, j = idx & 15;
    float inv = invt[0];
#pragma unroll
    for (int k = 1; k < 16; ++k) inv = (j == k) ? invt[k] : inv;
    const float angf = (float)pos * inv;
    const double x = (double)angf, q = __builtin_rint(x * 0.63661977236758134308), r = __builtin_fma(-q, 1.57079632679489661923, x) - q * 6.123233995736766e-17, r2 = r * r;
    double s = r2 * (1.0 / 6227020800.0) - 1.0 / 39916800.0; s = s * r2 + 1.0 / 362880.0; s = s * r2 - 1.0 / 5040.0; s = s * r2 + 1.0 / 120.0; s = s * r2 - 1.0 / 6.0; s = s * r2 * r + r;
    double c = r2 * (1.0 / 87178291200.0) - 1.0 / 479001600.0; c = c * r2 + 1.0 / 3628800.0; c = c * r2 - 1.0 / 40320.0; c = c * r2 + 1.0 / 720.0; c = c * r2 - 1.0 / 24.0; c = c * r2 + 0.5; c = 1.0 - c * r2;
    const int qi = ((int)q) & 3;
    const double sn = (qi == 0) ? s : (qi == 1) ? c : (qi == 2) ? -s : -c, cs = (qi == 0) ? c : (qi == 1) ? -s : (qi == 2) ? -c : s;
    tab[idx] = (float)cs; tab[65536 + idx] = (float)sn;
}

namespace att {
#ifndef ATT_QKD
#define ATT_QKD 2
#endif
#ifndef ATT_PVD
#define ATT_PVD 4
#endif
#ifndef ATT_SCHED_BETA
#define ATT_SCHED_BETA
#endif
constexpr int KT_BYTES = 32768, STAGE = 65536;
struct Unit { const bf16* Kb; const bf16* Vt; int ldv, ntiles, qrow0, kvh; };
__device__ __forceinline__ void attn_unit(LAS unsigned char* lds, const Unit& U, const bf16* QB, bf16* CAT, const float* subg, float lam) {
    int tid = threadIdx.x; asm volatile("" : "+v"(tid));
    const int lane = tid & 63, wid = __builtin_amdgcn_readfirstlane(tid >> 6);
    const int g = wid >> 2, c = (wid >> 1) & 1, qs = wid & 1, ql = lane & 31, h = lane >> 5;
    const int qrow = U.qrow0 + qs * 32 + ql;
    bf16x8 qf[6];
    LAS bf16x8* qx = (LAS bf16x8*)(lds + QX_OFF) + tid;
    { const bf16* qp = QB + (size_t)qrow * 2048 + (U.kvh * 2 + g) * 256 + c * 128 + 8 * h;
#pragma unroll
      for (int ks = 0; ks < 6; ++ks) qf[ks] = *(const GAS bf16x8*)(qp + 16 * ks);
      qx[0] = *(const GAS bf16x8*)(qp + 96); qx[512] = *(const GAS bf16x8*)(qp + 112); }
    const int kr = tid >> 5, kcc = (tid & 31) ^ (kr & 15);
    const unsigned koff = (unsigned)(kr * 1024 + kcc * 8) * 2u;
    const int ve = tid >> 3, vcc = (tid & 7) ^ ((ve >> 1) & 7);
    const unsigned voff = (unsigned)(ve * U.ldv + vcc * 8) * 2u;
    const char* kb0 = (const char*)U.Kb; const char* vb0 = (const char*)U.Vt;
    const size_t vstep = (size_t)128 * U.ldv;
#ifndef ATT_DMA_REP
#define ATT_DMA_REP 1
#endif
#define ATT_ISSUE_K(t, st) do { const char* kp_ = kb0 + (size_t)(t) * 131072; \
        _Pragma("unroll") for (int j2_ = 0; j2_ < 4 * ATT_DMA_REP; ++j2_) { const int j_ = j2_ & 3; __builtin_amdgcn_global_load_lds((const unsigned*)(kp_ + (size_t)j_ * 32768 + koff), (LAS unsigned*)(lds + (st) * STAGE + wid * 1024 + j_ * 8192), 16, 0, 0); } } while (0)
#define ATT_ISSUE_V(t, st) do { const char* vp_ = vb0 + (size_t)(t) * 128; \
        _Pragma("unroll") for (int j2_ = 0; j2_ < 4 * ATT_DMA_REP; ++j2_) { const int j_ = j2_ & 3; __builtin_amdgcn_global_load_lds((const unsigned*)(vp_ + j_ * vstep + voff), (LAS unsigned*)(lds + (st) * STAGE + KT_BYTES + wid * 1024 + j_ * 8192), 16, 0, 0); } } while (0)
    const int kap = (ql & 0x13) | ((ql & 4) << 1) | ((ql & 8) >> 1);
    const unsigned kaddr0 = (unsigned)(kap * 512 + c * 256 + 16 * ((kap & 15) ^ h));
    const unsigned vaddr0 = (unsigned)(KT_BYTES + ql * 128 + 16 * (((ql >> 1) & 7) ^ h));
    f32x16 O[8];
#pragma unroll
    for (int e = 0; e < 8; ++e)
#pragma unroll
        for (int i = 0; i < 16; ++i) O[e][i] = 0.f;
    float mrun = 0.f, lrun = 0.f;
    ATT_ISSUE_K(0, 0); ATT_ISSUE_V(0, 0);
    VM_WAIT(); RAW_BAR();
    if (g == 1) RAW_BAR();
    const int nt = U.ntiles;
    for (int t = 0; t < nt; ++t) {
        const int st = t & 1, tn = (t + 1 < nt) ? t + 1 : t;
        const unsigned ka = kaddr0 + (unsigned)st * STAGE, va = vaddr0 + (unsigned)st * STAGE;
        const unsigned ka5 = ka >> 5, kal = ka & 31u, va5 = va >> 5, val = va & 31u;
#define ATT_KF(beta, ks) (*(const LAS bf16x8*)(lds + ((((ka5 ^ (unsigned)(ks)) << 5) | kal) + 16384u * (beta))))
#define ATT_VF(e, s) (*(const LAS bf16x8*)(lds + ((((va5 ^ (unsigned)(s)) << 5) | val) + 4096u * (e))))
#pragma unroll
        for (int beta = 0; beta < 2; ++beta) {
            if (g == 1) __builtin_amdgcn_s_setprio(1);
            f32x16 S;
#pragma unroll
            for (int i = 0; i < 16; ++i) S[i] = -mrun;
            { bf16x8 kf[8];
#pragma unroll
              for (int ks = 0; ks < 8; ++ks) kf[ks] = ATT_KF(beta, ks);
#pragma unroll
              for (int ks = 0; ks < 8; ++ks) S = __builtin_amdgcn_mfma_f32_32x32x16_bf16(kf[ks], (ks < 6) ? qf[ks < 6 ? ks : 0] : qx[(ks - 6) * 512], S, 0, 0, 0);
              __builtin_amdgcn_sched_group_barrier(0x100, ATT_QKD + 2, 0);
#pragma unroll
              for (int ks = 0; ks < 8 - ATT_QKD; ++ks) { __builtin_amdgcn_sched_group_barrier(0x8, 1, 0); __builtin_amdgcn_sched_group_barrier(0x100, 1, 0); }
              __builtin_amdgcn_sched_group_barrier(0x8, ATT_QKD, 0); }
            float mx = fmaxf(fmaxf(S[0], S[1]), S[2]);
#pragma unroll
            for (int i = 3; i < 15; i += 2) mx = fmaxf(fmaxf(mx, S[i]), S[i + 1]);
            mx = fmaxf(mx, S[15]);
            mx = xhalf_max(mx);
            const bool first = (t == 0) && (beta == 0);
            if (first || __any(mx > 8.0f)) {
                const float d = first ? mx : fmaxf(mx, 0.f);
                if (!first) { const float al = __builtin_amdgcn_exp2f(-d); lrun *= al;
#pragma unroll
                    for (int e = 0; e < 8; ++e) O[e] = O[e] * al; }
                mrun += d;
#pragma unroll
                for (int i = 0; i < 16; ++i) S[i] -= d;
            }
            float ps = 0.f; bf16x8 pb[2];
#pragma unroll
            for (int j = 0; j < 2; ++j) { v4u w;
#pragma unroll
                for (int k = 0; k < 4; ++k) { const float p0 = __builtin_amdgcn_exp2f(S[8 * j + 2 * k]), p1 = __builtin_amdgcn_exp2f(S[8 * j + 2 * k + 1]); ps += p0 + p1; w[k] = cvt2bf(p0, p1); }
                pb[j] = __builtin_bit_cast(bf16x8, w); }
            lrun += ps;
            if (beta == 0) ATT_ISSUE_K(tn, st ^ 1);
            if (g == 1) __builtin_amdgcn_s_setprio(0);
            if (beta == 1) { if (ATT_DMA_REP == 1) asm volatile("s_waitcnt vmcnt(4)" ::: "memory"); else asm volatile("s_waitcnt vmcnt(8)" ::: "memory"); }
            LDS_WAIT(); RAW_BAR();
            { bf16x8 vf[8][2];
#pragma unroll
              for (int e = 0; e < 8; ++e)
#pragma unroll
                  for (int j = 0; j < 2; ++j) vf[e][j] = ATT_VF(e, 2 * beta + j);
#pragma unroll
              for (int e = 0; e < 8; ++e)
#pragma unroll
                  for (int j = 0; j < 2; ++j) O[e] = __builtin_amdgcn_mfma_f32_32x32x16_bf16(vf[e][j], pb[j], O[e], 0, 0, 0);
              __builtin_amdgcn_sched_group_barrier(0x100, ATT_PVD, 0);
#pragma unroll
              for (int e = 0; e < 16 - ATT_PVD; ++e) { __builtin_amdgcn_sched_group_barrier(0x8, 1, 0); __builtin_amdgcn_sched_group_barrier(0x100, 1, 0); }
              __builtin_amdgcn_sched_group_barrier(0x8, ATT_PVD, 0); }
            if (beta == 0) ATT_ISSUE_V(tn, st ^ 1);
            if (beta == 1) VM_WAIT();
            LDS_WAIT(); RAW_BAR();
        }
    }
    if (g == 0) RAW_BAR();
#undef ATT_KF
#undef ATT_VF
#undef ATT_ISSUE_K
#undef ATT_ISSUE_V
    lrun += __shfl_xor(lrun, 32);
    const float inv = 1.0f / lrun;
    LAS float* X = (LAS float*)(lds + (g * 2 + qs) * 32768);
    if (c == 1) {
#pragma unroll
        for (int e = 0; e < 8; ++e)
#pragma unroll
            for (int i = 0; i < 16; ++i) X[(e * 16 + i) * 64 + lane] = O[e][i] * inv;
    }
    LDS_WAIT(); RAW_BAR();
    if (c == 0) {
        float ss = 0.f;
#pragma unroll
        for (int e = 0; e < 8; ++e) {
#pragma unroll
            for (int i = 0; i < 16; ++i) { const float o = O[e][i] * inv - lam * X[(e * 16 + i) * 64 + lane]; O[e][i] = o; ss += o * o; }
            asm volatile("" : "+v"(ss) :: "memory"); }
        ss += __shfl_xor(ss, 32);
        const float rs = 1.0f / sqrtf(ss * (1.0f / 256.0f) + EPS);
        bf16* orow = CAT + (size_t)qrow * D + (U.kvh * 2 + g) * 256 + 4 * h;
#pragma unroll
        for (int e = 0; e < 8; ++e) {
#pragma unroll
            for (int i4 = 0; i4 < 4; ++i4) { const int e0 = 32 * e + 8 * i4; const f32x4 gv = *(const LAS f32x4*)(lds + SUBG_OFF + (e0 + 4 * h) * 4);
                v2u w; w.x = pk2(O[e][4 * i4] * rs * gv[0], O[e][4 * i4 + 1] * rs * gv[1]); w.y = pk2(O[e][4 * i4 + 2] * rs * gv[2], O[e][4 * i4 + 3] * rs * gv[3]);
                *(GAS v2u*)(orow + e0) = w; }
            asm volatile("" ::: "memory"); }
    }
    LDS_WAIT(); RAW_BAR();
}
}

namespace lru {
constexpr int XCB_PITCH = 272;
__device__ __forceinline__ float sigm(float x) { return __builtin_amdgcn_rcpf(1.0f + __expf(-x)); }
__device__ __forceinline__ float em1_small(float x) { float p = 1.0f / 5040.0f; p = p * x + 1.0f / 720.0f; p = p * x + 1.0f / 120.0f; p = p * x + 1.0f / 24.0f; p = p * x + 1.0f / 6.0f; p = p * x + 0.5f; p = p * x + 1.0f; return p * x; }
struct Job { int row0, n, nchunks; const float* cprev; const float* h0; float* conv_out; float* h_out; };
__device__ __forceinline__ void lru_chain(LAS unsigned char* lds, const Job& J, const bf16* XR, const bf16* GG, bf16* CAT, const bf16* GWT, const float* conv_w, const float* conv_b,
                                          const float* ga_b, const float* gx_b, const float* lam) {
    const int tid = threadIdx.x, lane = tid & 63, wid = __builtin_amdgcn_readfirstlane(tid >> 6);
    const int nl = lane & 15, g4 = lane >> 4, ch = 16 * wid + nl, gch = J.n * 128 + ch;
    LAS unsigned char* XCB = lds;
    const float w0 = conv_w[gch], w1 = conv_w[2048 + gch], w2 = conv_w[4096 + gch], w3 = conv_w[6144 + gch], cb = conv_b[gch];
    const float sp = log1pf(__expf(-lam[gch])), L2E = 1.4426950408889634f;
    const float nba = -ga_b[gch] * L2E, nbx = -gx_b[gch] * L2E, spl = -8.0f * sp * L2E, sp2 = -16.0f * sp;
    bf16x8 bfr[2][4];
#pragma unroll
    for (int gt = 0; gt < 2; ++gt)
#pragma unroll
        for (int ks = 0; ks < 4; ++ks) bfr[gt][ks] = *(const GAS bf16x8*)(GWT + ((size_t)(J.n * 256 + gt * 128 + ch)) * 128 + 32 * ks + 8 * g4);
    float hin = J.h0 ? J.h0[gch] : 0.f;
    float x[19], ggv[16];
    { const bf16* xp = XR + (size_t)(J.row0 + 16 * g4 - 3) * 2048 + gch;
#pragma unroll
      for (int j = 0; j < 19; ++j) { if (j < 3) x[j] = (g4 == 0) ? (J.cprev ? J.cprev[j * 2048 + gch] : 0.f) : bf2f(xp[(size_t)j * 2048]); else x[j] = bf2f(xp[(size_t)j * 2048]); }
      const bf16* gp = GG + (size_t)(J.row0 + 16 * g4) * 2048 + gch;
#pragma unroll
      for (int i = 0; i < 16; ++i) ggv[i] = bf2f(gp[(size_t)i * 2048]); }
    for (int cs = 0; cs < J.nchunks; ++cs) {
        const int t0 = J.row0 + 64 * cs;
        float xc[16], gcur[16];
#pragma unroll
        for (int i = 0; i < 16; ++i) { float v = cb + x[i] * w0; v += x[i + 1] * w1; v += x[i + 2] * w2; v += x[i + 3] * w3; xc[i] = v; gcur[i] = ggv[i];
            *(LAS unsigned short*)(XCB + (16 * g4 + i) * XCB_PITCH + 2 * ch) = (unsigned short)pg8::cvt_pk_bf16(v, v); }
        if (cs == J.nchunks - 1 && g4 == 3) { J.conv_out[gch] = x[16]; J.conv_out[2048 + gch] = x[17]; J.conv_out[4096 + gch] = x[18]; }
        if (cs + 1 < J.nchunks) { const bf16* xp = XR + (size_t)(t0 + 64 + 16 * g4 - 3) * 2048 + gch;
#pragma unroll
            for (int j = 0; j < 19; ++j) x[j] = bf2f(xp[(size_t)j * 2048]);
            const bf16* gp = GG + (size_t)(t0 + 64 + 16 * g4) * 2048 + gch;
#pragma unroll
            for (int i = 0; i < 16; ++i) ggv[i] = bf2f(gp[(size_t)i * 2048]); }
        LDS_WAIT(); RAW_BAR();
        pg8::f32x4 acc[4][2];
        { const int trow = 16 * (nl >> 2) + (nl & 3);
#pragma unroll
          for (int rb = 0; rb < 4; ++rb) { acc[rb][0] = (pg8::f32x4){0.f, 0.f, 0.f, 0.f}; acc[rb][1] = (pg8::f32x4){0.f, 0.f, 0.f, 0.f};
#pragma unroll
              for (int ks = 0; ks < 4; ++ks) { const bf16x8 af = *(const LAS bf16x8*)(XCB + (trow + 4 * rb) * XCB_PITCH + (32 * ks + 8 * g4) * 2);
                  acc[rb][0] = __builtin_amdgcn_mfma_f32_16x16x32_bf16(af, bfr[0][ks], acc[rb][0], 0, 0, 0); acc[rb][1] = __builtin_amdgcn_mfma_f32_16x16x32_bf16(af, bfr[1][ks], acc[rb][1], 0, 0, 0); } } }
        LDS_WAIT(); RAW_BAR();
        float Hl[16], Pc[16]; float H = 0.f, P = 1.f;
#pragma unroll
        for (int rb = 0; rb < 4; ++rb)
#pragma unroll
            for (int i = 0; i < 4; ++i) { const int j = 4 * rb + i;
                const float r = __builtin_amdgcn_rcpf(1.0f + __builtin_amdgcn_exp2f(acc[rb][0][i] * -L2E + nba)), ig = __builtin_amdgcn_rcpf(1.0f + __builtin_amdgcn_exp2f(acc[rb][1][i] * -L2E + nbx)), la2 = r * sp2;
                const float a = __builtin_amdgcn_exp2f(r * spl), m2 = (la2 > -0.25f) ? -em1_small(la2) : 1.0f - a * a, u = __builtin_amdgcn_sqrtf(m2) * (ig * xc[j]);
                H = a * H + u; P *= a; Hl[j] = H; Pc[j] = P; }
        float Pt = 1.f, Ht = 0.f, Pp = 1.f, Hp = 0.f;
#pragma unroll
        for (int s = 0; s < 4; ++s) { const float ps = __shfl(P, nl + 16 * s), hs = __shfl(H, nl + 16 * s); if (s == g4) { Pp = Pt; Hp = Ht; } Ht = ps * Ht + hs; Pt *= ps; }
        { const float hs = Pp * hin + Hp;
          bf16* op = CAT + (size_t)(t0 + 16 * g4) * D + 2048 + gch;
#pragma unroll
          for (int j = 0; j < 16; ++j) { const float yv = (Hl[j] + Pc[j] * hs) * gcur[j]; op[(size_t)j * D] = (bf16)pg8::cvt_pk_bf16(yv, yv); } }
        hin = Pt * hin + Ht;
    }
    if (g4 == 0) J.h_out[gch] = hin;
}
}

__global__ void __launch_bounds__(NWAVES * 64, 2) mega_fwd(Args args) {
    extern __shared__ __attribute__((aligned(16))) unsigned char lds_raw[];
    LAS unsigned char* lds = (LAS unsigned char*)lds_raw;
    volatile LAS unsigned* MISC = (volatile LAS unsigned*)(lds + MISC_OFF);
    const int tid = threadIdx.x, lane = tid & 63, wave = __builtin_amdgcn_readfirstlane(tid >> 6);
    const int G = gridDim.x, bx = blockIdx.x;
    const int vcu = (G % 8 == 0) ? (bx % 8) * (G / 8) + bx / 8 : bx;
    unsigned char* ws = args.ws;
    gu32* ctl = (gu32*)(ws + WS_CTL);
    float* out = args.out;
    const float* x_prompt = args.in[0]; const float* x_sample = args.in[1]; const float* cache_k = args.in[2]; const float* cache_v = args.in[3];
    const float* state_conv = args.in[4]; const float* state_lru = args.in[5]; const float* norm_mix = args.in[6]; const float* w_in = args.in[7];
    const float* conv_w = args.in[8]; const float* conv_b = args.in[9]; const float* gate_a_w = args.in[10]; const float* gate_a_b = args.in[11];
    const float* gate_x_w = args.in[12]; const float* gate_x_b = args.in[13]; const float* lru_lambda = args.in[14];
    const float* lq1 = args.in[15]; const float* lk1 = args.in[16]; const float* lq2 = args.in[17]; const float* lk2 = args.in[18]; const float* subln_g = args.in[19];
    const float* w_out = args.in[20]; const float* norm_mlp = args.in[21]; const float* w_up = args.in[22]; const float* w_down = args.in[23]; const float* norm_final = args.in[24];
    bf16* WIN = (bf16*)(ws + WS_WIN); bf16* WOUT = (bf16*)(ws + WS_WOUT); bf16* WUP = (bf16*)(ws + WS_WUP); bf16* WDN = (bf16*)(ws + WS_WDN);
    bf16* HN = (bf16*)(ws + WS_HN); bf16* Z = (bf16*)(ws + WS_Z); bf16* XN = (bf16*)(ws + WS_XN); bf16* CAT = XN; bf16* QB = (bf16*)(ws + WS_QB);
    bf16* KP = (bf16*)(ws + WS_KP); bf16* KS = (bf16*)(ws + WS_KS); bf16* VTP = (bf16*)(ws + WS_VTP); bf16* VTS = (bf16*)(ws + WS_VTS);
    bf16* XR = (bf16*)(ws + WS_XR); bf16* GG = (bf16*)(ws + WS_GG); bf16* GWT = (bf16*)(ws + WS_GWT); float* TAB = (float*)(ws + WS_TAB);
    float* RSS1 = (float*)(ws + WS_CTL) + CW_RSS1;

    for (int u = tid; u < LDSCTL_BYTES / 4; u += NWAVES * 64) ((LAS unsigned*)(lds + LDSCTL_OFF))[u] = 0u;
    __syncthreads();
    XcdBarrier bar; bar.bar = (unsigned*)(ctl + CW_BAR); bar.x = 0; bar.st = nullptr;
    if (N_LAUNCHES == 1) bar = xcd_barrier_post((unsigned*)(ctl + CW_BAR), MISC + 8);
#define GRID_BAR() do { if (N_LAUNCHES == 1) xcd_barrier(bar); } while (0)
    const int lo = args.ph_lo, hi = args.ph_hi;
#ifndef PH_MASK
#define PH_MASK 0x7f
#endif
#define IN(k) (((PH_MASK >> (k)) & 1) && lo <= (k) && (k) < hi)
#define BOTH(k) (IN(k) && IN((k) + 1))

#ifndef P0_REPS
#define P0_REPS 1
#endif
#ifndef P2_REPS
#define P2_REPS 1
#endif
#ifndef P4_REPS
#define P4_REPS 1
#endif
    if (IN(0)) {
      for (int rep0 = 0; rep0 < P0_REPS; ++rep0) {
        LAS float* scr = (LAS float*)(lds + wave * 16384);
        const int gw = vcu * NWAVES + wave, NGW = G * NWAVES;
        constexpr int I_IN = 64 * 256, I_OUT = 64 * 128, I_UP = 64 * 512, I_CV = 128 * 256, I_GW = 32 * 8;
        constexpr int NITEMS = I_IN + I_OUT + I_UP + I_CV + I_GW;
        for (int it = gw; it < NITEMS; it += NGW) {
            int r = it;
            if (r < I_IN) { tr_matrix_item(w_in, D, NIN, NIN, WIN, D, scr, r, lane, nullptr); continue; } r -= I_IN;
            if (r < I_OUT) { tr_matrix_item(w_out, D, D, D, WOUT, D, scr, r, lane, nullptr); continue; } r -= I_OUT;
            if (r < I_UP) { tr_matrix_item(w_up, D, DFF, DFF, WUP, D, scr, r, lane, norm_mlp); continue; } r -= I_UP;
            if (r < I_CV) { const int sl = r >> 8, sb = sl >> 2, kvh = sl & 3;
                tr_matrix_item(cache_v + (size_t)sb * PAST * 1024 + kvh * 256, PAST, 256, 1024, VTS + (size_t)sl * 256 * TKS, TKS, scr, r & 255, lane, nullptr); continue; } r -= I_CV;
            { const int gi = r >> 3, gt = gi >> 4, nb = gi & 15;
              tr_matrix_item((gt ? gate_x_w : gate_a_w) + (size_t)nb * 16384, 128, 128, 128, GWT + (size_t)(nb * 256 + gt * 128) * 128, 128, scr, r & 7, lane, nullptr); }
        }
        for (int m = gw; m < M; m += NGW) {
            const GAS f32x4* xr = (const GAS f32x4*)(m < MP ? x_prompt + (size_t)m * D : x_sample + (size_t)(m - MP) * D) + lane;
            f32x4 v[16]; float s = 0.f;
#pragma unroll
            for (int j = 0; j < 16; ++j) { v[j] = xr[64 * j]; s += (v[j][0] * v[j][0] + v[j][1] * v[j][1]) + (v[j][2] * v[j][2] + v[j][3] * v[j][3]); }
            const float rstd = 1.0f / sqrtf(wave_sum(s) * (1.0f / D) + EPS);
            GAS v2u* o8 = (GAS v2u*)(XN + (size_t)m * D) + lane;
#pragma unroll
            for (int j = 0; j < 16; ++j) { const f32x4 gv = ((const GAS f32x4*)norm_mix)[lane + 64 * j]; v2u w; w.x = pk2(v[j][0] * rstd * gv[0], v[j][1] * rstd * gv[1]); w.y = pk2(v[j][2] * rstd * gv[2], v[j][3] * rstd * gv[3]); o8[64 * j] = w; }
        }
        for (int rr = gw; rr < 32 * PAST; rr += NGW) {
            const int sb = rr >> 11, t = rr & 2047;
            const GAS f32x4* src = (const GAS f32x4*)(cache_k + (size_t)rr * 1024); GAS v4u* dst = (GAS v4u*)(KS + ((size_t)sb * TKS + t) * 1024);
#pragma unroll
            for (int j = 0; j < 2; ++j) { const f32x4 a = src[j * 128 + lane * 2], b = src[j * 128 + lane * 2 + 1]; v4u w; w.x = pk2(a[0], a[1]); w.y = pk2(a[2], a[3]); w.z = pk2(b[0], b[1]); w.w = pk2(b[2], b[3]); dst[j * 64 + lane] = w; }
        }
        for (int jb = gw; jb < 1024; jb += NGW) rope_entry(jb * 64 + lane, TAB);
      }
        if (BOTH(0)) GRID_BAR();
    }

    if (IN(1)) {
        pg8::Gemm g{XN, WIN, M, NIN, D, D}; pg8::StaticOrder S; S.init(M, NIN, G, bx);
        pg8::EpiProj E{QB, KP, KS, VTP, VTS, XR, GG, out, TAB};
#ifndef P1_REPS
#define P1_REPS 1
#endif
        for (int rep1 = 0; rep1 < P1_REPS; ++rep1)
        pg8::gemm_phase<pg8::EpiProj, pg8::StaticOrder, PG8_ALIGN, PG8_SP2>(lds, g, S, E);
        if (BOTH(1)) GRID_BAR();
    }

    if (IN(2)) {
      for (int rep2 = 0; rep2 < P2_REPS; ++rep2) {
#ifndef P2_NO_LRU
        if (args.variant != 1) {
            lru::Job J;
            if (bx < 64) { const int b = bx >> 4;
                J.row0 = b * TP; J.n = bx & 15; J.nchunks = TP / 64; J.cprev = nullptr; J.h0 = nullptr; J.conv_out = out + O_CP + (size_t)b * 3 * LW; J.h_out = out + O_LP + (size_t)b * LW;
                lru::lru_chain(lds, J, XR, GG, CAT, GWT, conv_w, conv_b, gate_a_b, gate_x_b, lru_lambda);
            } else for (int v = bx - 64; v < 512; v += G - 64) { const int sb = v >> 4;
                J.row0 = MP + sb * TS; J.n = v & 15; J.nchunks = 1; J.cprev = state_conv + (size_t)sb * 3 * LW; J.h0 = state_lru + (size_t)sb * LW;
                J.conv_out = out + O_CS + (size_t)sb * 3 * LW; J.h_out = out + O_LS + (size_t)sb * LW;
                lru::lru_chain(lds, J, XR, GG, CAT, GWT, conv_w, conv_b, gate_a_b, gate_x_b, lru_lambda); }
        }
#endif
#ifndef P2_NO_ATT
        float lam;
        { const float d1 = wave_sum(lq1[lane] * lk1[lane] + lq1[lane + 64] * lk1[lane + 64]), d2 = wave_sum(lq2[lane] * lk2[lane] + lq2[lane + 64] * lk2[lane + 64]); lam = expf(d1) - expf(d2) + LAM_INIT; }
        if (tid < 256) ((LAS float*)(lds + SUBG_OFF))[tid] = subln_g[tid] * (1.0f - LAM_INIT);
        const unsigned myq = xb_xcc_id() & 7u; unsigned qdone = 0u;
        if (args.variant != 2)
        for (;;) {
            if (tid == 0) { unsigned res = 0xffffffffu;
                for (unsigned k = 0; k < 8u; ++k) { const unsigned q = (myq + k) & 7u; if ((qdone >> q) & 1u) continue;
                    const unsigned p = __hip_atomic_fetch_add((unsigned*)(ctl + CW_QCTR + 64 * (q + 8 * (rep2 + args.qslot))), 1u, RLX_AGENT);
                    if (p < 144u) { res = q * 256u + p; break; } qdone |= 1u << q; }
                MISC[16] = res; }
            LDS_WAIT(); RAW_BAR();
            const unsigned res = (unsigned)__builtin_amdgcn_readfirstlane((int)MISC[16]);
            LDS_WAIT(); RAW_BAR();
            if (res == 0xffffffffu) break;
            const int q = (int)(res >> 8), p = (int)(res & 255u);
            att::Unit U;
            int qc = -1, pair = 0, su = -1;
            if (p < 62) { qc = 63 - (p >> 1); pair = 2 * q + (p & 1); } else if (p < 78) su = 16 * q + (p - 62); else { const int r = p - 78; qc = 32 - (r >> 1); pair = 2 * q + (r & 1); }
            if (su >= 0) { const int sb = su >> 2, kvh = su & 3; U.Kb = KS + (size_t)sb * TKS * 1024 + kvh * 256; U.Vt = VTS + (size_t)(sb * 4 + kvh) * 256 * TKS; U.ldv = TKS; U.ntiles = TKS / 64; U.qrow0 = MP + sb * TS; U.kvh = kvh; }
            else { const int b = pair >> 2, kvh = pair & 3; U.Kb = KP + (size_t)b * TP * 1024 + kvh * 256; U.Vt = VTP + (size_t)(b * 4 + kvh) * 256 * TP; U.ldv = TP; U.ntiles = qc + 1; U.qrow0 = b * TP + qc * 64; U.kvh = kvh; }
            att::attn_unit(lds, U, QB, CAT, subln_g, lam);
        }
#endif
      }
        if (BOTH(2)) GRID_BAR();
    }

    if (IN(3)) {
        pg8::Gemm g{CAT, WOUT, M, D, D, D}; pg8::StaticOrder S; S.init(M, D, G, bx);
        pg8::EpiRes1 E{x_prompt, x_sample, HN, RSS1};
        pg8::gemm_phase<pg8::EpiRes1, pg8::StaticOrder, PG8_ALIGN, PG8_SP2>(lds, g, S, E);
        {
            const int nfull = (72 * 16) % G, nidle = G - nfull;
            if (nfull > 0 && bx >= nfull) { LAS float* scr = (LAS float*)(lds + wave * 16384);
                for (int it = (bx - nfull) * NWAVES + wave; it < 256 * 128; it += nidle * NWAVES) tr_matrix_item(w_down, DFF, D, D, WDN, DFF, scr, it, lane, nullptr); }
            else if (nfull == 0) { LAS float* scr = (LAS float*)(lds + wave * 16384);
                for (int it = bx * NWAVES + wave; it < 256 * 128; it += G * NWAVES) tr_matrix_item(w_down, DFF, D, D, WDN, DFF, scr, it, lane, nullptr); } }
        if (BOTH(3)) GRID_BAR();
    }

    if (IN(4)) {
        pg8::Gemm g{HN, WUP, M, DFF, D, D}; pg8::StaticOrder S; S.init(M, DFF, G, bx);
        pg8::EpiUp E{Z};
        for (int rep4 = 0; rep4 < P4_REPS; ++rep4)
        pg8::gemm_phase<pg8::EpiUp, pg8::StaticOrder, PG8_ALIGN, PG8_SP2>(lds, g, S, E);
        if (BOTH(4)) GRID_BAR();
    }

    if (IN(5)) {
#define P5_SIGNAL(p) do { asm volatile("s_waitcnt vmcnt(0)" ::: "memory"); __syncthreads(); \
        if (tid == 0) { __builtin_amdgcn_fence(__ATOMIC_RELEASE, "agent"); asm volatile("s_waitcnt vmcnt(0)" ::: "memory"); (void)xb_add((unsigned*)(ctl + CW_P6) + (p), 1u); } } while (0)
        { const int hu = vcu, tile = hu >> 1, kh = hu & 1;
          pg8::Gemm g{Z + (size_t)MP * DFF + (size_t)kh * (DFF / 2), WDN + (size_t)kh * (DFF / 2), MS, D, DFF / 2, DFF};
          pg8::OneUnit S; S.u.pm = tile & 7; S.u.pn = tile >> 3; S.valid = (G == 256);
          pg8::EpiPart E{(float*)(ws + WS_SP) + (size_t)kh * MS * D, RSS1 + MP};
          pg8::gemm_phase<pg8::EpiPart, pg8::OneUnit, false, PG8_SP2>(lds, g, S, E); }
        P5_SIGNAL(64 * 8);
        { pg8::Gemm g{Z, WDN, MP, D, DFF, DFF}; pg8::StaticOrder S; S.init(MP, D, G, bx);
          pg8::EpiDown E{HN, RSS1};
          pg8::gemm_phase<pg8::EpiDown, pg8::StaticOrder, PG8_ALIGN, PG8_SP2>(lds, g, S, E); }
        P5_SIGNAL(64 * (bx & 7));
#undef P5_SIGNAL
        if (BOTH(5) && G != 256) GRID_BAR();
    }

    if (IN(6)) {
        const float* SP = (const float*)(ws + WS_SP);
#define P6_ROW(m_) do { const int m = (m_); \
            GAS f32x4* yr = (GAS f32x4*)(out + O_Y + (size_t)m * D) + lane; \
            const GAS v2u* hr = (const GAS v2u*)(HN + (size_t)m * D) + lane; \
            f32x4 v[16]; float s = 0.f; \
            _Pragma("unroll") for (int j = 0; j < 16; ++j) { const v2u hv = hr[64 * j]; v[j][0] = __builtin_bit_cast(float, hv.x << 16); v[j][1] = __builtin_bit_cast(float, hv.x & 0xffff0000u); v[j][2] = __builtin_bit_cast(float, hv.y << 16); v[j][3] = __builtin_bit_cast(float, hv.y & 0xffff0000u); } \
            if (m >= MP) { const GAS f32x4* p0 = (const GAS f32x4*)(SP + (size_t)(m - MP) * D) + lane; const GAS f32x4* p1 = (const GAS f32x4*)(SP + (size_t)(MS + m - MP) * D) + lane; \
                _Pragma("unroll") for (int j = 0; j < 16; ++j) v[j] = v[j] + p0[64 * j] + p1[64 * j]; } \
            _Pragma("unroll") for (int j = 0; j < 16; ++j) s += (v[j][0] * v[j][0] + v[j][1] * v[j][1]) + (v[j][2] * v[j][2] + v[j][3] * v[j][3]); \
            const float rstd = 1.0f / sqrtf(wave_sum(s) * (1.0f / D) + EPS); \
            _Pragma("unroll") for (int j = 0; j < 16; ++j) { const f32x4 gv = ((const GAS f32x4*)norm_final)[lane + 64 * j]; yr[64 * j] = v[j] * rstd * gv; } } while (0)
        if (G == 256) {
            unsigned* pc = (unsigned*)(ctl + CW_P6); unsigned* bw = (unsigned*)(ctl + CW_BAR);
            const unsigned myg = (unsigned)bx & 7u; unsigned pend = 0x1ffu;
            for (;;) {
                if (tid == 0) { unsigned res = 0xffffffffu, sp = 0u;
                    while (pend) {
                        for (unsigned k = 0; k < 9u; ++k) { const unsigned sx = (k == 0u) ? myg : (k == 1u) ? 8u : ((myg + k - 1u) & 7u);
                            if (!((pend >> sx) & 1u)) continue;
                            if (xb_ld(pc + 64 * sx) < (sx == 8u ? 256u : 32u)) continue;
                            const unsigned p = xb_add(pc + 1024 + 64 * sx, 1u);
                            if (p < 128u) { res = sx * 256u + p; break; } pend &= ~(1u << sx); }
                        if (res != 0xffffffffu || !pend) break;
                        __builtin_amdgcn_s_sleep(2);
                        if ((++sp & 255u) == 0u) { if (xb_ld(&bw[XB_TMO])) break; if (sp > XB_SPIN_CAP) { atomicAdd(&bw[XB_TMO], 1u); break; } } }
                    __builtin_amdgcn_fence(__ATOMIC_ACQUIRE, "agent"); asm volatile("s_waitcnt vmcnt(0)" ::: "memory");
                    MISC[16] = res; }
                LDS_WAIT(); RAW_BAR();
                const unsigned res = (unsigned)__builtin_amdgcn_readfirstlane((int)MISC[16]);
                LDS_WAIT(); RAW_BAR();
                if (res == 0xffffffffu) break;
                const int sx = (int)(res >> 8), r0 = (sx == 8 ? MP : sx * 2048) + 16 * (int)(res & 255u) + wave;
                P6_ROW(r0); P6_ROW(r0 + 8);
            }
        } else {
            const int gw = vcu * NWAVES + wave, NGW = G * NWAVES;
            for (int m2 = gw; m2 < M; m2 += NGW) P6_ROW(m2);
        }
#undef P6_ROW
    }
#undef IN
#undef BOTH
#undef GRID_BAR
}

extern "C" void kernel_launch(void* const* d_in, const int* in_sizes, int n_in, void* d_out, int out_size, void* d_ws, size_t ws_size, hipStream_t stream) {
    static int grid = 0;
    if (grid == 0) {
        if (n_in != 25 || in_sizes[0] != MP * D || (size_t)out_size != O_END || ws_size < WS_END) { fprintf(stderr, "kernel_launch: unexpected shapes (n_in %d, in0 %d, out %d, ws %zu); nothing launched\n", n_in, n_in > 0 ? in_sizes[0] : -1, out_size, ws_size); grid = -1; return; }
        int dev = 0, cus = 0, per_cu = 0;
        if (hipGetDevice(&dev) != hipSuccess || hipDeviceGetAttribute(&cus, hipDeviceAttributeMultiprocessorCount, dev) != hipSuccess) { grid = -1; return; }
        if (hipFuncSetAttribute((const void*)mega_fwd, hipFuncAttributeMaxDynamicSharedMemorySize, LDS_BYTES) != hipSuccess) { fprintf(stderr, "kernel_launch: hipFuncSetAttribute failed\n"); grid = -1; return; }
        if (hipOccupancyMaxActiveBlocksPerMultiprocessor(&per_cu, (const void*)mega_fwd, NWAVES * 64, LDS_BYTES) != hipSuccess || per_cu < 1) { fprintf(stderr, "kernel_launch: occupancy query reports %d workgroups per CU\n", per_cu); }
        (void)hipGetLastError();
        grid = cus;
        if (grid != 256) { fprintf(stderr, "kernel_launch: built for a 256-CU device (got %d); nothing launched\n", cus); grid = -1; return; }
    }
    if (grid < 0) return;
    if (hipMemsetAsync((char*)d_ws + WS_CTL, 0, CTL_ZERO_BYTES, stream) != hipSuccess) return;
    Args a{};
    for (int i = 0; i < 25; ++i) a.in[i] = (const float*)d_in[i];
    a.out = (float*)d_out; a.ws = (unsigned char*)d_ws;
#ifdef PROBE_SEQ
    const int seq[] = PROBE_SEQ; int nq = 0;
    for (int li = 0; li < (int)(sizeof(seq) / sizeof(seq[0])); ++li) {
        a.ph_lo = seq[li] % 10; a.ph_hi = seq[li] % 10 + 1; a.variant = seq[li] / 10; a.qslot = (seq[li] % 10 == 2) ? nq++ : 0;
#else
    for (int li = 0; li < N_LAUNCHES; ++li) {
        a.ph_lo = (N_LAUNCHES == 1) ? 0 : li; a.ph_hi = (N_LAUNCHES == 1) ? N_PHASES : li + 1;
#endif
        hipLaunchKernelGGL(mega_fwd, dim3(grid), dim3(NWAVES * 64), LDS_BYTES, stream, a);
        const hipError_t le = hipPeekAtLastError();
        if (le != hipSuccess) { fprintf(stderr, "kernel_launch: launch %d failed: %s\n", li, hipGetErrorName(le)); break; }
    }
}
```
